# Optimizing an MI355X kernel written in HIP

```python
import jax, jax.numpy as jnp
from jax import lax
import numpy as np

D_MODEL = 1024
BATCH = 4
SEQ = 4096
DEPTH = 2

CHUNK = 64
Q_BLOCK = 128

ATT_HEADS = 8
ATT_HEAD_DIM = 64
ATT_WIDTH = ATT_HEADS * ATT_HEAD_DIM
IDX_HEADS = 8
IDX_HEAD_DIM = 64
TOPK_MAX = 256

POOL_GROUPS = 4
POOL_GROUP_DIM = 64
POOL_WIDTH = POOL_GROUPS * POOL_GROUP_DIM
POOL_WINDOWS = (2, 4, 8, 16)

CONV_WIDTH = 256
CONV_KERNEL = 31

MIX_WIDTH = ATT_WIDTH + POOL_WIDTH + CONV_WIDTH
IN_SIZES = (ATT_WIDTH, ATT_WIDTH, ATT_WIDTH,
            IDX_HEADS * IDX_HEAD_DIM, IDX_HEAD_DIM, IDX_HEADS,
            POOL_WIDTH,
            2 * CONV_WIDTH)
N_IN = sum(IN_SIZES)

N_GROUPS = 4
EXPERTS_PER_GROUP = 4
EXPERT_HIDDEN = 512
TOP_K_EXPERTS = 2

EPS = 1e-6

kernel_name = "hybrid_dsa_pool_conformer_hiermoe"


def rmsnorm(x, g):
    xf = x.astype(jnp.float32)
    y = xf * lax.rsqrt(jnp.mean(xf * xf, axis=-1, keepdims=True) + EPS)
    return (y * g.astype(jnp.float32)).astype(x.dtype)


def split_columns(p):
    offsets = []
    acc = 0
    for s in IN_SIZES[:-1]:
        acc += s
        offsets.append(acc)
    return jnp.split(p, offsets, axis=-1)


def dsa_attention(q, k, v, q_idx, k_idx, w_idx):
    B, S = q.shape[0], q.shape[1]
    nb = S // Q_BLOCK
    k_top = min(TOPK_MAX, S // 4)
    key_chunk = jnp.arange(S, dtype=jnp.int32) // CHUNK
    pos_blocks = jnp.arange(S, dtype=jnp.int32).reshape(nb, Q_BLOCK)
    k_idx_f = k_idx.astype(jnp.float32)
    att_scale = ATT_HEAD_DIM ** -0.5

    def to_blocks(a):
        return a.reshape((B, nb, Q_BLOCK) + a.shape[2:]).swapaxes(0, 1)

    def block_fn(args):
        qb, qib, wb, pos = args
        q_chunk = pos // CHUNK
        dots = jnp.einsum('bqhd,bsd->bqhs', qib.astype(jnp.float32), k_idx_f) * (IDX_HEAD_DIM ** -0.5)
        score = jnp.einsum('bqhs,bqh->bqs', jax.nn.relu(dots), wb.astype(jnp.float32)) * (IDX_HEADS ** -0.5)
        admissible = key_chunk[None, :] <= q_chunk[:, None]
        score = jnp.where(admissible[None], score, -jnp.inf)
        _, sel = lax.top_k(score, k_top)
        sel_ok = key_chunk[sel] <= q_chunk[None, :, None]
        k_sel = jax.vmap(lambda kb, ib: kb[ib])(k, sel)
        v_sel = jax.vmap(lambda vb, ib: vb[ib])(v, sel)
        logits = jnp.einsum('bqhd,bqkhd->bqhk', qb, k_sel).astype(jnp.float32) * att_scale
        logits = jnp.where(sel_ok[:, :, None, :], logits, -jnp.inf)
        p = jax.nn.softmax(logits, axis=-1).astype(v.dtype)
        return jnp.einsum('bqhk,bqkhd->bqhd', p, v_sel)

    out = lax.map(block_fn, (to_blocks(q), to_blocks(q_idx), to_blocks(w_idx), pos_blocks))
    return out.swapaxes(0, 1).reshape(B, S, ATT_HEADS * ATT_HEAD_DIM)


def pool_mixer(u, pool_w, pool_scale):
    B, S, _ = u.shape
    uf = u.astype(jnp.float32)
    csum = jnp.concatenate([jnp.zeros((B, 1, POOL_WIDTH), jnp.float32), jnp.cumsum(uf, axis=1)], axis=1)
    t1 = jnp.arange(1, S + 1, dtype=jnp.float32)
    pooled = []
    for gi, w in enumerate(POOL_WINDOWS):
        c = csum[..., gi * POOL_GROUP_DIM:(gi + 1) * POOL_GROUP_DIM]
        lagged = jnp.pad(c, ((0, 0), (w, 0), (0, 0)))[:, :S + 1]
        window_sum = c[:, 1:] - lagged[:, 1:]
        count = jnp.minimum(t1, jnp.float32(w))
        pooled.append(window_sum / count[None, :, None])
    d = (jnp.concatenate(pooled, axis=-1) - uf).astype(u.dtype)
    d = d.reshape(B, S, POOL_GROUPS, POOL_GROUP_DIM)
    y = jnp.einsum('bsgc,gcd->bsgd', d, pool_w).reshape(B, S, POOL_WIDTH)
    return y * pool_scale


def conformer_conv(u, dw_w, dw_b, ln_g, ln_b, pw_w, pw_b):
    a, gate = jnp.split(u, 2, axis=-1)
    h = a * jax.nn.sigmoid(gate)
    h = lax.conv_general_dilated(h, dw_w[:, None, :], window_strides=(1,),
                                 padding=[(CONV_KERNEL - 1, 0)],
                                 dimension_numbers=('NWC', 'WIO', 'NWC'),
                                 feature_group_count=CONV_WIDTH) + dw_b
    hf = h.astype(jnp.float32)
    mu = jnp.mean(hf, axis=-1, keepdims=True)
    var = jnp.mean(jnp.square(hf - mu), axis=-1, keepdims=True)
    hf = (hf - mu) * lax.rsqrt(var + EPS) * ln_g.astype(jnp.float32) + ln_b.astype(jnp.float32)
    h = jax.nn.silu(hf).astype(u.dtype)
    return h @ pw_w + pw_b


def hier_moe(h, rg_w, rg_b, re_w, re_b, w_gate, w_up, w_down):
    B, S, D = h.shape
    t = h.reshape(B * S, D)
    g_prob = jax.nn.softmax((t @ rg_w + rg_b).astype(jnp.float32), axis=-1)
    g_sel = jnp.argmax(g_prob, axis=-1)
    p_g = jnp.take_along_axis(g_prob, g_sel[:, None], axis=1)[:, 0]
    e_logits = (t @ re_w + re_b).astype(jnp.float32).reshape(-1, N_GROUPS, EXPERTS_PER_GROUP)
    e_in = jnp.take_along_axis(e_logits, g_sel[:, None, None], axis=1)[:, 0]
    e_prob = jax.nn.softmax(e_in, axis=-1)
    top_v, top_i = lax.top_k(e_prob, TOP_K_EXPERTS)
    top_v = top_v / jnp.sum(top_v, axis=-1, keepdims=True)
    w_e = jnp.sum(jax.nn.one_hot(top_i, EXPERTS_PER_GROUP, dtype=jnp.float32) * top_v[..., None], axis=1)
    gate = (jax.nn.one_hot(g_sel, N_GROUPS, dtype=jnp.float32)[:, :, None]
            * (p_g[:, None, None] * w_e[:, None, :])).astype(h.dtype)
    y = jnp.zeros_like(t)
    for gi in range(N_GROUPS):
        a = jnp.einsum('td,edh->teh', t, w_gate[gi])
        b = jnp.einsum('td,edh->teh', t, w_up[gi])
        act = jax.nn.silu(a) * b * gate[:, gi, :, None]
        y = y + jnp.einsum('teh,ehd->td', act, w_down[gi])
    return y.reshape(B, S, D)


def setup_inputs(seed: int = 0) -> dict:
    key = jax.random.key(seed)
    ks = jax.random.split(key, 24)
    f32 = jnp.float32
    n = lambda k, shape: jax.random.normal(k, shape, f32)
    L, D, G, E, H = DEPTH, D_MODEL, N_GROUPS, EXPERTS_PER_GROUP, EXPERT_HIDDEN
    return {
        "x": n(ks[0], (BATCH, SEQ, D)),
        "norm1_g": 1.0 + 0.02 * n(ks[1], (L, D)),
        "w_in": n(ks[2], (L, D, N_IN)) * D ** -0.5,
        "pool_w": n(ks[3], (L, POOL_GROUPS, POOL_GROUP_DIM, POOL_GROUP_DIM)) * POOL_GROUP_DIM ** -0.5,
        "pool_scale": 1.0 + 0.02 * n(ks[4], (L, POOL_WIDTH)),
        "dw_w": n(ks[5], (L, CONV_KERNEL, CONV_WIDTH)) * CONV_KERNEL ** -0.5,
        "dw_b": 0.02 * n(ks[6], (L, CONV_WIDTH)),
        "conv_ln_g": 1.0 + 0.02 * n(ks[7], (L, CONV_WIDTH)),
        "conv_ln_b": 0.02 * n(ks[8], (L, CONV_WIDTH)),
        "pw_w": n(ks[9], (L, CONV_WIDTH, CONV_WIDTH)) * CONV_WIDTH ** -0.5,
        "pw_b": 0.02 * n(ks[10], (L, CONV_WIDTH)),
        "w_out": n(ks[11], (L, MIX_WIDTH, D)) * MIX_WIDTH ** -0.5,
        "norm2_g": 1.0 + 0.02 * n(ks[12], (L, D)),
        "rg_w": n(ks[13], (L, D, G)) * D ** -0.5,
        "rg_b": 0.01 * n(ks[14], (L, G)),
        "re_w": n(ks[15], (L, D, G * E)) * D ** -0.5,
        "re_b": 0.01 * n(ks[16], (L, G * E)),
        "w_gate": n(ks[17], (L, G, E, D, H)) * D ** -0.5,
        "w_up": n(ks[18], (L, G, E, D, H)) * D ** -0.5,
        "w_down": n(ks[19], (L, G, E, H, D)) * H ** -0.5,
        "final_g": 1.0 + 0.02 * n(ks[20], (D,)),
    }


def reference(x, norm1_g, w_in, pool_w, pool_scale, dw_w, dw_b, conv_ln_g, conv_ln_b, pw_w, pw_b,
              w_out, norm2_g, rg_w, rg_b, re_w, re_b, w_gate, w_up, w_down, final_g):
    B, S, _ = x.shape
    for l in range(DEPTH):
        h = rmsnorm(x, norm1_g[l])
        proj = h @ w_in[l]
        q, k, v, qi, ki, wi, pool_in, conv_in = split_columns(proj)
        q = q.reshape(B, S, ATT_HEADS, ATT_HEAD_DIM)
        k = k.reshape(B, S, ATT_HEADS, ATT_HEAD_DIM)
        v = v.reshape(B, S, ATT_HEADS, ATT_HEAD_DIM)
        qi = qi.reshape(B, S, IDX_HEADS, IDX_HEAD_DIM)
        y_a = dsa_attention(q, k, v, qi, ki, wi)
        y_b = pool_mixer(pool_in, pool_w[l], pool_scale[l])
        y_c = conformer_conv(conv_in, dw_w[l], dw_b[l], conv_ln_g[l], conv_ln_b[l], pw_w[l], pw_b[l])
        x = x + jnp.concatenate([y_a, y_b, y_c], axis=-1) @ w_out[l]
        h2 = rmsnorm(x, norm2_g[l])
        x = x + hier_moe(h2, rg_w[l], rg_b[l], re_w[l], re_b[l], w_gate[l], w_up[l], w_down[l])
    return rmsnorm(x, final_g)
```

```cpp
#include <hip/hip_runtime.h>
#include <cstdio>
#include <cstdint>
#include <cmath>

namespace nv {
constexpr int BATCH = 4, SEQ = 4096, D = 1024, T = BATCH * SEQ, DEPTH = 2;
constexpr int NIN = 2888;
constexpr int C_Q = 0, C_K = 512, C_V = 1024, C_QI = 1536, C_KI = 2048, C_WI = 2112, C_POOL = 2120, C_CONV = 2376;
constexpr float EPS = 1e-6f;

__device__ __forceinline__ float wave_sum(float v) {
#pragma unroll
    for (int o = 1; o < 64; o <<= 1) v += __shfl_xor(v, o);
    return v;
}
__device__ __forceinline__ float wave_max(float v) {
#pragma unroll
    for (int o = 1; o < 64; o <<= 1) v = fmaxf(v, __shfl_xor(v, o));
    return v;
}
__device__ __forceinline__ float block_sum256(float v, float* red) {
    v = wave_sum(v);
    __syncthreads();
    if ((threadIdx.x & 63) == 0) red[threadIdx.x >> 6] = v;
    __syncthreads();
    return (red[0] + red[1]) + (red[2] + red[3]);
}

__global__ void __launch_bounds__(256) k_rmsnorm(const float* x, const float* __restrict__ g, float* out) {
    __shared__ float red[4];
    const int row = blockIdx.x, tid = threadIdx.x;
    const float4 v = ((const float4*)(x + (size_t)row * D))[tid];
    float s = v.x * v.x + v.y * v.y + v.z * v.z + v.w * v.w;
    s = block_sum256(s, red);
    const float r = 1.0f / sqrtf(s * (1.0f / D) + EPS);
    const float4 gv = ((const float4*)g)[tid];
    float4 o; o.x = v.x * r * gv.x; o.y = v.y * r * gv.y; o.z = v.z * r * gv.z; o.w = v.w * r * gv.w;
    ((float4*)(out + (size_t)row * D))[tid] = o;
}

__global__ void __launch_bounds__(256) k_sgemm(const float* __restrict__ A, int lda, const float* __restrict__ B, int ldb, float* C, int ldc,
                                               const float* R, int ldr, int M, int N, int K) {
    __shared__ float sA[16][68];
    __shared__ float sB[16][68];
    const int tid = threadIdx.x, tx = tid & 15, ty = tid >> 4;
    const int m0 = blockIdx.y * 64, n0 = blockIdx.x * 64;
    float acc[4][4];
#pragma unroll
    for (int i = 0; i < 4; ++i)
#pragma unroll
        for (int j = 0; j < 4; ++j) acc[i][j] = 0.f;
    for (int k0 = 0; k0 < K; k0 += 16) {
#pragma unroll
        for (int i = 0; i < 4; ++i) { const int e = tid + i * 256, r = e >> 4, c = e & 15; sA[c][r] = A[(size_t)(m0 + r) * lda + k0 + c]; }
#pragma unroll
        for (int i = 0; i < 4; ++i) { const int e = tid + i * 256, r = e >> 6, c = e & 63; sB[r][c] = (n0 + c < N) ? B[(size_t)(k0 + r) * ldb + n0 + c] : 0.f; }
        __syncthreads();
#pragma unroll
        for (int kk = 0; kk < 16; ++kk) {
            float a[4], b[4];
#pragma unroll
            for (int i = 0; i < 4; ++i) { a[i] = sA[kk][ty * 4 + i]; b[i] = sB[kk][tx * 4 + i]; }
#pragma unroll
            for (int i = 0; i < 4; ++i)
#pragma unroll
                for (int j = 0; j < 4; ++j) acc[i][j] += a[i] * b[j];
        }
        __syncthreads();
    }
#pragma unroll
    for (int i = 0; i < 4; ++i)
#pragma unroll
        for (int j = 0; j < 4; ++j) {
            const int r = m0 + ty * 4 + i, c = n0 + tx * 4 + j;
            if (c < N) { float v = acc[i][j]; if (R) v += R[(size_t)r * ldr + c]; C[(size_t)r * ldc + c] = v; }
        }
}

__global__ void __launch_bounds__(256) k_index_topk(const float* __restrict__ P, unsigned* __restrict__ mask) {
    __shared__ float qi[512];
    __shared__ float w[8];
    __shared__ float sc[SEQ];
    const int tok = blockIdx.x, b = tok / SEQ, t = tok % SEQ, tid = threadIdx.x, lane = tid & 63, wv = tid >> 6;
    const int n = ((t >> 6) + 1) * 64;
    const float* prow = P + (size_t)tok * NIN;
    qi[tid] = prow[C_QI + tid]; qi[tid + 256] = prow[C_QI + 256 + tid];
    if (tid < 8) w[tid] = prow[C_WI + tid];
    __syncthreads();
    for (int s = tid; s < n; s += 256) {
        const float* kr = P + (size_t)(b * SEQ + s) * NIN + C_KI;
        float kv[64];
#pragma unroll
        for (int d = 0; d < 64; d += 4) { const float4 v = *(const float4*)(kr + d); kv[d] = v.x; kv[d + 1] = v.y; kv[d + 2] = v.z; kv[d + 3] = v.w; }
        float score = 0.f;
        for (int h = 0; h < 8; ++h) {
            float dsum = 0.f;
#pragma unroll
            for (int d = 0; d < 64; ++d) dsum += qi[h * 64 + d] * kv[d];
            score += fmaxf(dsum * 0.125f, 0.f) * w[h];
        }
        sc[s] = score * 0.35355339059327373f;
    }
    __syncthreads();
    unsigned* mrow = mask + (size_t)tok * 128;
    for (int base = 0; base < SEQ; base += 256) {
        const int s = base + wv * 64 + lane;
        bool sel = false;
        if (s < n) {
            if (n <= 256) sel = true;
            else {
                const float v = sc[s];
                int rank = 0;
                for (int j = 0; j < n; ++j) { const float u = sc[j]; rank += (u > v || (u == v && j < s)) ? 1 : 0; }
                sel = rank < 256;
            }
        }
        const unsigned long long bal = __ballot(sel);
        if (lane == 0) { mrow[(base + wv * 64) / 32] = (unsigned)bal; mrow[(base + wv * 64) / 32 + 1] = (unsigned)(bal >> 32); }
    }
}

__global__ void __launch_bounds__(256) k_attn(const float* __restrict__ P, const unsigned* __restrict__ mask, float* __restrict__ Y) {
    __shared__ float q[512];
    __shared__ int sel[256];
    __shared__ int pre[129];
    __shared__ float lg[8][256];
    __shared__ float rs[8];
    const int tok = blockIdx.x, b = tok / SEQ, tid = threadIdx.x, lane = tid & 63, wv = tid >> 6;
    const float* prow = P + (size_t)tok * NIN;
    q[tid] = prow[C_Q + tid]; q[tid + 256] = prow[C_Q + 256 + tid];
    const unsigned* mrow = mask + (size_t)tok * 128;
    unsigned mw = 0;
    if (tid < 128) mw = mrow[tid];
    if (tid < 128) pre[tid + 1] = __popc(mw);
    if (tid == 0) pre[0] = 0;
    __syncthreads();
    if (tid == 0) { for (int i = 1; i <= 128; ++i) pre[i] += pre[i - 1]; }
    __syncthreads();
    if (tid < 128) { int p = pre[tid]; unsigned m = mw; while (m) { const int bit = __ffs(m) - 1; m &= m - 1; if (p < 256) sel[p] = tid * 32 + bit; ++p; } }
    __syncthreads();
    int cnt = pre[128]; if (cnt > 256) cnt = 256;
    if (tid < cnt) {
        const float* kr = P + (size_t)(b * SEQ + sel[tid]) * NIN + C_K;
        for (int h = 0; h < 8; ++h) {
            float dsum = 0.f;
#pragma unroll
            for (int d = 0; d < 64; d += 4) { const float4 v = *(const float4*)(kr + h * 64 + d); dsum += q[h * 64 + d] * v.x + q[h * 64 + d + 1] * v.y + q[h * 64 + d + 2] * v.z + q[h * 64 + d + 3] * v.w; }
            lg[h][tid] = dsum * 0.125f;
        }
    }
    __syncthreads();
    for (int hh = 0; hh < 2; ++hh) {
        const int h = wv * 2 + hh;
        float m = -INFINITY;
        for (int j = lane; j < cnt; j += 64) m = fmaxf(m, lg[h][j]);
        m = wave_max(m);
        float s = 0.f;
        for (int j = lane; j < cnt; j += 64) { const float e = expf(lg[h][j] - m); lg[h][j] = e; s += e; }
        s = wave_sum(s);
        if (lane == 0) rs[h] = 1.0f / s;
    }
    __syncthreads();
    for (int oo = 0; oo < 2; ++oo) {
        const int o = tid + oo * 256, h = o >> 6;
        float acc = 0.f;
        for (int j = 0; j < cnt; ++j) acc += lg[h][j] * P[(size_t)(b * SEQ + sel[j]) * NIN + C_V + o];
        Y[(size_t)tok * D + o] = acc * rs[h];
    }
}

__global__ void __launch_bounds__(256) k_pool(const float* __restrict__ P, const float* __restrict__ pw, const float* __restrict__ ps, float* __restrict__ Y) {
    __shared__ float d[256];
    const int tok = blockIdx.x, t = tok % SEQ, c = threadIdx.x, g = c >> 6;
    const int win = 2 << g;
    const int cntw = (t + 1 < win) ? (t + 1) : win;
    float s = 0.f;
    for (int j = 0; j < cntw; ++j) s += P[(size_t)(tok - j) * NIN + C_POOL + c];
    d[c] = s / (float)cntw - P[(size_t)tok * NIN + C_POOL + c];
    __syncthreads();
    const int dout = c & 63;
    float acc = 0.f;
    for (int cc = 0; cc < 64; ++cc) acc += d[g * 64 + cc] * pw[(size_t)(g * 64 + cc) * 64 + dout];
    Y[(size_t)tok * D + 512 + c] = acc * ps[c];
}

__global__ void __launch_bounds__(256) k_conv(const float* __restrict__ P, const float* __restrict__ dw_w, const float* __restrict__ dw_b, const float* __restrict__ ln_g,
                                              const float* __restrict__ ln_b, const float* __restrict__ pw_w, const float* __restrict__ pw_b, float* __restrict__ Y) {
    __shared__ float sh[256];
    __shared__ float red[4];
    const int tok = blockIdx.x, t = tok % SEQ, c = threadIdx.x;
    float h = dw_b[c];
    for (int j = 0; j < 31; ++j) {
        const int tt = t - 30 + j;
        if (tt >= 0) {
            const float* pr = P + (size_t)(tok - 30 + j) * NIN + C_CONV;
            const float a = pr[c], gt = pr[256 + c];
            h += a * (1.0f / (1.0f + expf(-gt))) * dw_w[j * 256 + c];
        }
    }
    const float mu = block_sum256(h, red) * (1.0f / 256.0f);
    const float dv = h - mu;
    const float var = block_sum256(dv * dv, red) * (1.0f / 256.0f);
    float y = dv * (1.0f / sqrtf(var + EPS)) * ln_g[c] + ln_b[c];
    y = y / (1.0f + expf(-y));
    __syncthreads();
    sh[c] = y;
    __syncthreads();
    float acc = pw_b[c];
    for (int k = 0; k < 256; ++k) acc += sh[k] * pw_w[k * 256 + c];
    Y[(size_t)tok * D + 768 + c] = acc;
}

__global__ void __launch_bounds__(256) k_router(const float* __restrict__ X1, const float* __restrict__ g2, const float* __restrict__ rg_w, const float* __restrict__ rg_b,
                                                const float* __restrict__ re_w, const float* __restrict__ re_b, float* __restrict__ H2, int* __restrict__ route_e, float* __restrict__ route_w) {
    __shared__ float red[4];
    __shared__ float part[20][4];
    const int tok = blockIdx.x, tid = threadIdx.x, lane = tid & 63, wv = tid >> 6;
    const float4 v = ((const float4*)(X1 + (size_t)tok * D))[tid];
    float s = v.x * v.x + v.y * v.y + v.z * v.z + v.w * v.w;
    s = block_sum256(s, red);
    const float r = 1.0f / sqrtf(s * (1.0f / D) + EPS);
    const float4 gv = ((const float4*)g2)[tid];
    float hv[4] = {v.x * r * gv.x, v.y * r * gv.y, v.z * r * gv.z, v.w * r * gv.w};
    ((float4*)(H2 + (size_t)tok * D))[tid] = make_float4(hv[0], hv[1], hv[2], hv[3]);
    float lg[20];
#pragma unroll
    for (int j = 0; j < 20; ++j) lg[j] = 0.f;
#pragma unroll
    for (int i = 0; i < 4; ++i) {
        const int k = tid * 4 + i;
#pragma unroll
        for (int j = 0; j < 4; ++j) lg[j] += hv[i] * rg_w[k * 4 + j];
#pragma unroll
        for (int j = 0; j < 16; ++j) lg[4 + j] += hv[i] * re_w[k * 16 + j];
    }
#pragma unroll
    for (int j = 0; j < 20; ++j) { const float x = wave_sum(lg[j]); if (lane == 0) part[j][wv] = x; }
    __syncthreads();
    if (tid == 0) {
        float gl[4], el[16];
        for (int j = 0; j < 4; ++j) gl[j] = (part[j][0] + part[j][1]) + (part[j][2] + part[j][3]) + rg_b[j];
        for (int j = 0; j < 16; ++j) el[j] = (part[4 + j][0] + part[4 + j][1]) + (part[4 + j][2] + part[4 + j][3]) + re_b[j];
        int gs = 0; float gm = gl[0];
        for (int j = 1; j < 4; ++j) if (gl[j] > gm) { gm = gl[j]; gs = j; }
        float gsum = 0.f;
        for (int j = 0; j < 4; ++j) gsum += expf(gl[j] - gm);
        const float pg = 1.0f / gsum;
        float em = el[gs * 4];
        for (int j = 1; j < 4; ++j) em = fmaxf(em, el[gs * 4 + j]);
        float ep[4], esum = 0.f;
        for (int j = 0; j < 4; ++j) { ep[j] = expf(el[gs * 4 + j] - em); esum += ep[j]; }
        for (int j = 0; j < 4; ++j) ep[j] /= esum;
        int i1 = 0; for (int j = 1; j < 4; ++j) if (ep[j] > ep[i1]) i1 = j;
        int i2 = -1; for (int j = 0; j < 4; ++j) if (j != i1 && (i2 < 0 || ep[j] > ep[i2])) i2 = j;
        const float den = ep[i1] + ep[i2];
        route_e[tok * 2] = gs * 4 + i1; route_e[tok * 2 + 1] = gs * 4 + i2;
        route_w[tok * 2] = pg * (ep[i1] / den); route_w[tok * 2 + 1] = pg * (ep[i2] / den);
    }
}

__global__ void __launch_bounds__(256) k_moe(const float* __restrict__ H2, const int* __restrict__ route_e, const float* __restrict__ route_w,
                                             const float* __restrict__ w_gate, const float* __restrict__ w_up, const float* __restrict__ w_down,
                                             const float* Xin, float* Xout) {
    __shared__ float xs[1024];
    __shared__ float hid[2][512];
    const int tok = blockIdx.x, tid = threadIdx.x;
    ((float4*)xs)[tid] = ((const float4*)(H2 + (size_t)tok * D))[tid];
    __syncthreads();
    for (int s = 0; s < 2; ++s) {
        const int e = route_e[tok * 2 + s]; const float gw = route_w[tok * 2 + s];
        const float* Wg = w_gate + (size_t)e * 1024 * 512; const float* Wu = w_up + (size_t)e * 1024 * 512;
        for (int hh = 0; hh < 2; ++hh) {
            const int h = tid + hh * 256;
            float a = 0.f, bb = 0.f;
            for (int k = 0; k < 1024; ++k) { const float x = xs[k]; a += x * Wg[(size_t)k * 512 + h]; bb += x * Wu[(size_t)k * 512 + h]; }
            hid[s][h] = (a / (1.0f + expf(-a))) * bb * gw;
        }
    }
    __syncthreads();
    float acc[4] = {0.f, 0.f, 0.f, 0.f};
    for (int s = 0; s < 2; ++s) {
        const int e = route_e[tok * 2 + s];
        const float* Wd = w_down + (size_t)e * 512 * 1024;
        for (int h = 0; h < 512; ++h) {
            const float hv = hid[s][h];
#pragma unroll
            for (int i = 0; i < 4; ++i) acc[i] += hv * Wd[(size_t)h * 1024 + tid + i * 256];
        }
    }
#pragma unroll
    for (int i = 0; i < 4; ++i) Xout[(size_t)tok * D + tid + i * 256] = Xin[(size_t)tok * D + tid + i * 256] + acc[i];
}
}

extern "C" void kernel_launch(void* const* d_in, const int* in_sizes, int n_in, void* d_out, int out_size, void* d_ws, size_t ws_size, hipStream_t stream) {
    using namespace nv;
    const float* x = (const float*)d_in[0];
    const float* norm1_g = (const float*)d_in[1];
    const float* w_in = (const float*)d_in[2];
    const float* pool_w = (const float*)d_in[3];
    const float* pool_scale = (const float*)d_in[4];
    const float* dw_w = (const float*)d_in[5];
    const float* dw_b = (const float*)d_in[6];
    const float* conv_ln_g = (const float*)d_in[7];
    const float* conv_ln_b = (const float*)d_in[8];
    const float* pw_w = (const float*)d_in[9];
    const float* pw_b = (const float*)d_in[10];
    const float* w_out = (const float*)d_in[11];
    const float* norm2_g = (const float*)d_in[12];
    const float* rg_w = (const float*)d_in[13];
    const float* rg_b = (const float*)d_in[14];
    const float* re_w = (const float*)d_in[15];
    const float* re_b = (const float*)d_in[16];
    const float* w_gate = (const float*)d_in[17];
    const float* w_up = (const float*)d_in[18];
    const float* w_down = (const float*)d_in[19];
    const float* final_g = (const float*)d_in[20];
    float* out = (float*)d_out;
    unsigned char* ws = (unsigned char*)d_ws;
    const size_t MiB = 1u << 20;
    float* H = (float*)(ws);
    float* P = (float*)(ws + 64 * MiB);
    unsigned* mask = (unsigned*)(ws + 246 * MiB);
    int* route_e = (int*)(ws + 254 * MiB);
    float* route_w = (float*)(ws + 254 * MiB + 256 * 1024);
    if (ws_size < 255 * MiB) { fprintf(stderr, "ws too small\n"); return; }
    for (int l = 0; l < DEPTH; ++l) {
        const float* xin = (l == 0) ? x : out;
        k_rmsnorm<<<T, 256, 0, stream>>>(xin, norm1_g + (size_t)l * D, H);
        k_sgemm<<<dim3((NIN + 63) / 64, T / 64), 256, 0, stream>>>(H, D, w_in + (size_t)l * D * NIN, NIN, P, NIN, nullptr, 0, T, NIN, D);
        k_index_topk<<<T, 256, 0, stream>>>(P, mask);
        float* Y = H;
        k_attn<<<T, 256, 0, stream>>>(P, mask, Y);
        k_pool<<<T, 256, 0, stream>>>(P, pool_w + (size_t)l * 4 * 64 * 64, pool_scale + (size_t)l * 256, Y);
        k_conv<<<T, 256, 0, stream>>>(P, dw_w + (size_t)l * 31 * 256, dw_b + (size_t)l * 256, conv_ln_g + (size_t)l * 256, conv_ln_b + (size_t)l * 256,
                                      pw_w + (size_t)l * 256 * 256, pw_b + (size_t)l * 256, Y);
        k_sgemm<<<dim3(D / 64, T / 64), 256, 0, stream>>>(Y, D, w_out + (size_t)l * D * D, D, out, D, xin, D, T, D, D);
        k_router<<<T, 256, 0, stream>>>(out, norm2_g + (size_t)l * D, rg_w + (size_t)l * D * 4, rg_b + (size_t)l * 4, re_w + (size_t)l * D * 16, re_b + (size_t)l * 16, H, route_e, route_w);
        k_moe<<<T, 256, 0, stream>>>(H, route_e, route_w, w_gate + (size_t)l * 16 * 1024 * 512, w_up + (size_t)l * 16 * 1024 * 512, w_down + (size_t)l * 16 * 512 * 1024, out, out);
    }
    k_rmsnorm<<<T, 256, 0, stream>>>(out, final_g, out);
}
```

```cpp
#include <hip/hip_runtime.h>
#include <cstdio>
#include <cstdint>
#include <cmath>
#define MK_NAIVE_MASK 0x0u
#define MK_FUSE 1
namespace pg8 {
#define PG8_LAS __attribute__((address_space(3)))
typedef unsigned short bf16_t;
typedef short bf16x8 __attribute__((ext_vector_type(8)));
typedef float f32x4 __attribute__((ext_vector_type(4)));
typedef unsigned u32x4 __attribute__((ext_vector_type(4)));
constexpr int BM = 256, BK = 64, HALF = 128, HTB = HALF * BK * 2  , STAGE_BYTES = 8 * HTB, NXCD = 8, WGM = 8;

__host__ __device__ __forceinline__ int lds_byte(int r, int c) { const int st = (r >> 4) * 2 + (c >> 5), rr = r & 15, cc = c & 31, ob = rr * 64 + cc * 2; return st * 1024 + (ob ^ (((ob >> 9) & 1) << 5)); }
__host__ __device__ __forceinline__ void stage_rc(int b, int& R, int& C) { const int st = b / 1024, sb = b % 1024, swz = sb ^ (((sb >> 9) & 1) << 5); R = (st >> 1) * 16 + swz / 64; C = (st & 1) * 32 + (swz % 64) / 2; }
__host__ __device__ __forceinline__ int perm32(int rho) { const int n = rho >> 4, i = rho & 15; return 8 * (i >> 2) + 4 * n + (i & 3); }

struct Unit { int pm, pn; };
struct Gemm { const bf16_t* A; const bf16_t* Bt; int M, N, K; };

struct StaticOrder {
    int nM, nN, nwg, G, c;
    __host__ __device__ void init(int M, int N, int G_, int c_) { nM = M / BM; nN = N / BM; nwg = nM * nN; G = G_; c = c_; }
    __host__ __device__ bool next(int i, Unit& u) const {
        const long L = (long)i * G + c; if (L >= nwg) return false;
        int wgid = (int)L; { const int q = nwg / NXCD, r = nwg % NXCD, xcd = wgid % NXCD, off = wgid / NXCD; wgid = (xcd < r ? xcd * (q + 1) : r * (q + 1) + (xcd - r) * q) + off; }
        const int nig = WGM * nN, gid = wgid / nig, fm = gid * WGM, gsz = (nM - fm) < WGM ? (nM - fm) : WGM;
        u.pm = fm + ((wgid % nig) % gsz); u.pn = (wgid % nig) / gsz; return true;
    }
    __device__ __forceinline__ void a_ready(const Unit&) const {}
    __device__ __forceinline__ void done(const Unit&) const {}
};

__device__ __forceinline__ unsigned cvt_pk_bf16(float lo, float hi) { unsigned r; asm volatile("v_cvt_pk_bf16_f32 %0, %1, %2" : "=v"(r) : "v"(lo), "v"(hi)); return r; }
typedef float f32x2 __attribute__((ext_vector_type(2)));
__device__ __forceinline__ f32x2 gelu_pk(f32x2 v) {
    const f32x2 av = __builtin_elementwise_abs(v), d = av * 0.2316418882f + 1.0f;
    f32x2 t; t.x = __builtin_amdgcn_rcpf(d.x); t.y = __builtin_amdgcn_rcpf(d.y);
    f32x2 q = t * 0.5307027145f + (-0.7265760135f); q = q * t + 0.7107068705f; q = q * t + (-0.142248368f); q = q * t + 0.127414796f; q = q * t;
    const f32x2 s = (v * v) * (-0.72134752044f);
    f32x2 e; e.x = __builtin_amdgcn_exp2f(s.x); e.y = __builtin_amdgcn_exp2f(s.y);
    const f32x2 m = v * (q * e), r = v - m;
    f32x2 o; o.x = v.x < 0.f ? m.x : r.x; o.y = v.y < 0.f ? m.y : r.y; return o;
}

template <int ACT  > struct EpiBf16 {
    static constexpr bool PERM = true, AFTER_DRAIN = false; static_assert(ACT == 0 || ACT == 1, "EpiBf16: ACT is 0 (none) or 1 (gelu_pk)");
    bf16_t* O; int ldc; const float* bias; int split_cols; size_t split_stride; float scale0;
    __device__ __forceinline__ void operator()(const f32x4 (&acc)[2][2][4][2], const Unit& u, int wr, int wc, int fr, int fq) const {
        const int row0 = u.pm * BM + wr * 64 + fr; int colt = u.pn * BM; bf16_t* base = O;
        float sc = 1.f; if (split_cols) { const int t = colt / split_cols; base += (size_t)t * split_stride; colt -= t * split_cols; if (t == 0) sc = scale0; }
        const int col0 = colt + wc * 32 + 8 * fq, bcol0 = u.pn * BM + wc * 32 + 8 * fq;
        f32x4 bv[2][2];
#pragma unroll
        for (int bj = 0; bj < 2; ++bj)
#pragma unroll
            for (int n = 0; n < 2; ++n) bv[bj][n] = bias ? *(const f32x4*)(bias + bcol0 + bj * HALF + 4 * n) : (f32x4){0.f, 0.f, 0.f, 0.f};
#pragma unroll
        for (int ai = 0; ai < 2; ++ai)
#pragma unroll
            for (int m = 0; m < 4; ++m) { bf16_t* rowp = base + (size_t)(row0 + ai * HALF + m * 16) * ldc + col0;
#pragma unroll
                for (int bj = 0; bj < 2; ++bj) { f32x4 v0 = acc[ai][bj][m][0] + bv[bj][0], v1 = acc[ai][bj][m][1] + bv[bj][1];
                    if (ACT == 1) { f32x2 a = gelu_pk((f32x2){v0[0], v0[1]}), b = gelu_pk((f32x2){v0[2], v0[3]}), c = gelu_pk((f32x2){v1[0], v1[1]}), d = gelu_pk((f32x2){v1[2], v1[3]});
                        v0 = (f32x4){a.x, a.y, b.x, b.y}; v1 = (f32x4){c.x, c.y, d.x, d.y}; }
                    v0 = v0 * sc; v1 = v1 * sc; u32x4 w; w.x = cvt_pk_bf16(v0[0], v0[1]); w.y = cvt_pk_bf16(v0[2], v0[3]); w.z = cvt_pk_bf16(v1[0], v1[1]); w.w = cvt_pk_bf16(v1[2], v1[3]);
                    *(u32x4*)(rowp + bj * HALF) = w; } }
    }
};

struct PanelStats {
    unsigned* xbuf;
    unsigned* cnt;
    unsigned* tmo;
    int ntn; float eps;
    unsigned code;
    __device__ __forceinline__ bool run(const f32x4 (&v)[2][2][4][2], const Unit& u, int wr, int wc, int fr, int fq, PG8_LAS unsigned char* lds, int wid, int lane) const {
        typedef float f32x2v __attribute__((ext_vector_type(2)));
        PG8_LAS f32x2v* P = (PG8_LAS f32x2v*)lds;
        PG8_LAS f32x2v* S = (PG8_LAS f32x2v*)(lds + 8192);
        PG8_LAS unsigned* flag = (PG8_LAS unsigned*)(lds + 8192 + 2048);
#pragma unroll
        for (int ai = 0; ai < 2; ++ai)
#pragma unroll
            for (int m = 0; m < 4; ++m) {
                float s = 0.f;
#pragma unroll
                for (int bj = 0; bj < 2; ++bj)
#pragma unroll
                    for (int n = 0; n < 2; ++n) { const f32x4 x = v[ai][bj][m][n]; s += (x[0] + x[1]) + (x[2] + x[3]); }
                s += __shfl_xor(s, 16); s += __shfl_xor(s, 32);
                const float mw = s * (1.0f / 64.0f); float q = 0.f;
#pragma unroll
                for (int bj = 0; bj < 2; ++bj)
#pragma unroll
                    for (int n = 0; n < 2; ++n) { const f32x4 d = v[ai][bj][m][n] - mw; q += (d[0] * d[0] + d[1] * d[1]) + (d[2] * d[2] + d[3] * d[3]); }
                q += __shfl_xor(q, 16); q += __shfl_xor(q, 32);
                if (fq == 0) P[(ai * HALF + wr * 64 + m * 16 + fr) * 4 + wc] = (f32x2v){mw, q};
            }
        asm volatile("s_waitcnt lgkmcnt(0)" ::: "memory"); __builtin_amdgcn_s_barrier(); asm volatile("" ::: "memory");
#if defined(BROKEN_EXCHANGE_NO_WAIT)
#warning BROKEN CONTROL BUILD: the row-statistics exchange does not wait; results are wrong by design
        if (blockIdx.x >= 64) { const long long t0_ = clock64(); while (clock64() - t0_ < 60000) __builtin_amdgcn_s_sleep(8); }
#endif
        const int row = wid * 32 + (lane & 31);
        if (lane < 32) {
            const f32x2v a = P[row * 4 + 0], b = P[row * 4 + 1], c = P[row * 4 + 2], d = P[row * 4 + 3];
            const float mt = (a.x + b.x + c.x + d.x) * 0.25f;
            const float da = a.x - mt, db = b.x - mt, dc = c.x - mt, dd = d.x - mt;
            const float m2 = (a.y + b.y) + (c.y + d.y) + 64.0f * ((da * da + db * db) + (dc * dc + dd * dd));
            unsigned long long* slot = (unsigned long long*)xbuf + ((size_t)(u.pm * BM + row) * 4 + u.pn);
            __hip_atomic_store(slot, ((unsigned long long)__float_as_uint(m2) << 32) | __float_as_uint(mt), __ATOMIC_RELAXED, __HIP_MEMORY_SCOPE_AGENT);
        }
        asm volatile("s_waitcnt vmcnt(0)" ::: "memory");
        if (lane == 0) __hip_atomic_fetch_add(cnt + 64 * u.pm, 1u, __ATOMIC_RELAXED, __HIP_MEMORY_SCOPE_AGENT);
        if (wid == 0) {
            bool dead = false; const unsigned long long t0 = __builtin_amdgcn_s_memrealtime(); const unsigned want = 8u * (unsigned)ntn;
            for (;;) {
#if defined(BROKEN_EXCHANGE_NO_WAIT)
                break;
#endif
                if ((unsigned)__builtin_amdgcn_readfirstlane(__hip_atomic_load(cnt + 64 * u.pm, __ATOMIC_RELAXED, __HIP_MEMORY_SCOPE_AGENT)) >= want) break;
                if (__builtin_amdgcn_s_memrealtime() - t0 > 2000000ull) {
                    if (lane == 0) { unsigned expect = 0u; __hip_atomic_compare_exchange_strong(tmo + 1, &expect, code | (unsigned)(u.pm & 0xff), __ATOMIC_RELAXED, __ATOMIC_RELAXED, __HIP_MEMORY_SCOPE_AGENT);
                                     __hip_atomic_store(tmo, 1u, __ATOMIC_RELAXED, __HIP_MEMORY_SCOPE_AGENT); }
                    dead = true; break; }
                __builtin_amdgcn_s_sleep(2);
            }
            __builtin_amdgcn_fence(__ATOMIC_ACQUIRE, "agent");
            if (lane == 0) flag[0] = dead ? 1u : 0u;
        }
        asm volatile("s_waitcnt vmcnt(0) lgkmcnt(0)" ::: "memory"); __builtin_amdgcn_s_barrier(); asm volatile("" ::: "memory");
        const bool bad = flag[0] != 0u;
        if (lane < 32) {
            const unsigned long long* slot = (const unsigned long long*)xbuf + (size_t)(u.pm * BM + row) * 4; float mt[4], m2[4]; float ms = 0.f;
#pragma unroll
            for (int t = 0; t < 4; ++t) { if (t < ntn) { const unsigned long long w = __hip_atomic_load(slot + t, __ATOMIC_RELAXED, __HIP_MEMORY_SCOPE_AGENT); mt[t] = __uint_as_float((unsigned)w); m2[t] = __uint_as_float((unsigned)(w >> 32)); } else { mt[t] = 0.f; m2[t] = 0.f; } ms += mt[t]; }
            const float mean = ms / (float)ntn; float q = 0.f;
#pragma unroll
            for (int t = 0; t < 4; ++t) if (t < ntn) { const float dm = mt[t] - mean; q += m2[t] + 256.0f * dm * dm; }
            S[row] = (f32x2v){mean, 1.0f / sqrtf(q / (256.0f * (float)ntn) + eps)};
        }
        asm volatile("s_waitcnt lgkmcnt(0)" ::: "memory"); __builtin_amdgcn_s_barrier(); asm volatile("" ::: "memory");
        return bad;
    }
};
struct EpiLnRes {
    static constexpr bool PERM = false, AFTER_DRAIN = true;
    const float* base; float* out; int ldc; const float* bias; PanelStats st; unsigned poison;
    __device__ __forceinline__ void fused(f32x4 (&acc)[2][2][4][2], const Unit& u, int wr, int wc, int fr, int fq, PG8_LAS unsigned char* lds, int wid, int lane) const {
        typedef float f32x2v __attribute__((ext_vector_type(2)));
        const PG8_LAS f32x2v* S = (const PG8_LAS f32x2v*)(lds + 8192);
        const int col0 = u.pn * BM + wc * 32 + 4 * fq;
#pragma unroll
        for (int bj = 0; bj < 2; ++bj)
#pragma unroll
            for (int n = 0; n < 2; ++n) { const f32x4 bv = bias ? *(const f32x4*)(bias + col0 + bj * HALF + n * 16) : (f32x4){0.f, 0.f, 0.f, 0.f};
#pragma unroll
                for (int ai = 0; ai < 2; ++ai)
#pragma unroll
                    for (int m = 0; m < 4; ++m) acc[ai][bj][m][n] += bv; }
        f32x4 pre[4][2][2];
#pragma unroll
        for (int m = 0; m < 4; ++m) { const size_t off = (size_t)(u.pm * BM + wr * 64 + m * 16 + fr) * ldc + col0;
#pragma unroll
            for (int bj = 0; bj < 2; ++bj)
#pragma unroll
                for (int n = 0; n < 2; ++n) pre[m][bj][n] = *(const f32x4*)(base + off + bj * HALF + n * 16); }
        const bool bad = st.run(acc, u, wr, wc, fr, fq, lds, wid, lane) || poison != 0u;
        const float qnan = __builtin_nanf("");
#pragma unroll
        for (int ai = 0; ai < 2; ++ai)
#pragma unroll
            for (int m = 0; m < 4; ++m) { const int r = ai * HALF + wr * 64 + m * 16 + fr; const f32x2v sr = S[r]; const size_t off = (size_t)(u.pm * BM + r) * ldc + col0;
#pragma unroll
                for (int bj = 0; bj < 2; ++bj)
#pragma unroll
                    for (int n = 0; n < 2; ++n) { const f32x4 bs = ai == 0 ? pre[m][bj][n] : *(const f32x4*)(base + off + bj * HALF + n * 16); f32x4 o = bs + (acc[ai][bj][m][n] - sr.x) * sr.y;
                        if (bad) o = (f32x4){qnan, qnan, qnan, qnan}; *(f32x4*)(out + off + bj * HALF + n * 16) = o; }
                if (m & 1) asm volatile("" ::: "memory"); }
    }
};
struct EpiLnResLn {
    static constexpr bool PERM = false, AFTER_DRAIN = true;
    const float* base; float* out; bf16_t* xn; int ldc; const float* bias; PanelStats st1, st2; unsigned poison;
    __device__ __forceinline__ void fused(f32x4 (&acc)[2][2][4][2], const Unit& u, int wr, int wc, int fr, int fq, PG8_LAS unsigned char* lds, int wid, int lane) const {
        typedef float f32x2v __attribute__((ext_vector_type(2))); typedef unsigned u32x2v __attribute__((ext_vector_type(2)));
        const PG8_LAS f32x2v* S = (const PG8_LAS f32x2v*)(lds + 8192);
        const int col0 = u.pn * BM + wc * 32 + 4 * fq;
#pragma unroll
        for (int bj = 0; bj < 2; ++bj)
#pragma unroll
            for (int n = 0; n < 2; ++n) { const f32x4 bv = bias ? *(const f32x4*)(bias + col0 + bj * HALF + n * 16) : (f32x4){0.f, 0.f, 0.f, 0.f};
#pragma unroll
                for (int ai = 0; ai < 2; ++ai)
#pragma unroll
                    for (int m = 0; m < 4; ++m) acc[ai][bj][m][n] += bv; }
        bool bad = st1.run(acc, u, wr, wc, fr, fq, lds, wid, lane) || poison != 0u;
        const float qnan = __builtin_nanf("");
#pragma unroll
        for (int ai = 0; ai < 2; ++ai)
#pragma unroll
            for (int m = 0; m < 4; ++m) { const int r = ai * HALF + wr * 64 + m * 16 + fr; const f32x2v sr = S[r]; const size_t off = (size_t)(u.pm * BM + r) * ldc + col0;
#pragma unroll
                for (int bj = 0; bj < 2; ++bj)
#pragma unroll
                    for (int n = 0; n < 2; ++n) { const f32x4 bs = *(const f32x4*)(base + off + bj * HALF + n * 16); acc[ai][bj][m][n] = bs + (acc[ai][bj][m][n] - sr.x) * sr.y; }
                asm volatile("" : "+v"(acc[ai][0][m][0]), "+v"(acc[ai][0][m][1]), "+v"(acc[ai][1][m][0]), "+v"(acc[ai][1][m][1]));
                if (m & 1) asm volatile("" ::: "memory"); }
        const bool bad1 = bad;
        bad = st2.run(acc, u, wr, wc, fr, fq, lds, wid, lane) || bad;
#pragma unroll
        for (int ai = 0; ai < 2; ++ai)
#pragma unroll
            for (int m = 0; m < 4; ++m) { const int r = ai * HALF + wr * 64 + m * 16 + fr; const f32x2v sr = S[r]; const size_t off = (size_t)(u.pm * BM + r) * ldc + col0;
#pragma unroll
                for (int bj = 0; bj < 2; ++bj)
#pragma unroll
                    for (int n = 0; n < 2; ++n) { const f32x4 x1 = acc[ai][bj][m][n]; *(f32x4*)(out + off + bj * HALF + n * 16) = bad1 ? (f32x4){qnan, qnan, qnan, qnan} : x1;
                        const f32x4 o = (x1 - sr.x) * sr.y; u32x2v w; w.x = cvt_pk_bf16(o[0], o[1]); w.y = cvt_pk_bf16(o[2], o[3]);
                        if (bad) { w.x = 0x7fc07fc0u; w.y = 0x7fc07fc0u; } *(u32x2v*)(xn + off + bj * HALF + n * 16) = w; }
                asm volatile("" ::: "memory"); }
    }
};

template <class Epi, class Sched, bool ALIGN_EPI = false, bool SP2 = false>
__device__ __forceinline__ void gemm_phase(PG8_LAS unsigned char* lds, const Gemm g, const Sched& S, const Epi& E) {
    int tid_ = threadIdx.x; asm volatile("" : "+v"(tid_));
    const int tid = tid_, wid = __builtin_amdgcn_readfirstlane(tid >> 6), lane = tid & 63, wr = wid >> 2, wc = wid & 3, fr = lane & 15, fq = lane >> 4;
    const int K = g.K, nt = K / BK;
    unsigned voffA[2], voffB[2];
#pragma unroll
    for (int i = 0; i < 2; ++i) { int R, C; stage_rc(tid * 16 + i * 8192, R, C); const int Rb = Epi::PERM ? ((R & ~31) + perm32(R & 31)) : R;
        voffA[i] = (unsigned)(R * K + C) * 2u; voffB[i] = (unsigned)(Rb * K + C) * 2u; }
    const size_t kstep = (size_t)(BK * 2);
    const size_t hstep = (size_t)HALF * K * 2;
    const size_t tstep = 2 * hstep;
    const unsigned ldsw = (unsigned)wid * 1024u;
    const int aoff = lds_byte(wr * 64 + fr, fq * 8), boff = lds_byte(wc * 32 + fr, fq * 8);
#define PG8_SA(b, h) (((b) * 2 + (h)) * HTB)
#define PG8_SB(b, h) ((4 + (b) * 2 + (h)) * HTB)
#define PG8_STAGE(bufoff, gbase, voff) do { _Pragma("unroll") for (int _i = 0; _i < 2; ++_i) \
        __builtin_amdgcn_global_load_lds((const unsigned*)((const char*)(gbase) + (voff)[_i]), (PG8_LAS unsigned*)(lds + (bufoff) + ldsw + _i * 8192), 16, 0, 0); } while (0)
#define PG8_LDA(dst, b, h) do { _Pragma("unroll") for (int m = 0; m < 4; ++m) _Pragma("unroll") for (int k = 0; k < 2; ++k) dst[m][k] = *(const PG8_LAS bf16x8*)(lds + PG8_SA(b, h) + aoff + m * 2048 + k * 1024); } while (0)
#define PG8_LDB(dst, b, h) do { _Pragma("unroll") for (int n = 0; n < 2; ++n) _Pragma("unroll") for (int k = 0; k < 2; ++k) dst[n][k] = *(const PG8_LAS bf16x8*)(lds + PG8_SB(b, h) + boff + n * 2048 + k * 1024); } while (0)
#define PG8_MMA(ai, bj, At, Bt) do { __builtin_amdgcn_s_setprio(1); _Pragma("unroll") for (int m = 0; m < 4; ++m) _Pragma("unroll") for (int n = 0; n < 2; ++n) _Pragma("unroll") for (int k = 0; k < 2; ++k) \
        acc[ai][bj][m][n] = __builtin_amdgcn_mfma_f32_16x16x32_bf16(Bt[n][k], At[m][k], acc[ai][bj][m][n], 0, 0, 0); __builtin_amdgcn_s_setprio(0); } while (0)
#define PG8_WAIT_V(n) asm volatile("s_waitcnt vmcnt(" #n ")" ::: "memory")
#define PG8_WAIT_L(n) asm volatile("s_waitcnt lgkmcnt(" #n ")" ::: "memory")
#define PG8_BAR __builtin_amdgcn_s_barrier()
#define PG8_SCHED __builtin_amdgcn_sched_barrier(0)
    Unit cur, nxt; int ui = 0;
    if (!S.next(0, cur)) return;
    f32x4 acc[2][2][4][2];
#pragma unroll
    for (int a = 0; a < 2; ++a)
#pragma unroll
        for (int b = 0; b < 2; ++b)
#pragma unroll
            for (int m = 0; m < 4; ++m)
#pragma unroll
                for (int n = 0; n < 2; ++n) acc[a][b][m][n] = (f32x4){0.f, 0.f, 0.f, 0.f};
    bf16x8 At[4][2], B0[2][2], B1[2][2];
    const char* cA = (const char*)g.A + (size_t)cur.pm * tstep; const char* cB = (const char*)g.Bt + (size_t)cur.pn * tstep;
    S.a_ready(cur);
    if constexpr (SP2) {
        PG8_STAGE(PG8_SB(0, 0), cB, voffB); PG8_STAGE(PG8_SB(0, 1), cB + hstep, voffB); PG8_STAGE(PG8_SA(0, 0), cA, voffA); PG8_STAGE(PG8_SA(0, 1), cA + hstep, voffA);
        if (wr == 1) PG8_BAR;
        PG8_WAIT_V(2); PG8_BAR;
        PG8_STAGE(PG8_SB(1, 0), cB + kstep, voffB); PG8_STAGE(PG8_SA(1, 0), cA + kstep, voffA); PG8_STAGE(PG8_SB(1, 1), cB + hstep + kstep, voffB);
        PG8_WAIT_V(6); PG8_BAR;
    } else {
        PG8_STAGE(PG8_SB(0, 0), cB, voffB); PG8_STAGE(PG8_SA(0, 0), cA, voffA); PG8_STAGE(PG8_SB(0, 1), cB + hstep, voffB); PG8_STAGE(PG8_SA(0, 1), cA + hstep, voffA);
        if (wr == 1) PG8_BAR;
        PG8_WAIT_V(4); PG8_BAR;
        PG8_STAGE(PG8_SB(1, 0), cB + kstep, voffB); PG8_STAGE(PG8_SA(1, 0), cA + kstep, voffA); PG8_STAGE(PG8_SB(1, 1), cB + hstep + kstep, voffB);
        PG8_WAIT_V(6); PG8_BAR;
    }
    for (;;) {
        const bool has_next = S.next(ui + 1, nxt);
        const char* nA = has_next ? (const char*)g.A + (size_t)nxt.pm * tstep : cA; const char* nB = has_next ? (const char*)g.Bt + (size_t)nxt.pn * tstep : cB;
        for (int t = 0; t < nt; t += 2) {
            const bool last = (t == nt - 2);
            const char* a1 = cA + (size_t)(t + 1) * kstep;
            const char* a2 = last ? nA : cA + (size_t)(t + 2) * kstep; const char* b2 = last ? nB : cB + (size_t)(t + 2) * kstep;
            const char* a3 = a2 + kstep; const char* b3 = b2 + kstep;
            if (last && has_next) S.a_ready(nxt);
            if constexpr (SP2) {
            PG8_LDB(B0, 0, 0); PG8_LDB(B1, 0, 1); PG8_SCHED; PG8_LDA(At, 0, 0); PG8_STAGE(PG8_SA(1, 1), a1 + hstep, voffA);
            PG8_WAIT_V(8); PG8_WAIT_L(0); PG8_BAR; PG8_MMA(0, 0, At, B0); PG8_MMA(0, 1, At, B1); PG8_BAR; PG8_SCHED;
            PG8_LDA(At, 0, 1); PG8_STAGE(PG8_SB(0, 0), b2, voffB); PG8_STAGE(PG8_SB(0, 1), b2 + hstep, voffB); PG8_STAGE(PG8_SA(0, 0), a2, voffA);
            PG8_WAIT_V(8); PG8_WAIT_L(0); PG8_BAR; PG8_MMA(1, 0, At, B0); PG8_MMA(1, 1, At, B1); PG8_BAR; PG8_SCHED;
            PG8_LDB(B0, 1, 0); PG8_LDB(B1, 1, 1); PG8_SCHED; PG8_LDA(At, 1, 0); PG8_STAGE(PG8_SA(0, 1), a2 + hstep, voffA);
            PG8_WAIT_V(8); PG8_WAIT_L(0); PG8_BAR; PG8_MMA(0, 0, At, B0); PG8_MMA(0, 1, At, B1); PG8_BAR; PG8_SCHED;
            PG8_LDA(At, 1, 1); PG8_STAGE(PG8_SB(1, 0), b3, voffB); PG8_STAGE(PG8_SB(1, 1), b3 + hstep, voffB); PG8_STAGE(PG8_SA(1, 0), a3, voffA);
            PG8_WAIT_V(8); PG8_WAIT_L(0); PG8_BAR; PG8_MMA(1, 0, At, B0); PG8_MMA(1, 1, At, B1); PG8_BAR; PG8_SCHED;
            } else {
            PG8_LDB(B0, 0, 0); PG8_SCHED; PG8_LDA(At, 0, 0); PG8_STAGE(PG8_SA(1, 1), a1 + hstep, voffA);
            PG8_WAIT_L(8); PG8_BAR; PG8_WAIT_L(0); PG8_MMA(0, 0, At, B0); PG8_BAR; PG8_SCHED;
            PG8_LDB(B1, 0, 1); PG8_STAGE(PG8_SB(0, 0), b2, voffB);
            PG8_BAR; PG8_WAIT_L(0); PG8_MMA(0, 1, At, B1); PG8_BAR;
            PG8_LDA(At, 0, 1); PG8_STAGE(PG8_SA(0, 0), a2, voffA);
            PG8_BAR; PG8_WAIT_L(0); PG8_MMA(1, 0, At, B0); PG8_BAR; PG8_SCHED;
            PG8_STAGE(PG8_SB(0, 1), b2 + hstep, voffB);
            PG8_WAIT_V(6); PG8_BAR; PG8_MMA(1, 1, At, B1); PG8_BAR;
            PG8_LDB(B0, 1, 0); PG8_SCHED; PG8_LDA(At, 1, 0); PG8_STAGE(PG8_SA(0, 1), a2 + hstep, voffA);
            PG8_WAIT_L(8); PG8_BAR; PG8_WAIT_L(0); PG8_MMA(0, 0, At, B0); PG8_BAR; PG8_SCHED;
            PG8_LDB(B1, 1, 1); PG8_STAGE(PG8_SB(1, 0), b3, voffB);
            PG8_BAR; PG8_WAIT_L(0); PG8_MMA(0, 1, At, B1); PG8_BAR;
            PG8_LDA(At, 1, 1); PG8_STAGE(PG8_SA(1, 0), a3, voffA);
            PG8_BAR; PG8_WAIT_L(0); PG8_MMA(1, 0, At, B0); PG8_BAR; PG8_SCHED;
            PG8_STAGE(PG8_SB(1, 1), b3 + hstep, voffB);
            PG8_WAIT_V(6); PG8_BAR; PG8_MMA(1, 1, At, B1); PG8_BAR;
            }
        }
        if constexpr (ALIGN_EPI) { if (wr == 0) PG8_BAR; }
        if constexpr (!Epi::AFTER_DRAIN) { E(acc, cur, wr, wc, fr, fq); S.done(cur); }
        if (!has_next) break;
#pragma unroll
        for (int a = 0; a < 2; ++a)
#pragma unroll
            for (int b = 0; b < 2; ++b)
#pragma unroll
                for (int m = 0; m < 4; ++m)
#pragma unroll
                    for (int n = 0; n < 2; ++n) acc[a][b][m][n] = (f32x4){0.f, 0.f, 0.f, 0.f};
        cur = nxt; cA = nA; cB = nB; ++ui;
        if constexpr (ALIGN_EPI) { if (wr == 1) PG8_BAR; }
    }
    PG8_WAIT_V(0);
    if constexpr (!ALIGN_EPI) { if (wr == 0) PG8_BAR; }
    PG8_BAR;
    if constexpr (Epi::AFTER_DRAIN) { E.fused(acc, cur, wr, wc, fr, fq, lds, wid, lane); S.done(cur); }
#undef PG8_SA
#undef PG8_SB
#undef PG8_STAGE
#undef PG8_LDA
#undef PG8_LDB
#undef PG8_MMA
#undef PG8_WAIT_V
#undef PG8_WAIT_L
#undef PG8_BAR
#undef PG8_SCHED
}
}
#ifndef PG8_SP2
#define PG8_SP2 true
#endif
#ifndef PG8_ALIGN
#define PG8_ALIGN true
#endif
namespace pg8 {
struct Unit2 { int pm, pn, bk, r0, cnt; };
struct Gemm2 { int K, lda, ldb; };
template <class Epi, class Sched, bool GATHER, bool ALIGN_EPI>
__device__ __forceinline__ void gemm_phase2(PG8_LAS unsigned char* lds, const Gemm2 g, const Sched& S, const Epi& E) {
    int tid_ = threadIdx.x; asm volatile("" : "+v"(tid_));
    const int tid = tid_, wid = __builtin_amdgcn_readfirstlane(tid >> 6), lane = tid & 63, wr = wid >> 2, wc = wid & 3, fr = lane & 15, fq = lane >> 4;
    const int K = g.K, nt = K / BK, jt = nt / 2;
    unsigned voffB[2];
#pragma unroll
    for (int i = 0; i < 2; ++i) { int R, C; stage_rc(tid * 16 + i * 8192, R, C); const int Rb = Epi::PERM ? ((R & ~31) + perm32(R & 31)) : R; voffB[i] = (unsigned)(Rb * g.ldb + C) * 2u; }
    const size_t kstep = (size_t)(BK * 2);
    const size_t hstepB = (size_t)HALF * g.ldb * 2;
    const unsigned ldsw = (unsigned)wid * 1024u;
    const int aoff = lds_byte(wr * 64 + fr, fq * 8), boff = lds_byte(wc * 32 + fr, fq * 8);
#define PG8_SA(b, h) (((b) * 2 + (h)) * HTB)
#define PG8_SB(b, h) ((4 + (b) * 2 + (h)) * HTB)
#define PG8_STAGE(bufoff, gbase, voff) do { _Pragma("unroll") for (int _i = 0; _i < 2; ++_i) \
        __builtin_amdgcn_global_load_lds((const unsigned*)((const char*)(gbase) + (voff)[_i]), (PG8_LAS unsigned*)(lds + (bufoff) + ldsw + _i * 8192), 16, 0, 0); } while (0)
#define PG8_LDA(dst, b, h) do { _Pragma("unroll") for (int m = 0; m < 4; ++m) _Pragma("unroll") for (int k = 0; k < 2; ++k) dst[m][k] = *(const PG8_LAS bf16x8*)(lds + PG8_SA(b, h) + aoff + m * 2048 + k * 1024); } while (0)
#define PG8_LDB(dst, b, h) do { _Pragma("unroll") for (int n = 0; n < 2; ++n) _Pragma("unroll") for (int k = 0; k < 2; ++k) dst[n][k] = *(const PG8_LAS bf16x8*)(lds + PG8_SB(b, h) + boff + n * 2048 + k * 1024); } while (0)
#define PG8_MMA(ai, bj, At, Bt) do { __builtin_amdgcn_s_setprio(1); _Pragma("unroll") for (int m = 0; m < 4; ++m) _Pragma("unroll") for (int n = 0; n < 2; ++n) _Pragma("unroll") for (int k = 0; k < 2; ++k) \
        acc[ai][bj][m][n] = __builtin_amdgcn_mfma_f32_16x16x32_bf16(Bt[n][k], At[m][k], acc[ai][bj][m][n], 0, 0, 0); __builtin_amdgcn_s_setprio(0); } while (0)
#define PG8_WAIT_V(n) asm volatile("s_waitcnt vmcnt(" #n ")" ::: "memory")
#define PG8_WAIT_L(n) asm volatile("s_waitcnt lgkmcnt(" #n ")" ::: "memory")
#define PG8_BAR __builtin_amdgcn_s_barrier()
#define PG8_SCHED __builtin_amdgcn_sched_barrier(0)
#define PG8_AOFF(dst0, dst1, u) do { _Pragma("unroll") for (int _i = 0; _i < 2; ++_i) { int R_, C_; stage_rc(tid * 16 + _i * 8192, R_, C_); \
        if (GATHER) { dst0[_i] = (unsigned)(S.a_row(u, R_) * g.lda + C_) * 2u; dst1[_i] = (unsigned)(S.a_row(u, HALF + R_) * g.lda + C_) * 2u; } \
        else { dst0[_i] = (unsigned)(R_ * g.lda + C_) * 2u; dst1[_i] = (unsigned)((HALF + R_) * g.lda + C_) * 2u; } } } while (0)
    Unit2 cur, nxt; int ui = 0;
    if (!S.next(0, cur)) return;
    f32x4 acc[2][2][4][2];
#pragma unroll
    for (int a = 0; a < 2; ++a)
#pragma unroll
        for (int b = 0; b < 2; ++b)
#pragma unroll
            for (int m = 0; m < 4; ++m)
#pragma unroll
                for (int n = 0; n < 2; ++n) acc[a][b][m][n] = (f32x4){0.f, 0.f, 0.f, 0.f};
    bf16x8 At[4][2], B0[2][2], B1[2][2];
    unsigned vA0[2], vA1[2], nA0[2], nA1[2];
    PG8_AOFF(vA0, vA1, cur);
    const char* cA = S.a_base(cur); const char* cB = S.b_base(cur); long cJ = S.b_jump(cur);
    PG8_STAGE(PG8_SB(0, 0), cB, voffB); PG8_STAGE(PG8_SB(0, 1), cB + hstepB, voffB); PG8_STAGE(PG8_SA(0, 0), cA, vA0); PG8_STAGE(PG8_SA(0, 1), cA, vA1);
    if (wr == 1) PG8_BAR;
    PG8_WAIT_V(2); PG8_BAR;
    PG8_STAGE(PG8_SB(1, 0), cB + kstep, voffB); PG8_STAGE(PG8_SA(1, 0), cA + kstep, vA0); PG8_STAGE(PG8_SB(1, 1), cB + hstepB + kstep, voffB);
    PG8_WAIT_V(6); PG8_BAR;
    for (;;) {
        const bool has_next = S.next(ui + 1, nxt);
        const char* nA = cA; const char* nB = cB;
        if (has_next) { nA = S.a_base(nxt); nB = S.b_base(nxt); }
        if (GATHER && has_next) { PG8_AOFF(nA0, nA1, nxt); }
        else {
#pragma unroll
            for (int i = 0; i < 2; ++i) { nA0[i] = vA0[i]; nA1[i] = vA1[i]; } }
        for (int t = 0; t < nt; t += 2) {
            const bool last = (t == nt - 2);
            const char* a1 = cA + (size_t)(t + 1) * kstep;
            const char* a2 = last ? nA : cA + (size_t)(t + 2) * kstep;
            const char* b2 = last ? nB : cB + (size_t)(t + 2) * kstep + ((t + 2) >= jt ? cJ : 0l);
            const char* a3 = a2 + kstep; const char* b3 = b2 + kstep;
            unsigned w0[2], w1[2];
#pragma unroll
            for (int i = 0; i < 2; ++i) { w0[i] = last ? nA0[i] : vA0[i]; w1[i] = last ? nA1[i] : vA1[i]; }
            PG8_LDB(B0, 0, 0); PG8_LDB(B1, 0, 1); PG8_SCHED; PG8_LDA(At, 0, 0); PG8_STAGE(PG8_SA(1, 1), a1, vA1);
            PG8_WAIT_V(8); PG8_WAIT_L(0); PG8_BAR; PG8_MMA(0, 0, At, B0); PG8_MMA(0, 1, At, B1); PG8_BAR; PG8_SCHED;
            PG8_LDA(At, 0, 1); PG8_STAGE(PG8_SB(0, 0), b2, voffB); PG8_STAGE(PG8_SB(0, 1), b2 + hstepB, voffB); PG8_STAGE(PG8_SA(0, 0), a2, w0);
            PG8_WAIT_V(8); PG8_WAIT_L(0); PG8_BAR; PG8_MMA(1, 0, At, B0); PG8_MMA(1, 1, At, B1); PG8_BAR; PG8_SCHED;
            PG8_LDB(B0, 1, 0); PG8_LDB(B1, 1, 1); PG8_SCHED; PG8_LDA(At, 1, 0); PG8_STAGE(PG8_SA(0, 1), a2, w1);
            PG8_WAIT_V(8); PG8_WAIT_L(0); PG8_BAR; PG8_MMA(0, 0, At, B0); PG8_MMA(0, 1, At, B1); PG8_BAR; PG8_SCHED;
            PG8_LDA(At, 1, 1); PG8_STAGE(PG8_SB(1, 0), b3, voffB); PG8_STAGE(PG8_SB(1, 1), b3 + hstepB, voffB); PG8_STAGE(PG8_SA(1, 0), a3, w0);
            PG8_WAIT_V(8); PG8_WAIT_L(0); PG8_BAR; PG8_MMA(1, 0, At, B0); PG8_MMA(1, 1, At, B1); PG8_BAR; PG8_SCHED;
        }
        if constexpr (ALIGN_EPI) { if (wr == 0) PG8_BAR; }
        E(acc, cur, wr, wc, fr, fq);
        if (!has_next) break;
#pragma unroll
        for (int a = 0; a < 2; ++a)
#pragma unroll
            for (int b = 0; b < 2; ++b)
#pragma unroll
                for (int m = 0; m < 4; ++m)
#pragma unroll
                    for (int n = 0; n < 2; ++n) acc[a][b][m][n] = (f32x4){0.f, 0.f, 0.f, 0.f};
        cur = nxt; cA = nA; cB = nB; cJ = S.b_jump(cur); ++ui;
#pragma unroll
        for (int i = 0; i < 2; ++i) { vA0[i] = nA0[i]; vA1[i] = nA1[i]; }
        if constexpr (ALIGN_EPI) { if (wr == 1) PG8_BAR; }
    }
    PG8_WAIT_V(0);
    if constexpr (!ALIGN_EPI) { if (wr == 0) PG8_BAR; }
    PG8_BAR;
#undef PG8_AOFF
#undef PG8_SA
#undef PG8_SB
#undef PG8_STAGE
#undef PG8_LDA
#undef PG8_LDB
#undef PG8_MMA
#undef PG8_WAIT_V
#undef PG8_WAIT_L
#undef PG8_BAR
#undef PG8_SCHED
}
}
#include <hip/hip_bf16.h>
#include <cmath>
namespace attn_body {
using bf16=__hip_bfloat16;
using bf16x8=__attribute__((ext_vector_type(8)))short;
using s16x4=__attribute__((ext_vector_type(4)))short;
using f32x16=__attribute__((ext_vector_type(16)))float;
using u32x4=__attribute__((ext_vector_type(4)))unsigned;
constexpr int BATCH=4,NHEAD=8,SEQ=4096,D=64,DM=3072,DMO=1024;
constexpr int NW=8,QBLK=32,QB=QBLK*NW,KVBLK=64,NQB=SEQ/QB;
constexpr int ATTN_PITCH=DM, ATTN_UNIT_ROWS=QB;
__device__ __forceinline__ int crow(int r,int hi){return (r&3)+8*(r>>2)+4*hi;}
#define SBAR() __builtin_amdgcn_sched_barrier(0)
__device__ __forceinline__ void bmask(f32x16&p0,f32x16&p1,unsigned lo32,unsigned hi32,int hi){
  const unsigned a=lo32>>(4*hi), b=hi32>>(4*hi);
  #pragma unroll
  for(int r=0;r<16;++r){const unsigned bit=1u<<((r&3)+8*(r>>2)); if(!(a&bit))p0[r]=-1024.0f; if(!(b&bit))p1[r]=-1024.0f;}
}
typedef unsigned u32x2m __attribute__((ext_vector_type(2)));
__device__ __forceinline__ void mload(u32x2m&dst,const unsigned long long*p){ asm volatile("global_load_dwordx2 %0, %1, off":"=v"(dst):"v"(p):"memory"); }

constexpr int NSLOT=3, SLOTB=8192;
constexpr int LDS_K=0, LDS_V=NSLOT*SLOTB, LDS_WS=2*NSLOT*SLOTB, LDS_OST=LDS_WS+NW*64*4, LDS_BYTES=LDS_OST+NW*4096;
constexpr float C2=0.125f*1.4426950408889634f;
__device__ __forceinline__ void glds16(const void*gsrc,unsigned lds_dst){unsigned keep;
  asm volatile("s_mov_b32 %0, m0\n\ts_mov_b32 m0, %2\n\ts_nop 0\n\tglobal_load_lds_dwordx4 %1, off\n\ts_mov_b32 m0, %0":"=&s"(keep):"v"(gsrc),"s"(lds_dst):"memory");}
__device__ __forceinline__ float max3f(float a,float b,float c){float r;asm("v_max3_f32 %0, %1, %2, %3":"=v"(r):"v"(a),"v"(b),"v"(c));return r;}
__device__ __forceinline__ float max2f(float a,float b){float r;asm("v_max_f32_e32 %0, %1, %2":"=v"(r):"v"(a),"v"(b));return r;}
__device__ __forceinline__ float fadd_s(float a,float b){float r;asm("v_add_f32_e32 %0, %1, %2":"=v"(r):"v"(a),"v"(b));return r;}
__device__ __forceinline__ float fsub_s(float a,float b){float r;asm("v_sub_f32_e32 %0, %1, %2":"=v"(r):"v"(a),"v"(b));return r;}
typedef float f32x2_t __attribute__((ext_vector_type(2))); typedef __bf16 bf16x2_t __attribute__((ext_vector_type(2)));
__device__ __forceinline__ unsigned cvtpk_s(float lo,float hi){f32x2_t v={lo,hi};bf16x2_t b=__builtin_convertvector(v,bf16x2_t);return __builtin_bit_cast(unsigned,b);}
#define WAIT_BAR(N) asm volatile("s_waitcnt vmcnt(" #N ") lgkmcnt(0)\n\ts_barrier":::"memory")

__device__ __forceinline__ void qkt(f32x16&p0,f32x16&p1,const char*Kslot,const bf16x8*qr,const f32x16&negm,int r32,int hi){
  const char*kb=Kslot+hi*1024+r32*16;
  #pragma unroll
  for(int d0=0;d0<4;++d0){
    const bf16x8 b0=*reinterpret_cast<const bf16x8*>(kb+d0*2048);
    const bf16x8 b1=*reinterpret_cast<const bf16x8*>(kb+d0*2048+512);
    if(d0==0){p0=__builtin_amdgcn_mfma_f32_32x32x16_bf16(b0,qr[0],negm,0,0,0);p1=__builtin_amdgcn_mfma_f32_32x32x16_bf16(b1,qr[0],negm,0,0,0);}
    else{p0=__builtin_amdgcn_mfma_f32_32x32x16_bf16(b0,qr[d0],p0,0,0,0);p1=__builtin_amdgcn_mfma_f32_32x32x16_bf16(b1,qr[d0],p1,0,0,0);}}
}
typedef __attribute__((address_space(3))) const char* lds_cptr;
typedef short v4i16_t __attribute__((ext_vector_type(4)));
__device__ __forceinline__ void kload8(bf16x8*kf,lds_cptr kp){
  kf[0]=*(const __attribute__((address_space(3))) bf16x8*)(kp);      kf[1]=*(const __attribute__((address_space(3))) bf16x8*)(kp+512);
  kf[2]=*(const __attribute__((address_space(3))) bf16x8*)(kp+2048); kf[3]=*(const __attribute__((address_space(3))) bf16x8*)(kp+2560);
  kf[4]=*(const __attribute__((address_space(3))) bf16x8*)(kp+4096); kf[5]=*(const __attribute__((address_space(3))) bf16x8*)(kp+4608);
  kf[6]=*(const __attribute__((address_space(3))) bf16x8*)(kp+6144); kf[7]=*(const __attribute__((address_space(3))) bf16x8*)(kp+6656);
}
__device__ __forceinline__ void kload2(bf16x8*kf,lds_cptr kp,int j){ kf[2*j]=*(const __attribute__((address_space(3))) bf16x8*)(kp+j*2048); kf[2*j+1]=*(const __attribute__((address_space(3))) bf16x8*)(kp+j*2048+512); }
__device__ __forceinline__ s16x4 vtr(lds_cptr p){ return __builtin_bit_cast(s16x4,__builtin_amdgcn_ds_read_tr16_b64_v4i16((__attribute__((address_space(3))) v4i16_t*)p)); }
__device__ __forceinline__ float rowmax(const f32x16&p0,const f32x16&p1){
  float a=max3f(p0[0],p0[1],p1[0]),b=max3f(p0[2],p0[3],p1[1]);a=max3f(a,p1[2],p1[3]);
  #pragma unroll
  for(int r=4;r<16;r+=4){a=max3f(a,p0[r],p0[r+1]);b=max3f(b,p0[r+2],p0[r+3]);a=max3f(a,p1[r],p1[r+1]);b=max3f(b,p1[r+2],p1[r+3]);}
  const float m=max2f(a,b);
  auto rr=__builtin_amdgcn_permlane32_swap(__float_as_uint(m),__float_as_uint(m),false,false);
  return max2f(__uint_as_float(rr[0]),__uint_as_float(rr[1]));
}
__device__ __forceinline__ void pv(f32x16*o,int vb,bf16x8 pa0,bf16x8 pa1,bf16x8 pa2,bf16x8 pa3){
  #pragma unroll
  for(int d0=0;d0<2;++d0){s16x4 lo[4],hi[4];
    #pragma unroll
    for(int ks=0;ks<4;++ks){
      asm volatile("ds_read_b64_tr_b16 %0,%1 offset:%c2":"=&v"(lo[ks]):"v"(vb),"i"(d0*4096+ks*1024):"memory");
      asm volatile("ds_read_b64_tr_b16 %0,%1 offset:%c2":"=&v"(hi[ks]):"v"(vb),"i"(d0*4096+ks*1024+512):"memory");}
    asm volatile("s_waitcnt lgkmcnt(0)":::"memory");SBAR();
    #define PK(k) (bf16x8){lo[k][0],lo[k][1],lo[k][2],lo[k][3],hi[k][0],hi[k][1],hi[k][2],hi[k][3]}
    o[d0]=__builtin_amdgcn_mfma_f32_32x32x16_bf16(pa0,PK(0),o[d0],0,0,0);
    o[d0]=__builtin_amdgcn_mfma_f32_32x32x16_bf16(pa1,PK(1),o[d0],0,0,0);
    o[d0]=__builtin_amdgcn_mfma_f32_32x32x16_bf16(pa2,PK(2),o[d0],0,0,0);
    o[d0]=__builtin_amdgcn_mfma_f32_32x32x16_bf16(pa3,PK(3),o[d0],0,0,0);
    #undef PK
  }
}

#ifndef ATTN_STORE16
#define ATTN_STORE16(p,v) (*(u32x4*)(p)=(v))
#endif
template<int THRL> __device__ __forceinline__ void attn_unit(int b,int h,int qb,const bf16*Q,const bf16*__restrict__ K,const bf16*__restrict__ V,bf16*O,const unsigned long long*MK,char*shm){
  int tid_=threadIdx.x; asm volatile("":"+v"(tid_));
  const int tid=tid_,lane=tid&63,r32=lane&31,hi=lane>>5; const int wid=__builtin_amdgcn_readfirstlane(tid>>6);
  const long rowbase=(long)b*SEQ; const int q0=qb*QB;
  const bf16*Qw=Q+(rowbase+q0+wid*QBLK)*DM+h*D;
  const bf16*Kh=K+rowbase*DM+h*D,*Vh=V+rowbase*DM+h*D;
  const unsigned lds0=(unsigned)(uintptr_t)shm;
  float*wsf=(float*)(shm+LDS_WS)+wid*64;
  const bf16*ksrc=Kh+(long)lane*DM+wid*8;
  const bf16*vsrc=Vh+(long)(16*(wid&3)+(lane>>2))*DM+(wid>>2)*32+(lane&3)*8;
  const unsigned kdst=lds0+LDS_K+wid*1024, vdst=lds0+LDS_V+wid*1024;
  #define DMA_K(t,slot) glds16(ksrc+(long)(t)*KVBLK*DM,(unsigned)__builtin_amdgcn_readfirstlane(kdst+(slot)))
  #define DMA_V(t,slot) glds16(vsrc+(long)(t)*KVBLK*DM,(unsigned)__builtin_amdgcn_readfirstlane(vdst+(slot)))
  const int vb0=(int)(lds0+LDS_V)+((lane>>4)&1)*32+(lane&3)*8+(4*hi+((lane&15)>>2))*64;
  const char*Kbase=shm+LDS_K; bf16x8 kf[8];
  const lds_cptr shm3=(lds_cptr)shm; const lds_cptr kp0=shm3+LDS_K+hi*1024+r32*16; const lds_cptr vp0=shm3+LDS_V+((lane>>4)&1)*32+(lane&3)*8+(4*hi+((lane&15)>>2))*64;
  const int NT=(q0+QB)/KVBLK;
  const unsigned long long*mrow=MK+((rowbase+q0+wid*QBLK+r32)<<6);
  u32x2m mE,mO; mload(mE,mrow); mload(mO,mrow+1);
  DMA_K(0,0);DMA_V(0,0);DMA_K(1,SLOTB);
  bf16x8 qr[4];
  #pragma unroll
  for(int d0=0;d0<4;++d0)qr[d0]=*reinterpret_cast<const bf16x8*>(&Qw[(long)r32*DM+d0*16+hi*8]);
  float mhat=0.f,l_reg=0.f;f32x16 o[2];o[0]=f32x16{};o[1]=f32x16{};f32x16 negm=f32x16{};asm volatile("":"+v"(negm));
  const int qrel=wid*QBLK+r32;
  #define CMASK(P0,P1,M) do{ asm volatile("":"+v"(M)); bmask(P0,P1,M[0],M[1],hi); }while(0)
  bool resc=false;
  #define START(P0,P1) do{ const float rm=rowmax(P0,P1); resc=false; \
    { const float dl=rm; mhat=fadd_s(mhat,dl); \
      _Pragma("unroll") for(int r=0;r<16;++r){P0[r]=fsub_s(P0[r],dl);P1[r]=fsub_s(P1[r],dl);} \
      _Pragma("unroll") for(int r=0;r<16;++r)negm[r]=-mhat; asm volatile("":"+v"(negm)); } \
    _Pragma("unroll") for(int r=0;r<16;++r)P0[r]=__builtin_amdgcn_exp2f(P0[r]); }while(0)
  #define RESC() do{ if(resc){ asm volatile("s_waitcnt lgkmcnt(0)":::"memory"); \
      _Pragma("unroll") for(int d_=0;d_<2;++d_) _Pragma("unroll") for(int r=0;r<16;++r)o[d_][r]*=wsf[crow(r,hi)]; } }while(0)
  f32x16 pA0,pA1,pB0,pB1;
  int sl_prev=0,sl_cur=0,sl_next=SLOTB;
  #define ROT() do{sl_prev=sl_cur;sl_cur=sl_next;sl_next=(sl_next==(NSLOT-1)*SLOTB)?0:sl_next+SLOTB;}while(0)
  DMA_K(2,2*SLOTB);
  WAIT_BAR(3);
  qkt(pA0,pA1,Kbase,qr,negm,r32,hi);asm volatile("s_nop 15\n\ts_nop 7":"+v"(pA0),"+v"(pA1));CMASK(pA0,pA1,mE);
  START(pA0,pA1);
  _Pragma("unroll") for(int r=0;r<16;++r)pA1[r]=__builtin_amdgcn_exp2f(pA1[r]);
  WAIT_BAR(0);
  DMA_K(3,0);DMA_V(1,SLOTB);
  ROT();
  kload8(kf,kp0+sl_cur);
  WAIT_BAR(2);
  s16x4 vlo[8],vhi[8]; u32x4 pw0,pw1,pw2,pw3;
  #define PKW(P,B) cvtpk_s(P[B],P[B+1])
  #define PAF(k) __builtin_bit_cast(bf16x8,pw##k)
  #define VFR(i) (bf16x8){vlo[i][0],vlo[i][1],vlo[i][2],vlo[i][3],vhi[i][0],vhi[i][1],vhi[i][2],vhi[i][3]}
  #define PIN(x) asm volatile("":"+v"(x))
  #define MX3(a,b,c) __builtin_fmaxf(__builtin_fmaxf((a),(b)),(c))
  #define GAPA(MF,A0,A1,A2,A3,W0,W1,PW) do{ MF; sacc+=A0; sacc+=A1; sacc+=A2; sacc+=A3; PIN(sacc); W0; W1; PIN(PW); SBAR(); }while(0)
  #define EX(v) __builtin_amdgcn_exp2f(v)
  #define GAPB(MF,X,B) do{ MF; X[B]=EX(X[B]); X[B+1]=EX(X[B+1]); X[B+2]=EX(X[B+2]); X[B+3]=EX(X[B+3]); PIN(X); SBAR(); }while(0)
  #define VRD(i) do{ vlo[i]=vtr(vp_+(((i)>>2)*4096+((i)&3)*1024)); vhi[i]=vtr(vp_+(((i)>>2)*4096+((i)&3)*1024+512)); }while(0)
  #define KRD(G,j) do{ if(G){ kload2(kf,kp0+sl_next,j); SBAR(); } }while(0)
  #define STEP(C0,C1,P0,P1,t,GK,GV,GL,MC,MN,GM) do{ SBAR(); \
    if(GM){ mload(MN,mrow+(t)+1); } \
    const lds_cptr vp_=vp0+sl_prev; \
    VRD(0); SBAR(); float sacc=(P0[0]+P0[1]); \
    GAPA(C0=__builtin_amdgcn_mfma_f32_32x32x16_bf16(kf[0],qr[0],negm,0,0,0), P0[2],P0[3],P0[4],P0[5],     pw0[0]=PKW(P0,0), pw0[1]=PKW(P0,2), pw0); \
    VRD(4); SBAR(); GAPA(C1=__builtin_amdgcn_mfma_f32_32x32x16_bf16(kf[1],qr[0],negm,0,0,0), P0[6],P0[7],P0[8],P0[9],     pw0[2]=PKW(P0,4), pw0[3]=PKW(P0,6), pw0); \
    VRD(1); SBAR(); GAPA(C0=__builtin_amdgcn_mfma_f32_32x32x16_bf16(kf[2],qr[1],C0,0,0,0),   P0[10],P0[11],P0[12],P0[13], pw1[0]=PKW(P0,8), pw1[1]=PKW(P0,10), pw1); \
    VRD(5); SBAR(); GAPA(C1=__builtin_amdgcn_mfma_f32_32x32x16_bf16(kf[3],qr[1],C1,0,0,0),   P0[14],P0[15],P1[0],P1[1],   pw1[2]=PKW(P0,12),pw1[3]=PKW(P0,14), pw1); \
    VRD(2); SBAR(); GAPA(C0=__builtin_amdgcn_mfma_f32_32x32x16_bf16(kf[4],qr[2],C0,0,0,0),   P1[2],P1[3],P1[4],P1[5],     pw2[0]=PKW(P1,0), pw2[1]=PKW(P1,2), pw2); \
    VRD(6); SBAR(); GAPA(C1=__builtin_amdgcn_mfma_f32_32x32x16_bf16(kf[5],qr[2],C1,0,0,0),   P1[6],P1[7],P1[8],P1[9],     pw2[2]=PKW(P1,4), pw2[3]=PKW(P1,6), pw2); \
    VRD(3); SBAR(); GAPA(C0=__builtin_amdgcn_mfma_f32_32x32x16_bf16(kf[6],qr[3],C0,0,0,0),   P1[10],P1[11],P1[12],P1[13], pw3[0]=PKW(P1,8), pw3[1]=PKW(P1,10), pw3); \
    VRD(7); SBAR(); GAPA(C1=__builtin_amdgcn_mfma_f32_32x32x16_bf16(kf[7],qr[3],C1,0,0,0),   P1[14],P1[15],0.f,0.f,       pw3[2]=PKW(P1,12),pw3[3]=PKW(P1,14), pw3); \
    l_reg+=sacc; \
    if(GK){DMA_K((t)+3,sl_cur);} if(GV){DMA_V((t)+1,sl_next);} \
    CMASK(C0,C1,MC); \
    { float a=MX3(C0[0],C0[1],C1[0]),b=MX3(C0[2],C0[3],C1[1]); a=MX3(a,C1[2],C1[3]); \
      _Pragma("unroll") for(int r=4;r<16;r+=4){a=MX3(a,C0[r],C0[r+1]);b=MX3(b,C0[r+2],C0[r+3]);a=MX3(a,C1[r],C1[r+1]);b=MX3(b,C1[r+2],C1[r+3]);} \
      float rm=__builtin_fmaxf(a,b); { auto rr=__builtin_amdgcn_permlane32_swap(__float_as_uint(rm),__float_as_uint(rm),false,false); rm=__builtin_fmaxf(__uint_as_float(rr[0]),__uint_as_float(rr[1])); } \
      resc=false; \
      if(__builtin_expect(__any(rm>(float)THRL),0)){ const float dl=__builtin_fmaxf(rm,0.f); mhat+=dl; \
        _Pragma("unroll") for(int r=0;r<16;++r){C0[r]-=dl;C1[r]-=dl;} \
        _Pragma("unroll") for(int r=0;r<16;++r)negm[r]=-mhat; asm volatile("":"+v"(negm)); \
        const float f=__builtin_amdgcn_exp2f(-dl); l_reg*=f; if(hi==0)wsf[r32]=f; resc=true; } } \
    SBAR(); \
    GAPB(o[0]=__builtin_amdgcn_mfma_f32_32x32x16_bf16(PAF(0),VFR(0),o[0],0,0,0), C0,0); \
    GAPB(o[1]=__builtin_amdgcn_mfma_f32_32x32x16_bf16(PAF(0),VFR(4),o[1],0,0,0), C0,4); \
    KRD(GL,0); GAPB(o[0]=__builtin_amdgcn_mfma_f32_32x32x16_bf16(PAF(1),VFR(1),o[0],0,0,0), C0,8); \
    KRD(GL,1); GAPB(o[1]=__builtin_amdgcn_mfma_f32_32x32x16_bf16(PAF(1),VFR(5),o[1],0,0,0), C0,12); \
    KRD(GL,2); GAPB(o[0]=__builtin_amdgcn_mfma_f32_32x32x16_bf16(PAF(2),VFR(2),o[0],0,0,0), C1,0); \
    KRD(GL,3); GAPB(o[1]=__builtin_amdgcn_mfma_f32_32x32x16_bf16(PAF(2),VFR(6),o[1],0,0,0), C1,4); \
    GAPB(o[0]=__builtin_amdgcn_mfma_f32_32x32x16_bf16(PAF(3),VFR(3),o[0],0,0,0), C1,8); \
    GAPB(o[1]=__builtin_amdgcn_mfma_f32_32x32x16_bf16(PAF(3),VFR(7),o[1],0,0,0), C1,12); \
    }while(0)
  int t=1;
  for(;t+5<NT;t+=2){
    STEP(pB0,pB1,pA0,pA1,t,true,true,true,mO,mE,true);     WAIT_BAR(2); RESC(); ROT();
    STEP(pA0,pA1,pB0,pB1,t+1,true,true,true,mE,mO,true);   WAIT_BAR(2); RESC(); ROT();
  }
  #define ENDW(tt) do{ if((tt)+3<NT){WAIT_BAR(2);} else if((tt)+2<NT){WAIT_BAR(1);} else {WAIT_BAR(0);} }while(0)
  for(;t+1<NT;t+=2){
    STEP(pB0,pB1,pA0,pA1,t,(t+3<NT),(t+1<NT),(t+1<NT),mO,mE,true);       ENDW(t);   RESC(); ROT();
    STEP(pA0,pA1,pB0,pB1,t+1,(t+4<NT),(t+2<NT),(t+2<NT),mE,mO,true);     ENDW(t+1); RESC(); ROT();
  }
  STEP(pB0,pB1,pA0,pA1,NT-1,false,false,false,mO,mE,false); RESC();
  { float sacc=pB0[0]+pB0[1]; _Pragma("unroll") for(int r=2;r<16;++r)sacc+=pB0[r]; _Pragma("unroll") for(int r=0;r<16;++r)sacc+=pB1[r]; l_reg+=sacc;
    pw0=(u32x4){PKW(pB0,0),PKW(pB0,2),PKW(pB0,4),PKW(pB0,6)};pw1=(u32x4){PKW(pB0,8),PKW(pB0,10),PKW(pB0,12),PKW(pB0,14)};pw2=(u32x4){PKW(pB1,0),PKW(pB1,2),PKW(pB1,4),PKW(pB1,6)};pw3=(u32x4){PKW(pB1,8),PKW(pB1,10),PKW(pB1,12),PKW(pB1,14)};
    SBAR(); pv(o,vb0+sl_cur,PAF(0),PAF(1),PAF(2),PAF(3)); }
  #undef PKW
  #undef PAF
  #undef VFR
  #undef PIN
  #undef MX3
  #undef GAPA
  #undef GAPB
  #undef EX
  #undef VRD
  #undef KRD
  #undef STEP
  #undef ENDW
  {auto rr=__builtin_amdgcn_permlane32_swap(__float_as_uint(l_reg),__float_as_uint(l_reg),false,false);l_reg=__uint_as_float(rr[0])+__uint_as_float(rr[1]);}
  int lane_e=lane; asm volatile("":"+v"(lane_e));
  const int r32e=lane_e&31,hie=lane_e>>5;
  if(hie==0)wsf[32+r32e]=l_reg;asm volatile("s_waitcnt lgkmcnt(0)":::"memory");
  float rli[16];
  #pragma unroll
  for(int r=0;r<16;++r)rli[r]=__builtin_amdgcn_rcpf(wsf[32+crow(r,hie)]);
  bf16*Ow=O+(rowbase+q0+wid*QBLK)*DMO+h*D;
  { bf16*stg=(bf16*)(shm+LDS_OST)+wid*2048;
    #pragma unroll
    for(int r=0;r<16;++r){const int orow=crow(r,hie);
      #pragma unroll
      for(int d0=0;d0<2;++d0)stg[orow*64+d0*32+r32e]=__float2bfloat16(o[d0][r]*rli[r]);}
    asm volatile("s_waitcnt lgkmcnt(0)":::"memory");
    #pragma unroll
    for(int i=0;i<4;++i){const int row=i*8+(lane_e>>3),ch=lane_e&7; const u32x4 v=*(const u32x4*)(stg+row*64+ch*8); ATTN_STORE16(Ow+(long)row*DMO+ch*8,v);} }
  asm volatile("s_waitcnt lgkmcnt(0)\n\ts_barrier":::"memory");
  #undef DMA_K
  #undef DMA_V
  #undef CMASK
  #undef START
  #undef RESC
  #undef ROT
}
constexpr int ATTN_LDS_BYTES=LDS_BYTES;
struct AttnTensors { const bf16* Q; const bf16* K; const bf16* V; bf16* O; const unsigned long long* MK; };
struct AttnUnit { int bh; int qb; };
struct StaticOrder {
  int vcu;
  __device__ __forceinline__ explicit StaticOrder(int grid,int block):vcu((block%8)*(grid/8)+block/8){}
  __device__ __forceinline__ bool next(int i,AttnUnit&u)const{ if(i>=2)return false; const int s=vcu&7; u.bh=vcu>>3; u.qb=(i==0)?15-s:s; return true; }
  __device__ __forceinline__ void a_ready(const AttnUnit&)const{}
  __device__ __forceinline__ void done(const AttnUnit&)const{}
};
template<class Sched,int THRL=8> __device__ __forceinline__ void attn_phase(char*lds,const AttnTensors&T,const Sched&S){
  AttnUnit u;
  for(int i=0;S.next(i,u);++i){ S.a_ready(u); attn_unit<THRL>(u.bh/NHEAD,u.bh%NHEAD,u.qb,T.Q,T.K,T.V,T.O,T.MK,lds); S.done(u); }
}
#undef SBAR
#undef WAIT_BAR
}
#define GAS __attribute__((address_space(1)))
#define LAS __attribute__((address_space(3)))
typedef unsigned short bf16;
typedef unsigned v4u __attribute__((ext_vector_type(4)));
typedef float f32x4 __attribute__((ext_vector_type(4)));
typedef short bf16x8 __attribute__((ext_vector_type(8)));
typedef GAS unsigned gu32;
typedef GAS unsigned long long gu64;
#define RLX_AGENT __ATOMIC_RELAXED, __HIP_MEMORY_SCOPE_AGENT
#define LDS_WAIT() asm volatile("s_waitcnt lgkmcnt(0)" ::: "memory")
#define VM_WAIT() asm volatile("s_waitcnt vmcnt(0)" ::: "memory")
__device__ __forceinline__ unsigned long long rt() { return __builtin_amdgcn_s_memrealtime(); }
__device__ __forceinline__ unsigned f2bf(float f) { unsigned u = __builtin_bit_cast(unsigned, f); return (u + 0x7fffu + ((u >> 16) & 1u)) >> 16; }
__device__ __forceinline__ unsigned pk2(float lo, float hi) { return f2bf(lo) | (f2bf(hi) << 16); }

#define XB_TMO      128
#define XB_XCNT(j)  (256  + 64 * (j))
#define XB_XSUB(j)  (1280 + 64 * (j))
#define XB_XGEN(j)  (2304 + 64 * (j))
#define XB_TOP      3328
#define XB_TOPGEN   3392
#define XCD_BAR_WORDS 3456
#define XB_SPIN_CAP (1u << 18)

__device__ __forceinline__ unsigned xb_ld(unsigned* p)              { return __hip_atomic_load(p, __ATOMIC_RELAXED, __HIP_MEMORY_SCOPE_AGENT); }
__device__ __forceinline__ unsigned xb_add(unsigned* p, unsigned v) { return __hip_atomic_fetch_add(p, v, __ATOMIC_RELAXED, __HIP_MEMORY_SCOPE_AGENT); }
__device__ __forceinline__ unsigned xb_xcc_id() { return (unsigned)__builtin_amdgcn_s_getreg((3 << 11) | 20) & 0xFu; }
#define XB_SPIN(cond, bar) do { unsigned _sp = 0; while (cond) { __builtin_amdgcn_s_sleep(1); \
    if ((++_sp & 255u) == 0u) { if (xb_ld(&(bar)[XB_TMO])) break; if (_sp > XB_SPIN_CAP) { atomicAdd(&(bar)[XB_TMO], 1u); break; } } } } while (0)

struct XcdBarrier {
    unsigned* bar; unsigned x;
    volatile LAS unsigned* st;
};

__device__ __forceinline__ XcdBarrier xcd_barrier_post(unsigned* bar, volatile LAS unsigned* st) {
    XcdBarrier b; b.bar = bar; b.x = xb_xcc_id(); b.st = st;
    if (threadIdx.x == 0) (void)xb_add(&bar[XB_XCNT(b.x)], 1u);
    return b;
}
__device__ __forceinline__ void xcd_barrier_complete(unsigned* bar, unsigned x, unsigned& nloc, unsigned& nx) {
    const unsigned G = gridDim.x * gridDim.y * gridDim.z;
    unsigned sum, cnt, mine, sp = 0u;
    for (;;) {
        sum = 0u; cnt = 0u; mine = 0u;
#pragma unroll
        for (unsigned j = 0; j < 16; ++j) { const unsigned c = xb_ld(&bar[XB_XCNT(j)]); sum += c; cnt += (c > 0u) ? 1u : 0u; mine = (j == x) ? c : mine; }
        if (sum == G) break;
        __builtin_amdgcn_s_sleep(1);
        if ((++sp & 255u) == 0u) { if (xb_ld(&bar[XB_TMO])) break; if (sp > XB_SPIN_CAP) { atomicAdd(&bar[XB_TMO], 1u); break; } }
    }
    nloc = mine > 0u ? mine : 1u; nx = cnt > 0u ? cnt : 1u;
}

__device__ __forceinline__ void xcd_barrier(const XcdBarrier& b) {
    asm volatile("s_waitcnt vmcnt(0)" ::: "memory");
    __syncthreads();
    if (threadIdx.x == 0) {
        unsigned* bar = b.bar;
        __builtin_amdgcn_s_waitcnt(0);
        unsigned nloc = b.st[0], nx = b.st[1];
        if (nloc == 0u) { xcd_barrier_complete(bar, b.x, nloc, nx); b.st[0] = nloc; b.st[1] = nx; }
        const unsigned old = xb_add(&bar[XB_XSUB(b.x)], 1u);
        const unsigned gen = old / nloc;
        if (old + 1u == (gen + 1u) * nloc) {
            __builtin_amdgcn_fence(__ATOMIC_RELEASE, "agent");
            asm volatile("s_waitcnt vmcnt(0)" ::: "memory");
            const unsigned og = xb_add(&bar[XB_TOP], 1u);
            const unsigned tg = og / nx;
            if (og + 1u == (tg + 1u) * nx) xb_add(&bar[XB_TOPGEN], 1u);
            else XB_SPIN(xb_ld(&bar[XB_TOPGEN]) == tg, bar);
            __builtin_amdgcn_fence(__ATOMIC_ACQUIRE, "agent");
            xb_add(&bar[XB_XGEN(b.x)], 1u);
            asm volatile("s_waitcnt vmcnt(0)" ::: "memory");
        } else {
            XB_SPIN(xb_ld(&bar[XB_XGEN(b.x)]) == gen, bar);
            __builtin_amdgcn_fence(__ATOMIC_ACQUIRE, "agent");
            asm volatile("s_waitcnt vmcnt(0)" ::: "memory");
        }
    }
    __syncthreads();
}
constexpr int NWAVES = 8;
constexpr int BATCH = 4, SEQ = 4096, T = BATCH * SEQ, D = 1024, DEPTH = 2;
constexpr int NIN = 2888, NP = 3072;
constexpr int PC_Q = 0, PC_K = 512, PC_V = 1024, PC_QI = 1536, PC_POOL = 2048, PC_CA = 2304, PC_CG = 2560, PC_KI = 2816, PC_WI = 2880;
constexpr int SC_KI = 2048, SC_WI = 2112, SC_POOL = 2120, SC_CONV = 2376;
constexpr float RMS_EPS = 1e-6f;
constexpr float C2 = 0.125f * 1.4426950408889634f;

constexpr size_t MiB = 1u << 20;
constexpr size_t WS_CTL = 0, CTL_ZERO_BYTES = 1 * MiB;
constexpr size_t WS_WIN = 2 * MiB;
constexpr size_t WS_WOUT = 14 * MiB;
constexpr size_t WS_WGU = 18 * MiB;
constexpr size_t WS_WD = 82 * MiB;
constexpr size_t WS_SMALL = 114 * MiB;
constexpr size_t WS_POOLWT = WS_SMALL, WS_PWWT = WS_SMALL + 64 * 1024;
constexpr size_t WS_ROUTE_E = WS_SMALL + 512 * 1024;
constexpr size_t WS_ROUTE_W = WS_SMALL + 768 * 1024;
constexpr size_t WS_HB = 118 * MiB;
constexpr size_t WS_PB = 150 * MiB;
constexpr size_t WS_MASK = 246 * MiB;
constexpr size_t WS_BLIST = 254 * MiB;
constexpr size_t WS_BW = 256 * MiB;
constexpr size_t WS_END = 260 * MiB;

constexpr int CW_TMO = 0, CW_CODE = 1;
constexpr int CW_BAR = 4096;
constexpr int CW_BCNT = 131072;

constexpr int RING_OFF = 0, RING_BYTES = 131072;
constexpr int LDSCTL_OFF = RING_BYTES, MISC_OFF = LDSCTL_OFF + 320;
constexpr int LDS_BYTES = 147456;

struct Args { const float* in[21]; float* out; unsigned char* ws; int ph_lo, ph_hi, li, pad; };
struct Frame {
    LAS unsigned char* lds;
    volatile LAS unsigned* MISC;
    gu32* ctl;
    int tid, lane, wave;
    int vcu, G;
    float* out;
    unsigned char* ws;
};
enum { I_X = 0, I_N1G, I_WIN, I_POOLW, I_POOLS, I_DWW, I_DWB, I_LNG, I_LNB, I_PWW, I_PWB, I_WOUT, I_N2G, I_RGW, I_RGB, I_REW, I_REB, I_WG, I_WU, I_WDN, I_FG };

__device__ __forceinline__ float wave_sum(float v) {
#pragma unroll
    for (int o = 1; o < 64; o <<= 1) v += __shfl_xor(v, o);
    return v;
}
__device__ __forceinline__ float bf2f(unsigned short b) { return __uint_as_float((unsigned)b << 16); }

__device__ __forceinline__ void p0_transpose_item(const float* W, int ldw, int c0, int Kd, bf16* WT, int row_off, int row_mul, LAS float* scr, int kb, int nb, int lane) {
    const int k0 = 64 * kb, n0 = 32 * nb;
#pragma unroll 8
    for (int i = 0; i < 32; ++i) { const int kk = 2 * i + (lane >> 5); scr[kk * 33 + (lane & 31)] = W[(size_t)(k0 + kk) * ldw + c0 + n0 + (lane & 31)]; }
    LDS_WAIT(); asm volatile("" ::: "memory");
    const int c = lane & 7;
#pragma unroll
    for (int j = 0; j < 4; ++j) { const int n = (lane >> 3) + 8 * j; const LAS float* s = scr + (8 * c) * 33 + n;
        v4u o; o.x = pk2(s[0 * 33], s[1 * 33]); o.y = pk2(s[2 * 33], s[3 * 33]); o.z = pk2(s[4 * 33], s[5 * 33]); o.w = pk2(s[6 * 33], s[7 * 33]);
        *(GAS v4u*)(WT + (size_t)(row_off + (n0 + n) * row_mul) * Kd + k0 + 8 * c) = o; }
    LDS_WAIT(); asm volatile("" ::: "memory");
}
__device__ __forceinline__ void rms_row_to_bf16(const float* xrow, const float* g, bf16* orow, int lane) {
    const GAS f32x4* xr = (const GAS f32x4*)xrow + lane; const GAS f32x4* gr = (const GAS f32x4*)g + lane;
    f32x4 v[4]; float s = 0.f;
#pragma unroll
    for (int j = 0; j < 4; ++j) { v[j] = xr[64 * j]; s += (v[j].x * v[j].x + v[j].y * v[j].y) + (v[j].z * v[j].z + v[j].w * v[j].w); }
    const float rstd = 1.f / sqrtf(wave_sum(s) * (1.f / D) + RMS_EPS);
    GAS unsigned long long* o8 = (GAS unsigned long long*)orow + lane;
#pragma unroll
    for (int j = 0; j < 4; ++j) { const f32x4 gv = gr[64 * j];
        o8[64 * j] = (unsigned long long)pk2(v[j].x * rstd * gv.x, v[j].y * rstd * gv.y) | ((unsigned long long)pk2(v[j].z * rstd * gv.z, v[j].w * rstd * gv.w) << 32); }
}
__device__ __forceinline__ void rms_row_f32(float* xrow, const float* g, int lane) {
    GAS f32x4* xr = (GAS f32x4*)xrow + lane; const GAS f32x4* gr = (const GAS f32x4*)g + lane;
    f32x4 v[4]; float s = 0.f;
#pragma unroll
    for (int j = 0; j < 4; ++j) { v[j] = xr[64 * j]; s += (v[j].x * v[j].x + v[j].y * v[j].y) + (v[j].z * v[j].z + v[j].w * v[j].w); }
    const float rstd = 1.f / sqrtf(wave_sum(s) * (1.f / D) + RMS_EPS);
#pragma unroll
    for (int j = 0; j < 4; ++j) { const f32x4 gv = gr[64 * j]; xr[64 * j] = (f32x4){v[j].x * rstd * gv.x, v[j].y * rstd * gv.y, v[j].z * rstd * gv.z, v[j].w * rstd * gv.w}; }
}

__device__ __forceinline__ void p0_prologue(Frame& F, const Args& A) {
    LAS float* scr = (LAS float*)(F.lds + RING_OFF + F.wave * 16384);
    const int gw = F.vcu * NWAVES + F.wave, NGW = F.G * NWAVES, lane = F.lane;
    bf16* Win_t = (bf16*)(F.ws + WS_WIN); bf16* Wout_t = (bf16*)(F.ws + WS_WOUT); bf16* Wgu_t = (bf16*)(F.ws + WS_WGU); bf16* Wd_t = (bf16*)(F.ws + WS_WD);
    bf16* pool_wt = (bf16*)(F.ws + WS_POOLWT); bf16* pw_wt = (bf16*)(F.ws + WS_PWWT);
    constexpr int I_IN0 = 16 * 64, I_IN1 = 16 * 8, I_IN2 = 16 * 16, I_IN3 = 16 * 2;
    constexpr int I_OUT = 16 * 32, I_G = 16 * 256, I_U = 16 * 256, I_DN = 16 * 256, I_PL = 4 * 2, I_PW = 4 * 8;
    constexpr int PER_L = I_IN0 + I_IN1 + I_IN2 + I_IN3 + I_OUT + I_G + I_U + I_DN + I_PL + I_PW;
    for (int it = gw; it < DEPTH * PER_L; it += NGW) {
        const int l = it / PER_L; int r = it % PER_L;
        const float* w_in = A.in[I_WIN] + (size_t)l * D * NIN; bf16* wt = Win_t + (size_t)l * NP * D;
        if (r < I_IN0) { p0_transpose_item(w_in, NIN, 0, D, wt, 0, 1, scr, r / 64, r % 64, lane); continue; } r -= I_IN0;
        if (r < I_IN1) { p0_transpose_item(w_in, NIN, SC_POOL, D, wt, PC_POOL, 1, scr, r / 8, r % 8, lane); continue; } r -= I_IN1;
        if (r < I_IN2) { p0_transpose_item(w_in, NIN, SC_CONV, D, wt, PC_CA, 1, scr, r / 16, r % 16, lane); continue; } r -= I_IN2;
        if (r < I_IN3) { p0_transpose_item(w_in, NIN, SC_KI, D, wt, PC_KI, 1, scr, r / 2, r % 2, lane); continue; } r -= I_IN3;
        if (r < I_OUT) { p0_transpose_item(A.in[I_WOUT] + (size_t)l * D * D, D, 0, D, Wout_t + (size_t)l * D * D, 0, 1, scr, r / 32, r % 32, lane); continue; } r -= I_OUT;
        if (r < I_G) { const int e = r / 256, q = r % 256; p0_transpose_item(A.in[I_WG] + ((size_t)l * 16 + e) * 1024 * 512, 512, 0, 1024, Wgu_t + ((size_t)l * 16 + e) * 1024 * 1024, 0, 2, scr, q / 16, q % 16, lane); continue; } r -= I_G;
        if (r < I_U) { const int e = r / 256, q = r % 256; p0_transpose_item(A.in[I_WU] + ((size_t)l * 16 + e) * 1024 * 512, 512, 0, 1024, Wgu_t + ((size_t)l * 16 + e) * 1024 * 1024, 1, 2, scr, q / 16, q % 16, lane); continue; } r -= I_U;
        if (r < I_DN) { const int e = r / 256, q = r % 256; p0_transpose_item(A.in[I_WDN] + ((size_t)l * 16 + e) * 512 * 1024, 1024, 0, 512, Wd_t + ((size_t)l * 16 + e) * 1024 * 512, 0, 1, scr, q / 32, q % 32, lane); continue; } r -= I_DN;
        if (r < I_PL) { const int g = r / 2; p0_transpose_item(A.in[I_POOLW] + ((size_t)l * 4 + g) * 64 * 64, 64, 0, 64, pool_wt + ((size_t)l * 4 + g) * 64 * 64, 0, 1, scr, 0, r % 2, lane); continue; } r -= I_PL;
        p0_transpose_item(A.in[I_PWW] + (size_t)l * 256 * 256, 256, 0, 256, pw_wt + (size_t)l * 256 * 256, 0, 1, scr, r / 8, r % 8, lane);
    }
    for (int it = gw; it < DEPTH * 192; it += NGW) {
        const int l = it / 192, rr = it % 192;
        bf16* dst = Win_t + ((size_t)l * NP + PC_WI + rr) * D;
        const float* w_in = A.in[I_WIN] + (size_t)l * D * NIN;
#pragma unroll
        for (int j = 0; j < 16; ++j) { const int k = lane + 64 * j; dst[k] = (rr < 8) ? (bf16)f2bf(w_in[(size_t)k * NIN + SC_WI + rr]) : (bf16)0; }
    }
    bf16* HB = (bf16*)(F.ws + WS_HB);
    for (int m = gw; m < T; m += NGW) rms_row_to_bf16(A.in[I_X] + (size_t)m * D, A.in[I_N1G], HB + (size_t)m * D, lane);
}

struct EpiResF32 {
    static constexpr bool PERM = false, AFTER_DRAIN = false;
    const float* base; float* out; int ldc;
    __device__ __forceinline__ void operator()(const pg8::f32x4 (&acc)[2][2][4][2], const pg8::Unit& u, int wr, int wc, int fr, int fq) const {
        const int col0 = u.pn * pg8::BM + wc * 32 + 4 * fq;
#pragma unroll
        for (int ai = 0; ai < 2; ++ai)
#pragma unroll
            for (int m = 0; m < 4; ++m) { const size_t off = (size_t)(u.pm * pg8::BM + ai * pg8::HALF + wr * 64 + m * 16 + fr) * ldc + col0;
#pragma unroll
                for (int bj = 0; bj < 2; ++bj)
#pragma unroll
                    for (int n = 0; n < 2; ++n) { const pg8::f32x4 bs = *(const pg8::f32x4*)(base + off + bj * pg8::HALF + n * 16); *(pg8::f32x4*)(out + off + bj * pg8::HALF + n * 16) = bs + acc[ai][bj][m][n]; } }
    }
};


constexpr int MOE_TAB_OFF = LDSCTL_OFF + 1024;
__device__ __forceinline__ int pair_lo(int p) { return p < 3 ? 0 : (p < 5 ? 1 : 2); }
__device__ __forceinline__ int pair_hi(int p) { return p < 3 ? p + 1 : (p < 5 ? p - 1 : 3); }

__device__ __forceinline__ void r2_router(Frame& F, const Args& A, int l) {
    LAS float* Wt = (LAS float*)(F.lds + RING_OFF);
    const float* rg = A.in[I_RGW] + (size_t)l * D * 4; const float* re = A.in[I_REW] + (size_t)l * D * 16;
    for (int e = F.tid; e < D * 4; e += NWAVES * 64) Wt[(e & 3) * 1024 + (e >> 2)] = rg[e];
    for (int e = F.tid; e < D * 16; e += NWAVES * 64) Wt[(4 + (e & 15)) * 1024 + (e >> 4)] = re[e];
    __syncthreads();
    const int gw = F.vcu * NWAVES + F.wave, NGW = F.G * NWAVES, lane = F.lane;
    bf16* HB = (bf16*)(F.ws + WS_HB); int* blist = (int*)(F.ws + WS_BLIST); float* bw = (float*)(F.ws + WS_BW);
    const float* g2 = A.in[I_N2G] + (size_t)l * D; const float* rgb = A.in[I_RGB] + l * 4; const float* reb = A.in[I_REB] + l * 16;
    for (int m = gw; m < T; m += NGW) {
        const GAS f32x4* xr = (const GAS f32x4*)(F.out + (size_t)m * D) + lane; const GAS f32x4* gr = (const GAS f32x4*)g2 + lane;
        f32x4 v[4]; float s = 0.f;
#pragma unroll
        for (int j = 0; j < 4; ++j) { v[j] = xr[64 * j]; s += (v[j].x * v[j].x + v[j].y * v[j].y) + (v[j].z * v[j].z + v[j].w * v[j].w); }
        const float rstd = 1.f / sqrtf(wave_sum(s) * (1.f / D) + RMS_EPS);
        GAS unsigned long long* o8 = (GAS unsigned long long*)(HB + (size_t)m * D) + lane;
#pragma unroll
        for (int j = 0; j < 4; ++j) { const f32x4 gv = gr[64 * j]; v[j] = (f32x4){v[j].x * rstd * gv.x, v[j].y * rstd * gv.y, v[j].z * rstd * gv.z, v[j].w * rstd * gv.w};
            o8[64 * j] = (unsigned long long)pk2(v[j].x, v[j].y) | ((unsigned long long)pk2(v[j].z, v[j].w) << 32); }
        float lg[20];
#pragma unroll
        for (int q = 0; q < 20; ++q) { float a = 0.f;
#pragma unroll
            for (int j = 0; j < 4; ++j) { const f32x4 w = *(const LAS f32x4*)(Wt + q * 1024 + 4 * lane + 256 * j); a += (v[j].x * w.x + v[j].y * w.y) + (v[j].z * w.z + v[j].w * w.w); }
            lg[q] = wave_sum(a); __builtin_amdgcn_sched_barrier(0); }
        float gl[4];
#pragma unroll
        for (int j = 0; j < 4; ++j) gl[j] = lg[j] + rgb[j];
        int gs = 0; float gm = gl[0];
#pragma unroll
        for (int j = 1; j < 4; ++j) if (gl[j] > gm) { gm = gl[j]; gs = j; }
        float gsum = 0.f;
#pragma unroll
        for (int j = 0; j < 4; ++j) gsum += expf(gl[j] - gm);
        const float pg = 1.0f / gsum;
        float el[4];
#pragma unroll
        for (int j = 0; j < 4; ++j) { const float e0 = lg[4 + j] + reb[j], e1 = lg[8 + j] + reb[4 + j], e2 = lg[12 + j] + reb[8 + j], e3 = lg[16 + j] + reb[12 + j]; el[j] = gs == 0 ? e0 : (gs == 1 ? e1 : (gs == 2 ? e2 : e3)); }
        float em = fmaxf(fmaxf(el[0], el[1]), fmaxf(el[2], el[3]));
        float ep[4], esum = 0.f;
#pragma unroll
        for (int j = 0; j < 4; ++j) { ep[j] = expf(el[j] - em); esum += ep[j]; }
#pragma unroll
        for (int j = 0; j < 4; ++j) ep[j] /= esum;
        int i1 = 0; float p1 = ep[0];
#pragma unroll
        for (int j = 1; j < 4; ++j) if (ep[j] > p1) { p1 = ep[j]; i1 = j; }
        int i2 = -1; float p2 = -1.f;
#pragma unroll
        for (int j = 0; j < 4; ++j) if (j != i1 && ep[j] > p2) { p2 = ep[j]; i2 = j; }
        const float den = p1 + p2; const float w1 = pg * (p1 / den), w2 = pg * (p2 / den);
        const int lo = i1 < i2 ? i1 : i2, hi = i1 < i2 ? i2 : i1;
        const int pidx = lo == 0 ? hi - 1 : (lo == 1 ? hi + 1 : 5);
        const int bk = gs * 6 + pidx;
        if (lane == 0) {
            const unsigned pos = __hip_atomic_fetch_add((unsigned*)(F.ctl + CW_BCNT + (l * 24 + bk) * 64), 1u, __ATOMIC_RELAXED, __HIP_MEMORY_SCOPE_AGENT);
            blist[(size_t)bk * T + pos] = m;
            bw[((size_t)bk * T + pos) * 2] = i1 < i2 ? w1 : w2; bw[((size_t)bk * T + pos) * 2 + 1] = i1 < i2 ? w2 : w1;
        }
    }
}
__device__ __forceinline__ void moe_build_table(Frame& F, int l) {
    LAS int* tab = (LAS int*)(F.lds + MOE_TAB_OFF);
    if (F.tid == 0) {
        int nt = 0;
        for (int b = 0; b < 24; ++b) {
            const int c = (int)__hip_atomic_load((unsigned*)(F.ctl + CW_BCNT + (l * 24 + b) * 64), __ATOMIC_RELAXED, __HIP_MEMORY_SCOPE_AGENT);
            tab[128 + b] = c;
            const int ntb = (c + 255) >> 8;
            for (int i = 0; i < ntb && nt < 96; ++i) tab[8 + nt++] = (b << 16) | i;
        }
        tab[0] = nt;
    }
    __syncthreads();
}
struct MoeSched {
    const LAS int* tab; int ntiles, ntx, npn, xcd, j, mode;
    const int* blist; const char* Abase; const char* Bbase;
    __device__ __forceinline__ bool next(int i, pg8::Unit2& u) const {
        const int m = i * 32 + j, tl = m / npn, tg = xcd * ntx + tl;
        if (tl >= ntx || tg >= ntiles) return false;
        const int e = __builtin_amdgcn_readfirstlane(tab[8 + tg]);
        u.pm = tg; u.pn = m % npn; u.bk = e >> 16; u.r0 = (e & 0xffff) * 256; u.cnt = __builtin_amdgcn_readfirstlane(tab[128 + (e >> 16)]);
        return true;
    }
    __device__ __forceinline__ int expert(const pg8::Unit2& u, int which) const { const int g = u.bk / 6, p = u.bk % 6; return g * 4 + (which ? pair_hi(p) : pair_lo(p)); }
    __device__ __forceinline__ const char* a_base(const pg8::Unit2& u) const { return mode == 1 ? Abase : Abase + (size_t)u.pm * 256 * 1024 * 2; }
    __device__ __forceinline__ const char* b_base(const pg8::Unit2& u) const {
        if (mode == 1) return Bbase + ((size_t)expert(u, u.pn >> 2) * 1024 + (size_t)(u.pn & 3) * 256) * 1024 * 2;
        return Bbase + ((size_t)expert(u, 0) * 1024 + (size_t)u.pn * 256) * 512 * 2;
    }
    __device__ __forceinline__ long b_jump(const pg8::Unit2& u) const { return mode == 1 ? 0l : (long)(expert(u, 1) - expert(u, 0)) * 1024 * 512 * 2 - 8 * 128; }
    __device__ __forceinline__ int a_row(const pg8::Unit2& u, int r) const { int q = u.r0 + r; q = q < u.cnt ? q : u.cnt - 1; return blist[(size_t)u.bk * T + q]; }
};
__device__ __forceinline__ float silu_f(float a) { return a * __builtin_amdgcn_rcpf(1.0f + __builtin_amdgcn_exp2f(-1.4426950408889634f * a)); }
struct EpiSwiGLU {
    static constexpr bool PERM = true;
    bf16* HID; const float* bw;
    __device__ __forceinline__ void operator()(const pg8::f32x4 (&acc)[2][2][4][2], const pg8::Unit2& u, int wr, int wc, int fr, int fq) const {
        const int half = u.pn >> 2, hc0 = half * 512 + (u.pn & 3) * 128 + wc * 16 + 4 * fq;
#pragma unroll
        for (int ai = 0; ai < 2; ++ai)
#pragma unroll
            for (int m = 0; m < 4; ++m) { const int r = ai * 128 + wr * 64 + m * 16 + fr; int q = u.r0 + r; q = q < u.cnt ? q : u.cnt - 1;
                const float w = bw[((size_t)u.bk * T + q) * 2 + half];
                bf16* rowp = HID + (size_t)(u.pm * 256 + r) * 1024 + hc0;
#pragma unroll
                for (int bj = 0; bj < 2; ++bj) { const pg8::f32x4 v0 = acc[ai][bj][m][0], v1 = acc[ai][bj][m][1];
                    const float h0 = silu_f(v0[0]) * v0[1] * w, h1 = silu_f(v0[2]) * v0[3] * w, h2 = silu_f(v1[0]) * v1[1] * w, h3 = silu_f(v1[2]) * v1[3] * w;
                    *(uint2*)(rowp + bj * 64) = make_uint2(pg8::cvt_pk_bf16(h0, h1), pg8::cvt_pk_bf16(h2, h3)); } }
    }
};
struct EpiScatter {
    static constexpr bool PERM = false;
    float* out; const int* blist;
    __device__ __forceinline__ void operator()(const pg8::f32x4 (&acc)[2][2][4][2], const pg8::Unit2& u, int wr, int wc, int fr, int fq) const {
        const int col0 = u.pn * 256 + wc * 32 + 4 * fq;
#pragma unroll
        for (int ai = 0; ai < 2; ++ai)
#pragma unroll
            for (int m = 0; m < 4; ++m) { const int r = ai * 128 + wr * 64 + m * 16 + fr; const int q = u.r0 + r;
                if (q < u.cnt) { const int tok = blist[(size_t)u.bk * T + q]; float* rowp = out + (size_t)tok * D + col0;
#pragma unroll
                    for (int bj = 0; bj < 2; ++bj)
#pragma unroll
                        for (int n = 0; n < 2; ++n) { pg8::f32x4* p = (pg8::f32x4*)(rowp + bj * 128 + n * 16); *p = *p + acc[ai][bj][m][n]; } } }
    }
};

typedef float f32x16 __attribute__((ext_vector_type(16)));
typedef unsigned u32x2 __attribute__((ext_vector_type(2)));
constexpr int SC_OFF = RING_OFF;
constexpr int HIST_OFF = LDSCTL_OFF + 2048;
__device__ __forceinline__ float wave_min_f(float v) {
#pragma unroll
    for (int o = 1; o < 64; o <<= 1) v = fminf(v, __shfl_xor(v, o));
    return v;
}
__device__ __forceinline__ float wave_max_f(float v) {
#pragma unroll
    for (int o = 1; o < 64; o <<= 1) v = fmaxf(v, __shfl_xor(v, o));
    return v;
}
__device__ __forceinline__ void topk_unit(Frame& F, int b, int t0) {
    const bf16* PB = (const bf16*)(F.ws + WS_PB);
    unsigned long long* MASK = (unsigned long long*)(F.ws + WS_MASK);
    const int lane = F.lane, wave = F.wave;
    const int c = t0 >> 6, n = (c + 1) * 64;
    const size_t tb = (size_t)b * SEQ;
    if (n <= 256) {
        const unsigned long long w = (lane <= c) ? ~0ull : 0ull;
        MASK[(tb + t0 + wave) * 64 + lane] = w;
        return;
    }
    LAS float* sc = (LAS float*)(F.lds + SC_OFF);
    {
        const int r = lane & 31, hb = lane >> 5;
        const int a_ = r >> 3, hi_ = (r >> 2) & 1, i_ = r & 3;
        const int ql = 2 * (a_ >> 1) + hi_, head = 4 * (a_ & 1) + i_;
        bf16x8 af[2][4];
#pragma unroll
        for (int rt = 0; rt < 2; ++rt)
#pragma unroll
            for (int ks = 0; ks < 4; ++ks) af[rt][ks] = *(const bf16x8*)(PB + (tb + t0 + rt * 4 + ql) * NP + PC_QI + head * 64 + ks * 16 + 8 * hb);
        float wq[2][2][8];
#pragma unroll
        for (int rt = 0; rt < 2; ++rt)
#pragma unroll
            for (int s = 0; s < 2; ++s) { const bf16x8 wv = *(const bf16x8*)(PB + (tb + t0 + rt * 4 + 2 * s + hb) * NP + PC_WI);
#pragma unroll
                for (int h = 0; h < 8; ++h) wq[rt][s][h] = bf2f((unsigned short)wv[h]); }
        const int nkt = n >> 5;
        for (int kt = wave; kt < nkt; kt += NWAVES) {
            const bf16* kp = PB + (tb + kt * 32 + r) * NP + PC_KI + 8 * hb;
            bf16x8 bfr[4];
#pragma unroll
            for (int ks = 0; ks < 4; ++ks) bfr[ks] = *(const bf16x8*)(kp + ks * 16);
#pragma unroll
            for (int rt = 0; rt < 2; ++rt) {
                f32x16 acc = {};
#pragma unroll
                for (int ks = 0; ks < 4; ++ks) acc = __builtin_amdgcn_mfma_f32_32x32x16_bf16(af[rt][ks], bfr[ks], acc, 0, 0, 0);
                float s0 = 0.f, s1 = 0.f;
#pragma unroll
                for (int h = 0; h < 8; ++h) { s0 += fmaxf(acc[h], 0.f) * wq[rt][0][h]; s1 += fmaxf(acc[8 + h], 0.f) * wq[rt][1][h]; }
                sc[(rt * 4 + hb) * SEQ + kt * 32 + r] = s0;
                sc[(rt * 4 + 2 + hb) * SEQ + kt * 32 + r] = s1;
            }
        }
    }
    __syncthreads();
    {
        const LAS float* row = sc + wave * SEQ;
        LAS unsigned* hist = (LAS unsigned*)(F.lds + HIST_OFF) + wave * 256;
        const int nblk = (n + 255) >> 8;
        float mn = INFINITY, mx = -INFINITY;
        for (int i = 0; i < nblk; ++i) { const int k0 = i * 256 + 4 * lane; if (k0 < n) { const f32x4 v = *(const LAS f32x4*)(row + k0);
            mn = fminf(fminf(mn, v.x), fminf(v.y, fminf(v.z, v.w))); mx = fmaxf(fmaxf(mx, v.x), fmaxf(v.y, fmaxf(v.z, v.w))); } }
        float lo = wave_min_f(mn), hi = wave_max_f(mx);
        int need = 256; float thr = hi; int need_eq = 0x7fffffff;
        for (int iter = 0; iter < 16; ++iter) {
            if (!(lo < hi)) { thr = lo; need_eq = need; break; }
            *(LAS v4u*)(hist + 4 * lane) = (v4u){0u, 0u, 0u, 0u};
            const float scale = 256.0f / (hi - lo);
            LDS_WAIT();
            for (int i = 0; i < nblk; ++i) { const int k0 = i * 256 + 4 * lane; if (k0 < n) { const f32x4 v = *(const LAS f32x4*)(row + k0);
#pragma unroll
                for (int e = 0; e < 4; ++e) { const float s = v[e]; if (s >= lo && s <= hi) { int bn = (int)((s - lo) * scale); bn = bn > 255 ? 255 : bn; __hip_atomic_fetch_add(hist + bn, 1u, __ATOMIC_RELAXED, __HIP_MEMORY_SCOPE_WORKGROUP); } } } }
            LDS_WAIT();
            const v4u hv = *(const LAS v4u*)(hist + 4 * lane);
            const unsigned mysum = hv.x + hv.y + hv.z + hv.w;
            unsigned suf = mysum;
#pragma unroll
            for (int o = 1; o < 64; o <<= 1) { const unsigned t = __shfl_down(suf, o); if (lane + o < 64) suf += t; }
            const unsigned above = suf - mysum;
            const unsigned c3 = above, c2 = c3 + hv.w, c1 = c2 + hv.z, c0 = c1 + hv.y;
            int bsel = -1; unsigned cab = 0, hc = 0;
            if (c3 < (unsigned)need && (unsigned)need <= c3 + hv.w) { bsel = 4 * lane + 3; cab = c3; hc = hv.w; }
            else if (c2 < (unsigned)need && (unsigned)need <= c2 + hv.z) { bsel = 4 * lane + 2; cab = c2; hc = hv.z; }
            else if (c1 < (unsigned)need && (unsigned)need <= c1 + hv.y) { bsel = 4 * lane + 1; cab = c1; hc = hv.y; }
            else if (c0 < (unsigned)need && (unsigned)need <= c0 + hv.x) { bsel = 4 * lane; cab = c0; hc = hv.x; }
            const unsigned long long bal = __ballot(bsel >= 0);
            if (bal == 0ull) { thr = hi; need_eq = need; break; }
            const int src = __ffsll((long long)bal) - 1;
            const int bstar = __shfl(bsel, src); const unsigned cabove = __shfl(cab, src), hcount = __shfl(hc, src);
            need -= (int)cabove;
            float bmn = INFINITY, bmx = -INFINITY;
            for (int i = 0; i < nblk; ++i) { const int k0 = i * 256 + 4 * lane; if (k0 < n) { const f32x4 v = *(const LAS f32x4*)(row + k0);
#pragma unroll
                for (int e = 0; e < 4; ++e) { const float s = v[e]; if (s >= lo && s <= hi) { int bn = (int)((s - lo) * scale); bn = bn > 255 ? 255 : bn; if (bn == bstar) { bmn = fminf(bmn, s); bmx = fmaxf(bmx, s); } } } } }
            bmn = wave_min_f(bmn); bmx = wave_max_f(bmx);
            if ((int)hcount == need) { thr = bmn; need_eq = 0x7fffffff; break; }
            lo = bmn; hi = bmx;
            if (iter == 15) { thr = hi; need_eq = need; }
        }
        unsigned long long myword = 0ull; int run_eq = 0;
        const int nkb = n >> 6;
        for (int kb = 0; kb < nkb; ++kb) {
            const float s = row[kb * 64 + lane];
            const bool gt = s > thr, eq = s == thr;
            const unsigned long long em = __ballot(eq);
            const int rank = run_eq + __popcll(em & ((1ull << lane) - 1ull));
            const bool sel = gt || (eq && rank < need_eq);
            const unsigned long long w = __ballot(sel);
            if (lane == kb) myword = w;
            run_eq += __popcll(em);
        }
        MASK[(tb + t0 + wave) * 64 + lane] = myword;
    }
    __syncthreads();
}

__device__ __forceinline__ void poolconv_tile(Frame& F, const Args& A, int l, int tile) {
    const bf16* PB = (const bf16*)(F.ws + WS_PB); bf16* YB = (bf16*)(F.ws + WS_HB);
    const int tid = F.tid, lane = F.lane, wave = F.wave;
    const int t0 = (tile & 63) * 64; const size_t tb = (size_t)(tile >> 6) * SEQ;
    LAS bf16* glu = (LAS bf16*)(F.lds + RING_OFF);
    LAS float* hbuf = (LAS float*)(F.lds + RING_OFF + 49152);
    LAS bf16* dpl = (LAS bf16*)(F.lds + RING_OFF + 49152 + 65536);
    const int ch = tid & 255, th = tid >> 8;
    for (int e = tid; e < 94 * 128; e += NWAVES * 64) { const int rr = e >> 7, c2 = (e & 127) * 2; const int t = t0 - 30 + rr;
        unsigned o = 0u;
        if (t >= 0) { const unsigned av = *(const unsigned*)(PB + (tb + t) * NP + PC_CA + c2), gv = *(const unsigned*)(PB + (tb + t) * NP + PC_CG + c2);
            const float a0 = bf2f((unsigned short)(av & 0xffff)), a1 = bf2f((unsigned short)(av >> 16)), g0 = bf2f((unsigned short)(gv & 0xffff)), g1 = bf2f((unsigned short)(gv >> 16));
            o = pk2(a0 / (1.0f + expf(-g0)), a1 / (1.0f + expf(-g1))); }
        *(LAS unsigned*)(glu + rr * 256 + c2) = o; }
    __syncthreads();
    {
        const float* dw = A.in[I_DWW] + (size_t)l * 31 * 256; float wt[31];
#pragma unroll
        for (int j = 0; j < 31; ++j) wt[j] = dw[j * 256 + ch];
        const float bias = A.in[I_DWB][l * 256 + ch];
        for (int tt = 0; tt < 32; ++tt) { const int tr = th * 32 + tt; float acc = bias;
#pragma unroll
            for (int j = 0; j < 31; ++j) acc += bf2f(glu[(tr + j) * 256 + ch]) * wt[j];
            hbuf[tr * 256 + ch] = acc; }
    }
    __syncthreads();
    LAS bf16* act = glu;
    {
        const f32x4 g4 = *(const f32x4*)(A.in[I_LNG] + l * 256 + 4 * lane), b4 = *(const f32x4*)(A.in[I_LNB] + l * 256 + 4 * lane);
        for (int tr = wave; tr < 64; tr += NWAVES) { const f32x4 v = *(const LAS f32x4*)(hbuf + tr * 256 + 4 * lane);
            const float mu = wave_sum((v.x + v.y) + (v.z + v.w)) * (1.0f / 256.0f);
            const f32x4 d = v - mu; const float var = wave_sum((d.x * d.x + d.y * d.y) + (d.z * d.z + d.w * d.w)) * (1.0f / 256.0f);
            const float rs = 1.0f / sqrtf(var + RMS_EPS);
            f32x4 y = d * rs * g4 + b4;
            y.x = y.x / (1.0f + expf(-y.x)); y.y = y.y / (1.0f + expf(-y.y)); y.z = y.z / (1.0f + expf(-y.z)); y.w = y.w / (1.0f + expf(-y.w));
            *(LAS u32x2*)(act + tr * 264 + 4 * lane) = (u32x2){pk2(y.x, y.y), pk2(y.z, y.w)}; }
    }
    __syncthreads();
    {
        const bf16* pw = (const bf16*)(F.ws + WS_PWWT) + (size_t)l * 256 * 256;
        f32x4 acc[2][4];
#pragma unroll
        for (int a = 0; a < 2; ++a)
#pragma unroll
            for (int t = 0; t < 4; ++t) acc[a][t] = (f32x4){0.f, 0.f, 0.f, 0.f};
        const int fr = lane & 15, fq = lane >> 4;
#pragma unroll
        for (int ks = 0; ks < 8; ++ks) {
            bf16x8 af[2], bfv[4];
#pragma unroll
            for (int a = 0; a < 2; ++a) af[a] = *(const bf16x8*)(pw + (size_t)((2 * wave + a) * 16 + fr) * 256 + ks * 32 + 8 * fq);
#pragma unroll
            for (int t = 0; t < 4; ++t) bfv[t] = *(const LAS bf16x8*)(act + (t * 16 + fr) * 264 + ks * 32 + 8 * fq);
#pragma unroll
            for (int a = 0; a < 2; ++a)
#pragma unroll
                for (int t = 0; t < 4; ++t) acc[a][t] = __builtin_amdgcn_mfma_f32_16x16x32_bf16(af[a], bfv[t], acc[a][t], 0, 0, 0);
        }
#pragma unroll
        for (int a = 0; a < 2; ++a) { const int n0 = (2 * wave + a) * 16 + 4 * fq; const f32x4 pb4 = *(const f32x4*)(A.in[I_PWB] + l * 256 + n0);
#pragma unroll
            for (int t = 0; t < 4; ++t) { const f32x4 o = acc[a][t] + pb4;
                *(uint2*)(YB + (tb + t0 + t * 16 + fr) * D + 768 + n0) = make_uint2(pk2(o.x, o.y), pk2(o.z, o.w)); } }
    }
    __syncthreads();
    LAS bf16* dp = (LAS bf16*)hbuf;
    {
        const int win = 2 << (ch >> 6);
        float u[47];
#pragma unroll
        for (int i = 0; i < 47; ++i) { const int t = t0 + th * 32 - 15 + i; u[i] = (t >= 0) ? bf2f(PB[(tb + (t >= 0 ? t : 0)) * NP + PC_POOL + ch]) : 0.f; }
#pragma unroll
        for (int tt = 0; tt < 32; ++tt) { const int t = t0 + th * 32 + tt; float s = 0.f;
#pragma unroll
            for (int j = 0; j < 16; ++j) if (j < win) s += u[15 + tt - j];
            const int cnt = (t + 1 < win) ? (t + 1) : win;
            dp[(th * 32 + tt) * 264 + ch] = (bf16)f2bf(s / (float)cnt - u[15 + tt]); }
    }
    __syncthreads();
    {
        const int g = wave >> 1; const bf16* pwt = (const bf16*)(F.ws + WS_POOLWT) + ((size_t)l * 4 + g) * 64 * 64;
        f32x4 acc[2][4];
#pragma unroll
        for (int a = 0; a < 2; ++a)
#pragma unroll
            for (int t = 0; t < 4; ++t) acc[a][t] = (f32x4){0.f, 0.f, 0.f, 0.f};
        const int fr = lane & 15, fq = lane >> 4;
#pragma unroll
        for (int ks = 0; ks < 2; ++ks) {
            bf16x8 af[2], bfv[4];
#pragma unroll
            for (int a = 0; a < 2; ++a) af[a] = *(const bf16x8*)(pwt + (size_t)((2 * (wave & 1) + a) * 16 + fr) * 64 + ks * 32 + 8 * fq);
#pragma unroll
            for (int t = 0; t < 4; ++t) bfv[t] = *(const LAS bf16x8*)(dp + (t * 16 + fr) * 264 + g * 64 + ks * 32 + 8 * fq);
#pragma unroll
            for (int a = 0; a < 2; ++a)
#pragma unroll
                for (int t = 0; t < 4; ++t) acc[a][t] = __builtin_amdgcn_mfma_f32_16x16x32_bf16(af[a], bfv[t], acc[a][t], 0, 0, 0);
        }
#pragma unroll
        for (int a = 0; a < 2; ++a) { const int n0 = g * 64 + (2 * (wave & 1) + a) * 16 + 4 * fq; const f32x4 ps4 = *(const f32x4*)(A.in[I_POOLS] + l * 256 + n0);
#pragma unroll
            for (int t = 0; t < 4; ++t) { const f32x4 o = acc[a][t] * ps4;
                *(uint2*)(YB + (tb + t0 + t * 16 + fr) * D + 512 + n0) = make_uint2(pk2(o.x, o.y), pk2(o.z, o.w)); } }
    }
    __syncthreads();
}
__device__ __forceinline__ void phaseB(Frame& F, const Args& A, int l) {
    const int b = F.vcu & 3, j = F.vcu >> 2;
    for (int i = 0; i < 8; ++i) { const int c = (i < 4) ? j : 63 - j, g8 = (i < 4) ? i : i; topk_unit(F, b, c * 64 + g8 * 8); }
    poolconv_tile(F, A, l, F.vcu);
}
constexpr int N_PHASES = 17;
__global__ void __launch_bounds__(NWAVES * 64, 2) skel_fwd(Args args) {
    extern __shared__ __attribute__((aligned(16))) unsigned char lds[];
    Frame F;
    F.lds = (LAS unsigned char*)lds;
    F.MISC = (volatile LAS unsigned*)(F.lds + MISC_OFF);
    F.tid = threadIdx.x; F.lane = F.tid & 63; F.wave = __builtin_amdgcn_readfirstlane(F.tid >> 6);
    F.G = gridDim.x; { const int bx = blockIdx.x; F.vcu = (F.G % 8 == 0) ? (bx % 8) * (F.G / 8) + bx / 8 : bx; }
    F.ws = args.ws; F.out = args.out; F.ctl = (gu32*)(args.ws + WS_CTL);
    for (int u = F.tid; u < (LDS_BYTES - LDSCTL_OFF) / 4; u += NWAVES * 64) ((LAS unsigned*)(F.lds + LDSCTL_OFF))[u] = 0u;
    __syncthreads();
    const int lo = args.ph_lo, hi = args.ph_hi;
    const bool multi = (hi - lo) > 1;
    XcdBarrier bar; bar.bar = (unsigned*)(F.ctl + CW_BAR) + args.li * XCD_BAR_WORDS; bar.x = 0; bar.st = nullptr;
    if (multi) bar = xcd_barrier_post((unsigned*)(F.ctl + CW_BAR) + args.li * XCD_BAR_WORDS, F.MISC + 8);
#define FRESH() do { int t_ = threadIdx.x; asm volatile("" : "+v"(t_)); F.tid = t_; F.lane = t_ & 63; F.wave = __builtin_amdgcn_readfirstlane(t_ >> 6); } while (0)
#define IN(k) (lo <= (k) && (k) < hi)
#define SEAM(k) do { if (IN(k) && IN((k) + 1)) xcd_barrier(bar); } while (0)

    if (IN(0)) { FRESH(); p0_prologue(F, args); SEAM(0); }
    for (int l = 0; l < DEPTH; ++l) {
        const int pb = 1 + 8 * l;
        bf16* HB = (bf16*)(F.ws + WS_HB); bf16* PB = (bf16*)(F.ws + WS_PB);
        if (IN(pb + 0)) {
            pg8::Gemm g{HB, (const bf16*)(F.ws + WS_WIN) + (size_t)l * NP * D, T, NP, D}; pg8::StaticOrder S; S.init(T, NP, F.G, (int)blockIdx.x);
            pg8::EpiBf16<0> E{PB, NP, nullptr, 512, 512, C2};
            pg8::gemm_phase<pg8::EpiBf16<0>, pg8::StaticOrder, PG8_ALIGN, PG8_SP2>(F.lds + RING_OFF, g, S, E);
            SEAM(pb + 0);
        }
        if (IN(pb + 1)) { FRESH(); phaseB(F, args, l); SEAM(pb + 1); }
        if (IN(pb + 2)) {
            const attn_body::AttnTensors AT{(const attn_body::bf16*)(PB + PC_Q), (const attn_body::bf16*)(PB + PC_K), (const attn_body::bf16*)(PB + PC_V), (attn_body::bf16*)HB, (const unsigned long long*)(F.ws + WS_MASK)};
            const attn_body::StaticOrder S((int)F.G, (int)blockIdx.x);
            attn_body::attn_phase<attn_body::StaticOrder>((char*)lds + RING_OFF, AT, S);
            SEAM(pb + 2);
        }
        if (IN(pb + 3)) {
            pg8::Gemm g{HB, (const bf16*)(F.ws + WS_WOUT) + (size_t)l * D * D, T, D, D}; pg8::StaticOrder S; S.init(T, D, F.G, (int)blockIdx.x);
            EpiResF32 E{l == 0 ? args.in[I_X] : F.out, F.out, D};
            pg8::gemm_phase<EpiResF32, pg8::StaticOrder, PG8_ALIGN, PG8_SP2>(F.lds + RING_OFF, g, S, E);
            SEAM(pb + 3);
        }
#ifndef MK_NO_R2
        if (IN(pb + 4)) { FRESH(); r2_router(F, args, l); SEAM(pb + 4); }
#endif
        if (IN(pb + 5) || IN(pb + 6)) {
            FRESH(); moe_build_table(F, l);
            MoeSched S; S.tab = (const LAS int*)(F.lds + MOE_TAB_OFF); S.ntiles = __builtin_amdgcn_readfirstlane(S.tab[0]); S.ntx = (S.ntiles + 7) / 8; S.xcd = F.vcu / 32; S.j = F.vcu % 32;
            S.blist = (const int*)(F.ws + WS_BLIST);
            bf16* HID = PB;
#ifndef MK_NO_D1
            if (IN(pb + 5)) {
                S.mode = 1; S.npn = 8; S.Abase = (const char*)HB; S.Bbase = (const char*)(F.ws + WS_WGU) + (size_t)l * 16 * 1024 * 1024 * 2;
                pg8::Gemm2 g{1024, 1024, 1024}; EpiSwiGLU E{HID, (const float*)(F.ws + WS_BW)};
                pg8::gemm_phase2<EpiSwiGLU, MoeSched, true, PG8_ALIGN>(F.lds + RING_OFF, g, S, E);
                SEAM(pb + 5);
            }
#endif
#ifndef MK_NO_D2
            if (IN(pb + 6)) {
                S.mode = 2; S.npn = 4; S.Abase = (const char*)HID; S.Bbase = (const char*)(F.ws + WS_WD) + (size_t)l * 16 * 1024 * 512 * 2;
                pg8::Gemm2 g{1024, 1024, 512}; EpiScatter E{F.out, (const int*)(F.ws + WS_BLIST)};
                pg8::gemm_phase2<EpiScatter, MoeSched, false, PG8_ALIGN>(F.lds + RING_OFF, g, S, E);
                SEAM(pb + 6);
            }
#endif
        }
        if (IN(pb + 7)) {
            FRESH(); const int gw = F.vcu * NWAVES + F.wave, NGW = F.G * NWAVES;
            if (l + 1 < DEPTH) { for (int m = gw; m < T; m += NGW) rms_row_to_bf16(F.out + (size_t)m * D, args.in[I_N1G] + (size_t)(l + 1) * D, HB + (size_t)m * D, F.lane); }
            else { for (int m = gw; m < T; m += NGW) rms_row_f32(F.out + (size_t)m * D, args.in[I_FG], F.lane); }
            SEAM(pb + 7);
        }
    }
#undef IN
#undef SEAM
}
namespace nv {
__device__ __forceinline__ float wave_max(float v) {
#pragma unroll
    for (int o = 1; o < 64; o <<= 1) v = fmaxf(v, __shfl_xor(v, o));
    return v;
}
__device__ __forceinline__ float block_sum256(float v, float* red) {
    v = wave_sum(v);
    __syncthreads();
    if ((threadIdx.x & 63) == 0) red[threadIdx.x >> 6] = v;
    __syncthreads();
    return (red[0] + red[1]) + (red[2] + red[3]);
}
__device__ __forceinline__ float ldb(const bf16* p) { return bf2f(*p); }

__global__ void __launch_bounds__(256) k_index_topk(const bf16* __restrict__ PB, unsigned* __restrict__ mask) {
    __shared__ float qi[512];
    __shared__ float w[8];
    __shared__ float sc[SEQ];
    const int tok = blockIdx.x, b = tok / SEQ, t = tok % SEQ, tid = threadIdx.x, lane = tid & 63, wv = tid >> 6;
    const int n = ((t >> 6) + 1) * 64;
    const bf16* prow = PB + (size_t)tok * NP;
    qi[tid] = ldb(prow + PC_QI + tid); qi[tid + 256] = ldb(prow + PC_QI + 256 + tid);
    if (tid < 8) w[tid] = ldb(prow + PC_WI + tid);
    __syncthreads();
    for (int s = tid; s < n; s += 256) {
        const bf16* kr = PB + (size_t)(b * SEQ + s) * NP + PC_KI;
        float kv[64];
#pragma unroll
        for (int d = 0; d < 64; ++d) kv[d] = ldb(kr + d);
        float score = 0.f;
        for (int h = 0; h < 8; ++h) {
            float dsum = 0.f;
#pragma unroll
            for (int d = 0; d < 64; ++d) dsum += qi[h * 64 + d] * kv[d];
            score += fmaxf(dsum, 0.f) * w[h];
        }
        sc[s] = score;
    }
    __syncthreads();
    unsigned* mrow = mask + (size_t)tok * 128;
    for (int base = 0; base < SEQ; base += 256) {
        const int s = base + wv * 64 + lane;
        bool sel = false;
        if (s < n) {
            if (n <= 256) sel = true;
            else {
                const float v = sc[s];
                int rank = 0;
                for (int j = 0; j < n; ++j) { const float u = sc[j]; rank += (u > v || (u == v && j < s)) ? 1 : 0; }
                sel = rank < 256;
            }
        }
        const unsigned long long bal = __ballot(sel);
        if (lane == 0) { mrow[(base + wv * 64) / 32] = (unsigned)bal; mrow[(base + wv * 64) / 32 + 1] = (unsigned)(bal >> 32); }
    }
}

__global__ void __launch_bounds__(256) k_attn(const bf16* __restrict__ PB, const unsigned* __restrict__ mask, bf16* __restrict__ YB) {
    __shared__ float q[512];
    __shared__ int sel[256];
    __shared__ int pre[129];
    __shared__ float lg[8][256];
    __shared__ float rs[8];
    const int tok = blockIdx.x, b = tok / SEQ, tid = threadIdx.x, lane = tid & 63, wv = tid >> 6;
    const bf16* prow = PB + (size_t)tok * NP;
    q[tid] = ldb(prow + PC_Q + tid); q[tid + 256] = ldb(prow + PC_Q + 256 + tid);
    const unsigned* mrow = mask + (size_t)tok * 128;
    unsigned mw = 0;
    if (tid < 128) mw = mrow[tid];
    if (tid < 128) pre[tid + 1] = __popc(mw);
    if (tid == 0) pre[0] = 0;
    __syncthreads();
    if (tid == 0) { for (int i = 1; i <= 128; ++i) pre[i] += pre[i - 1]; }
    __syncthreads();
    if (tid < 128) { int p = pre[tid]; unsigned m = mw; while (m) { const int bit = __ffs(m) - 1; m &= m - 1; if (p < 256) sel[p] = tid * 32 + bit; ++p; } }
    __syncthreads();
    int cnt = pre[128]; if (cnt > 256) cnt = 256;
    if (tid < cnt) {
        const bf16* kr = PB + (size_t)(b * SEQ + sel[tid]) * NP + PC_K;
        for (int h = 0; h < 8; ++h) {
            float dsum = 0.f;
#pragma unroll
            for (int d = 0; d < 64; ++d) dsum += q[h * 64 + d] * ldb(kr + h * 64 + d);
            lg[h][tid] = dsum;
        }
    }
    __syncthreads();
    for (int hh = 0; hh < 2; ++hh) {
        const int h = wv * 2 + hh;
        float m = -INFINITY;
        for (int j = lane; j < cnt; j += 64) m = fmaxf(m, lg[h][j]);
        m = wave_max(m);
        float s = 0.f;
        for (int j = lane; j < cnt; j += 64) { const float e = exp2f(lg[h][j] - m); lg[h][j] = e; s += e; }
        s = wave_sum(s);
        if (lane == 0) rs[h] = 1.0f / s;
    }
    __syncthreads();
    for (int oo = 0; oo < 2; ++oo) {
        const int o = tid + oo * 256, h = o >> 6;
        float acc = 0.f;
        for (int j = 0; j < cnt; ++j) acc += lg[h][j] * ldb(PB + (size_t)(b * SEQ + sel[j]) * NP + PC_V + o);
        YB[(size_t)tok * D + o] = (bf16)f2bf(acc * rs[h]);
    }
}

__global__ void __launch_bounds__(256) k_pool(const bf16* __restrict__ PB, const float* __restrict__ pw, const float* __restrict__ ps, bf16* __restrict__ YB) {
    __shared__ float d[256];
    const int tok = blockIdx.x, t = tok % SEQ, c = threadIdx.x, g = c >> 6;
    const int win = 2 << g;
    const int cntw = (t + 1 < win) ? (t + 1) : win;
    float s = 0.f;
    for (int j = 0; j < cntw; ++j) s += ldb(PB + (size_t)(tok - j) * NP + PC_POOL + c);
    d[c] = s / (float)cntw - ldb(PB + (size_t)tok * NP + PC_POOL + c);
    __syncthreads();
    const int dout = c & 63;
    float acc = 0.f;
    for (int cc = 0; cc < 64; ++cc) acc += d[g * 64 + cc] * pw[(size_t)(g * 64 + cc) * 64 + dout];
    YB[(size_t)tok * D + 512 + c] = (bf16)f2bf(acc * ps[c]);
}

__global__ void __launch_bounds__(256) k_conv(const bf16* __restrict__ PB, const float* __restrict__ dw_w, const float* __restrict__ dw_b, const float* __restrict__ ln_g,
                                              const float* __restrict__ ln_b, const float* __restrict__ pw_w, const float* __restrict__ pw_b, bf16* __restrict__ YB) {
    __shared__ float sh[256];
    __shared__ float red[4];
    const int tok = blockIdx.x, t = tok % SEQ, c = threadIdx.x;
    float h = dw_b[c];
    for (int j = 0; j < 31; ++j) {
        const int tt = t - 30 + j;
        if (tt >= 0) {
            const bf16* pr = PB + (size_t)(tok - 30 + j) * NP;
            const float a = ldb(pr + PC_CA + c), gt = ldb(pr + PC_CG + c);
            h += a * (1.0f / (1.0f + expf(-gt))) * dw_w[j * 256 + c];
        }
    }
    const float mu = block_sum256(h, red) * (1.0f / 256.0f);
    const float dv = h - mu;
    const float var = block_sum256(dv * dv, red) * (1.0f / 256.0f);
    float y = dv * (1.0f / sqrtf(var + RMS_EPS)) * ln_g[c] + ln_b[c];
    y = y / (1.0f + expf(-y));
    __syncthreads();
    sh[c] = y;
    __syncthreads();
    float acc = pw_b[c];
    for (int k = 0; k < 256; ++k) acc += sh[k] * pw_w[k * 256 + c];
    YB[(size_t)tok * D + 768 + c] = (bf16)f2bf(acc);
}

__global__ void __launch_bounds__(256) k_router(const float* __restrict__ X1, const float* __restrict__ g2, const float* __restrict__ rg_w, const float* __restrict__ rg_b,
                                                const float* __restrict__ re_w, const float* __restrict__ re_b, bf16* __restrict__ H2, int* __restrict__ route_e, float* __restrict__ route_w) {
    __shared__ float red[4];
    __shared__ float part[20][4];
    const int tok = blockIdx.x, tid = threadIdx.x, lane = tid & 63, wv = tid >> 6;
    const float4 v = ((const float4*)(X1 + (size_t)tok * D))[tid];
    float s = v.x * v.x + v.y * v.y + v.z * v.z + v.w * v.w;
    s = block_sum256(s, red);
    const float r = 1.0f / sqrtf(s * (1.0f / D) + RMS_EPS);
    const float4 gv = ((const float4*)g2)[tid];
    float hv[4] = {v.x * r * gv.x, v.y * r * gv.y, v.z * r * gv.z, v.w * r * gv.w};
    ((uint2*)(H2 + (size_t)tok * D))[tid] = make_uint2(pk2(hv[0], hv[1]), pk2(hv[2], hv[3]));
    float lg[20];
#pragma unroll
    for (int j = 0; j < 20; ++j) lg[j] = 0.f;
#pragma unroll
    for (int i = 0; i < 4; ++i) {
        const int k = tid * 4 + i;
#pragma unroll
        for (int j = 0; j < 4; ++j) lg[j] += hv[i] * rg_w[k * 4 + j];
#pragma unroll
        for (int j = 0; j < 16; ++j) lg[4 + j] += hv[i] * re_w[k * 16 + j];
    }
#pragma unroll
    for (int j = 0; j < 20; ++j) { const float x = wave_sum(lg[j]); if (lane == 0) part[j][wv] = x; }
    __syncthreads();
    if (tid == 0) {
        float gl[4], el[16];
        for (int j = 0; j < 4; ++j) gl[j] = (part[j][0] + part[j][1]) + (part[j][2] + part[j][3]) + rg_b[j];
        for (int j = 0; j < 16; ++j) el[j] = (part[4 + j][0] + part[4 + j][1]) + (part[4 + j][2] + part[4 + j][3]) + re_b[j];
        int gs = 0; float gm = gl[0];
        for (int j = 1; j < 4; ++j) if (gl[j] > gm) { gm = gl[j]; gs = j; }
        float gsum = 0.f;
        for (int j = 0; j < 4; ++j) gsum += expf(gl[j] - gm);
        const float pg = 1.0f / gsum;
        float em = el[gs * 4];
        for (int j = 1; j < 4; ++j) em = fmaxf(em, el[gs * 4 + j]);
        float ep[4], esum = 0.f;
        for (int j = 0; j < 4; ++j) { ep[j] = expf(el[gs * 4 + j] - em); esum += ep[j]; }
        for (int j = 0; j < 4; ++j) ep[j] /= esum;
        int i1 = 0; for (int j = 1; j < 4; ++j) if (ep[j] > ep[i1]) i1 = j;
        int i2 = -1; for (int j = 0; j < 4; ++j) if (j != i1 && (i2 < 0 || ep[j] > ep[i2])) i2 = j;
        const float den = ep[i1] + ep[i2];
        route_e[tok * 2] = gs * 4 + i1; route_e[tok * 2 + 1] = gs * 4 + i2;
        route_w[tok * 2] = pg * (ep[i1] / den); route_w[tok * 2 + 1] = pg * (ep[i2] / den);
    }
}

__global__ void __launch_bounds__(256) k_moe(const bf16* __restrict__ H2, const int* __restrict__ route_e, const float* __restrict__ route_w,
                                             const float* __restrict__ w_gate, const float* __restrict__ w_up, const float* __restrict__ w_down,
                                             const float* Xin, float* Xout) {
    __shared__ float xs[1024];
    __shared__ float hid[2][512];
    const int tok = blockIdx.x, tid = threadIdx.x;
#pragma unroll
    for (int i = 0; i < 4; ++i) xs[tid + 256 * i] = ldb(H2 + (size_t)tok * D + tid + 256 * i);
    __syncthreads();
    for (int s = 0; s < 2; ++s) {
        const int e = route_e[tok * 2 + s]; const float gw = route_w[tok * 2 + s];
        const float* Wg = w_gate + (size_t)e * 1024 * 512; const float* Wu = w_up + (size_t)e * 1024 * 512;
        for (int hh = 0; hh < 2; ++hh) {
            const int h = tid + hh * 256;
            float a = 0.f, bb = 0.f;
            for (int k = 0; k < 1024; ++k) { const float x = xs[k]; a += x * Wg[(size_t)k * 512 + h]; bb += x * Wu[(size_t)k * 512 + h]; }
            hid[s][h] = (a / (1.0f + expf(-a))) * bb * gw;
        }
    }
    __syncthreads();
    float acc[4] = {0.f, 0.f, 0.f, 0.f};
    for (int s = 0; s < 2; ++s) {
        const int e = route_e[tok * 2 + s];
        const float* Wd = w_down + (size_t)e * 512 * 1024;
        for (int h = 0; h < 512; ++h) {
            const float hv = hid[s][h];
#pragma unroll
            for (int i = 0; i < 4; ++i) acc[i] += hv * Wd[(size_t)h * 1024 + tid + i * 256];
        }
    }
#pragma unroll
    for (int i = 0; i < 4; ++i) Xout[(size_t)tok * D + tid + i * 256] = Xin[(size_t)tok * D + tid + i * 256] + acc[i];
}
}
#ifndef MK_NAIVE_MASK
#define MK_NAIVE_MASK 0u
#endif
#ifndef MK_FUSE
#define MK_FUSE 1
#endif
static void launch_naive_phase(int ph, void* const* d_in, float* out, unsigned char* ws, hipStream_t stream) {
    const int l = (ph - 1) / 8, k = (ph - 1) % 8;
    const bf16* PB = (const bf16*)(ws + WS_PB); bf16* HB = (bf16*)(ws + WS_HB); unsigned* mask = (unsigned*)(ws + WS_MASK);
    int* route_e = (int*)(ws + WS_ROUTE_E); float* route_w = (float*)(ws + WS_ROUTE_W);
    const float* const* in = (const float* const*)d_in;
    switch (k) {
    case 1:
        nv::k_index_topk<<<T, 256, 0, stream>>>(PB, mask);
        nv::k_pool<<<T, 256, 0, stream>>>(PB, in[I_POOLW] + (size_t)l * 4 * 64 * 64, in[I_POOLS] + (size_t)l * 256, HB);
        nv::k_conv<<<T, 256, 0, stream>>>(PB, in[I_DWW] + (size_t)l * 31 * 256, in[I_DWB] + (size_t)l * 256, in[I_LNG] + (size_t)l * 256, in[I_LNB] + (size_t)l * 256,
                                          in[I_PWW] + (size_t)l * 256 * 256, in[I_PWB] + (size_t)l * 256, HB);
        break;
    case 2: nv::k_attn<<<T, 256, 0, stream>>>(PB, mask, HB); break;
    case 4: nv::k_router<<<T, 256, 0, stream>>>(out, in[I_N2G] + (size_t)l * D, in[I_RGW] + (size_t)l * D * 4, in[I_RGB] + (size_t)l * 4, in[I_REW] + (size_t)l * D * 16, in[I_REB] + (size_t)l * 16, HB, route_e, route_w); break;
    case 5: break;
    case 6: nv::k_moe<<<T, 256, 0, stream>>>(HB, route_e, route_w, in[I_WG] + (size_t)l * 16 * 1024 * 512, in[I_WU] + (size_t)l * 16 * 1024 * 512, in[I_WDN] + (size_t)l * 16 * 512 * 1024, out, out); break;
    default: break;
    }
}
extern "C" void kernel_launch(void* const* d_in, const int* in_sizes, int n_in, void* d_out, int out_size, void* d_ws, size_t ws_size, hipStream_t stream) {
    static int grid = 0;
    if (grid == 0) {
        if (n_in != 21 || in_sizes[0] != T * D || out_size != T * D || ws_size < WS_END) { fprintf(stderr, "kernel_launch: unexpected shapes / workspace (%d inputs, ws %zu)\n", n_in, ws_size); grid = -1; return; }
        int dev = 0, cus = 0, per_cu = 0;
        if (hipGetDevice(&dev) != hipSuccess || hipDeviceGetAttribute(&cus, hipDeviceAttributeMultiprocessorCount, dev) != hipSuccess) { grid = -1; return; }
        if (hipFuncSetAttribute((const void*)skel_fwd, hipFuncAttributeMaxDynamicSharedMemorySize, LDS_BYTES) != hipSuccess) { fprintf(stderr, "kernel_launch: hipFuncSetAttribute failed\n"); grid = -1; return; }
        if (hipOccupancyMaxActiveBlocksPerMultiprocessor(&per_cu, (const void*)skel_fwd, NWAVES * 64, LDS_BYTES) != hipSuccess || per_cu < 1)
            fprintf(stderr, "kernel_launch: note: occupancy query reports %d workgroups per CU\n", per_cu);
        (void)hipGetLastError();
        grid = cus;
    }
    if (grid < 0) return;
    if (hipMemsetAsync((char*)d_ws + WS_CTL, 0, CTL_ZERO_BYTES, stream) != hipSuccess) return;
    Args a{};
    for (int i = 0; i < 21; ++i) a.in[i] = (const float*)d_in[i];
    a.out = (float*)d_out; a.ws = (unsigned char*)d_ws;
    int ph = 0, li = 0;
    while (ph < N_PHASES) {
        if ((MK_NAIVE_MASK >> ph) & 1u) { launch_naive_phase(ph, d_in, (float*)d_out, (unsigned char*)d_ws, stream); ++ph; continue; }
        int hi = ph + 1;
        if (MK_FUSE) while (hi < N_PHASES && !((MK_NAIVE_MASK >> hi) & 1u)) ++hi;
        a.ph_lo = ph; a.ph_hi = hi; a.li = li++;
        hipLaunchKernelGGL(skel_fwd, dim3(grid), dim3(NWAVES * 64), LDS_BYTES, stream, a);
        ph = hi;
    }
}
```

```cpp
#include <hip/hip_runtime.h>
#include <cstdio>
#include <cstdint>
#include <cmath>
#define MK_NAIVE_MASK 0x0u
#define MK_FUSE 1
namespace pg8 {
#define PG8_LAS __attribute__((address_space(3)))
typedef unsigned short bf16_t;
typedef short bf16x8 __attribute__((ext_vector_type(8)));
typedef float f32x4 __attribute__((ext_vector_type(4)));
typedef unsigned u32x4 __attribute__((ext_vector_type(4)));
constexpr int BM = 256, BK = 64, HALF = 128, HTB = HALF * BK * 2  , STAGE_BYTES = 8 * HTB, NXCD = 8, WGM = 8;

__host__ __device__ __forceinline__ int lds_byte(int r, int c) { const int st = (r >> 4) * 2 + (c >> 5), rr = r & 15, cc = c & 31, ob = rr * 64 + cc * 2; return st * 1024 + (ob ^ (((ob >> 9) & 1) << 5)); }
__host__ __device__ __forceinline__ void stage_rc(int b, int& R, int& C) { const int st = b / 1024, sb = b % 1024, swz = sb ^ (((sb >> 9) & 1) << 5); R = (st >> 1) * 16 + swz / 64; C = (st & 1) * 32 + (swz % 64) / 2; }
__host__ __device__ __forceinline__ int perm32(int rho) { const int n = rho >> 4, i = rho & 15; return 8 * (i >> 2) + 4 * n + (i & 3); }

struct Unit { int pm, pn; };
struct Gemm { const bf16_t* A; const bf16_t* Bt; int M, N, K; };

struct StaticOrder {
    int nM, nN, nwg, G, c;
    __host__ __device__ void init(int M, int N, int G_, int c_) { nM = M / BM; nN = N / BM; nwg = nM * nN; G = G_; c = c_; }
    __host__ __device__ bool next(int i, Unit& u) const {
        const long L = (long)i * G + c; if (L >= nwg) return false;
        int wgid = (int)L; { const int q = nwg / NXCD, r = nwg % NXCD, xcd = wgid % NXCD, off = wgid / NXCD; wgid = (xcd < r ? xcd * (q + 1) : r * (q + 1) + (xcd - r) * q) + off; }
        const int nig = WGM * nN, gid = wgid / nig, fm = gid * WGM, gsz = (nM - fm) < WGM ? (nM - fm) : WGM;
        u.pm = fm + ((wgid % nig) % gsz); u.pn = (wgid % nig) / gsz; return true;
    }
    __device__ __forceinline__ void a_ready(const Unit&) const {}
    __device__ __forceinline__ void done(const Unit&) const {}
};

__device__ __forceinline__ unsigned cvt_pk_bf16(float lo, float hi) { unsigned r; asm volatile("v_cvt_pk_bf16_f32 %0, %1, %2" : "=v"(r) : "v"(lo), "v"(hi)); return r; }
typedef float f32x2 __attribute__((ext_vector_type(2)));
__device__ __forceinline__ f32x2 gelu_pk(f32x2 v) {
    const f32x2 av = __builtin_elementwise_abs(v), d = av * 0.2316418882f + 1.0f;
    f32x2 t; t.x = __builtin_amdgcn_rcpf(d.x); t.y = __builtin_amdgcn_rcpf(d.y);
    f32x2 q = t * 0.5307027145f + (-0.7265760135f); q = q * t + 0.7107068705f; q = q * t + (-0.142248368f); q = q * t + 0.127414796f; q = q * t;
    const f32x2 s = (v * v) * (-0.72134752044f);
    f32x2 e; e.x = __builtin_amdgcn_exp2f(s.x); e.y = __builtin_amdgcn_exp2f(s.y);
    const f32x2 m = v * (q * e), r = v - m;
    f32x2 o; o.x = v.x < 0.f ? m.x : r.x; o.y = v.y < 0.f ? m.y : r.y; return o;
}

template <int ACT  > struct EpiBf16 {
    static constexpr bool PERM = true, AFTER_DRAIN = false; static_assert(ACT == 0 || ACT == 1, "EpiBf16: ACT is 0 (none) or 1 (gelu_pk)");
    bf16_t* O; int ldc; const float* bias; int split_cols; size_t split_stride; float scale0;
    __device__ __forceinline__ void operator()(const f32x4 (&acc)[2][2][4][2], const Unit& u, int wr, int wc, int fr, int fq) const {
        const int row0 = u.pm * BM + wr * 64 + fr; int colt = u.pn * BM; bf16_t* base = O;
        float sc = 1.f; if (split_cols) { const int t = colt / split_cols; base += (size_t)t * split_stride; colt -= t * split_cols; if (t == 0) sc = scale0; }
        const int col0 = colt + wc * 32 + 8 * fq, bcol0 = u.pn * BM + wc * 32 + 8 * fq;
        f32x4 bv[2][2];
#pragma unroll
        for (int bj = 0; bj < 2; ++bj)
#pragma unroll
            for (int n = 0; n < 2; ++n) bv[bj][n] = bias ? *(const f32x4*)(bias + bcol0 + bj * HALF + 4 * n) : (f32x4){0.f, 0.f, 0.f, 0.f};
#pragma unroll
        for (int ai = 0; ai < 2; ++ai)
#pragma unroll
            for (int m = 0; m < 4; ++m) { bf16_t* rowp = base + (size_t)(row0 + ai * HALF + m * 16) * ldc + col0;
#pragma unroll
                for (int bj = 0; bj < 2; ++bj) { f32x4 v0 = acc[ai][bj][m][0] + bv[bj][0], v1 = acc[ai][bj][m][1] + bv[bj][1];
                    if (ACT == 1) { f32x2 a = gelu_pk((f32x2){v0[0], v0[1]}), b = gelu_pk((f32x2){v0[2], v0[3]}), c = gelu_pk((f32x2){v1[0], v1[1]}), d = gelu_pk((f32x2){v1[2], v1[3]});
                        v0 = (f32x4){a.x, a.y, b.x, b.y}; v1 = (f32x4){c.x, c.y, d.x, d.y}; }
                    v0 = v0 * sc; v1 = v1 * sc; u32x4 w; w.x = cvt_pk_bf16(v0[0], v0[1]); w.y = cvt_pk_bf16(v0[2], v0[3]); w.z = cvt_pk_bf16(v1[0], v1[1]); w.w = cvt_pk_bf16(v1[2], v1[3]);
                    *(u32x4*)(rowp + bj * HALF) = w; } }
    }
};

struct PanelStats {
    unsigned* xbuf;
    unsigned* cnt;
    unsigned* tmo;
    int ntn; float eps;
    unsigned code;
    __device__ __forceinline__ bool run(const f32x4 (&v)[2][2][4][2], const Unit& u, int wr, int wc, int fr, int fq, PG8_LAS unsigned char* lds, int wid, int lane) const {
        typedef float f32x2v __attribute__((ext_vector_type(2)));
        PG8_LAS f32x2v* P = (PG8_LAS f32x2v*)lds;
        PG8_LAS f32x2v* S = (PG8_LAS f32x2v*)(lds + 8192);
        PG8_LAS unsigned* flag = (PG8_LAS unsigned*)(lds + 8192 + 2048);
#pragma unroll
        for (int ai = 0; ai < 2; ++ai)
#pragma unroll
            for (int m = 0; m < 4; ++m) {
                float s = 0.f;
#pragma unroll
                for (int bj = 0; bj < 2; ++bj)
#pragma unroll
                    for (int n = 0; n < 2; ++n) { const f32x4 x = v[ai][bj][m][n]; s += (x[0] + x[1]) + (x[2] + x[3]); }
                s += __shfl_xor(s, 16); s += __shfl_xor(s, 32);
                const float mw = s * (1.0f / 64.0f); float q = 0.f;
#pragma unroll
                for (int bj = 0; bj < 2; ++bj)
#pragma unroll
                    for (int n = 0; n < 2; ++n) { const f32x4 d = v[ai][bj][m][n] - mw; q += (d[0] * d[0] + d[1] * d[1]) + (d[2] * d[2] + d[3] * d[3]); }
                q += __shfl_xor(q, 16); q += __shfl_xor(q, 32);
                if (fq == 0) P[(ai * HALF + wr * 64 + m * 16 + fr) * 4 + wc] = (f32x2v){mw, q};
            }
        asm volatile("s_waitcnt lgkmcnt(0)" ::: "memory"); __builtin_amdgcn_s_barrier(); asm volatile("" ::: "memory");
#if defined(BROKEN_EXCHANGE_NO_WAIT)
#warning BROKEN CONTROL BUILD: the row-statistics exchange does not wait; results are wrong by design
        if (blockIdx.x >= 64) { const long long t0_ = clock64(); while (clock64() - t0_ < 60000) __builtin_amdgcn_s_sleep(8); }
#endif
        const int row = wid * 32 + (lane & 31);
        if (lane < 32) {
            const f32x2v a = P[row * 4 + 0], b = P[row * 4 + 1], c = P[row * 4 + 2], d = P[row * 4 + 3];
            const float mt = (a.x + b.x + c.x + d.x) * 0.25f;
            const float da = a.x - mt, db = b.x - mt, dc = c.x - mt, dd = d.x - mt;
            const float m2 = (a.y + b.y) + (c.y + d.y) + 64.0f * ((da * da + db * db) + (dc * dc + dd * dd));
            unsigned long long* slot = (unsigned long long*)xbuf + ((size_t)(u.pm * BM + row) * 4 + u.pn);
            __hip_atomic_store(slot, ((unsigned long long)__float_as_uint(m2) << 32) | __float_as_uint(mt), __ATOMIC_RELAXED, __HIP_MEMORY_SCOPE_AGENT);
        }
        asm volatile("s_waitcnt vmcnt(0)" ::: "memory");
        if (lane == 0) __hip_atomic_fetch_add(cnt + 64 * u.pm, 1u, __ATOMIC_RELAXED, __HIP_MEMORY_SCOPE_AGENT);
        if (wid == 0) {
            bool dead = false; const unsigned long long t0 = __builtin_amdgcn_s_memrealtime(); const unsigned want = 8u * (unsigned)ntn;
            for (;;) {
#if defined(BROKEN_EXCHANGE_NO_WAIT)
                break;
#endif
                if ((unsigned)__builtin_amdgcn_readfirstlane(__hip_atomic_load(cnt + 64 * u.pm, __ATOMIC_RELAXED, __HIP_MEMORY_SCOPE_AGENT)) >= want) break;
                if (__builtin_amdgcn_s_memrealtime() - t0 > 2000000ull) {
                    if (lane == 0) { unsigned expect = 0u; __hip_atomic_compare_exchange_strong(tmo + 1, &expect, code | (unsigned)(u.pm & 0xff), __ATOMIC_RELAXED, __ATOMIC_RELAXED, __HIP_MEMORY_SCOPE_AGENT);
                                     __hip_atomic_store(tmo, 1u, __ATOMIC_RELAXED, __HIP_MEMORY_SCOPE_AGENT); }
                    dead = true; break; }
                __builtin_amdgcn_s_sleep(2);
            }
            __builtin_amdgcn_fence(__ATOMIC_ACQUIRE, "agent");
            if (lane == 0) flag[0] = dead ? 1u : 0u;
        }
        asm volatile("s_waitcnt vmcnt(0) lgkmcnt(0)" ::: "memory"); __builtin_amdgcn_s_barrier(); asm volatile("" ::: "memory");
        const bool bad = flag[0] != 0u;
        if (lane < 32) {
            const unsigned long long* slot = (const unsigned long long*)xbuf + (size_t)(u.pm * BM + row) * 4; float mt[4], m2[4]; float ms = 0.f;
#pragma unroll
            for (int t = 0; t < 4; ++t) { if (t < ntn) { const unsigned long long w = __hip_atomic_load(slot + t, __ATOMIC_RELAXED, __HIP_MEMORY_SCOPE_AGENT); mt[t] = __uint_as_float((unsigned)w); m2[t] = __uint_as_float((unsigned)(w >> 32)); } else { mt[t] = 0.f; m2[t] = 0.f; } ms += mt[t]; }
            const float mean = ms / (float)ntn; float q = 0.f;
#pragma unroll
            for (int t = 0; t < 4; ++t) if (t < ntn) { const float dm = mt[t] - mean; q += m2[t] + 256.0f * dm * dm; }
            S[row] = (f32x2v){mean, 1.0f / sqrtf(q / (256.0f * (float)ntn) + eps)};
        }
        asm volatile("s_waitcnt lgkmcnt(0)" ::: "memory"); __builtin_amdgcn_s_barrier(); asm volatile("" ::: "memory");
        return bad;
    }
};
struct EpiLnRes {
    static constexpr bool PERM = false, AFTER_DRAIN = true;
    const float* base; float* out; int ldc; const float* bias; PanelStats st; unsigned poison;
    __device__ __forceinline__ void fused(f32x4 (&acc)[2][2][4][2], const Unit& u, int wr, int wc, int fr, int fq, PG8_LAS unsigned char* lds, int wid, int lane) const {
        typedef float f32x2v __attribute__((ext_vector_type(2)));
        const PG8_LAS f32x2v* S = (const PG8_LAS f32x2v*)(lds + 8192);
        const int col0 = u.pn * BM + wc * 32 + 4 * fq;
#pragma unroll
        for (int bj = 0; bj < 2; ++bj)
#pragma unroll
            for (int n = 0; n < 2; ++n) { const f32x4 bv = bias ? *(const f32x4*)(bias + col0 + bj * HALF + n * 16) : (f32x4){0.f, 0.f, 0.f, 0.f};
#pragma unroll
                for (int ai = 0; ai < 2; ++ai)
#pragma unroll
                    for (int m = 0; m < 4; ++m) acc[ai][bj][m][n] += bv; }
        f32x4 pre[4][2][2];
#pragma unroll
        for (int m = 0; m < 4; ++m) { const size_t off = (size_t)(u.pm * BM + wr * 64 + m * 16 + fr) * ldc + col0;
#pragma unroll
            for (int bj = 0; bj < 2; ++bj)
#pragma unroll
                for (int n = 0; n < 2; ++n) pre[m][bj][n] = *(const f32x4*)(base + off + bj * HALF + n * 16); }
        const bool bad = st.run(acc, u, wr, wc, fr, fq, lds, wid, lane) || poison != 0u;
        const float qnan = __builtin_nanf("");
#pragma unroll
        for (int ai = 0; ai < 2; ++ai)
#pragma unroll
            for (int m = 0; m < 4; ++m) { const int r = ai * HALF + wr * 64 + m * 16 + fr; const f32x2v sr = S[r]; const size_t off = (size_t)(u.pm * BM + r) * ldc + col0;
#pragma unroll
                for (int bj = 0; bj < 2; ++bj)
#pragma unroll
                    for (int n = 0; n < 2; ++n) { const f32x4 bs = ai == 0 ? pre[m][bj][n] : *(const f32x4*)(base + off + bj * HALF + n * 16); f32x4 o = bs + (acc[ai][bj][m][n] - sr.x) * sr.y;
                        if (bad) o = (f32x4){qnan, qnan, qnan, qnan}; *(f32x4*)(out + off + bj * HALF + n * 16) = o; }
                if (m & 1) asm volatile("" ::: "memory"); }
    }
};
struct EpiLnResLn {
    static constexpr bool PERM = false, AFTER_DRAIN = true;
    const float* base; float* out; bf16_t* xn; int ldc; const float* bias; PanelStats st1, st2; unsigned poison;
    __device__ __forceinline__ void fused(f32x4 (&acc)[2][2][4][2], const Unit& u, int wr, int wc, int fr, int fq, PG8_LAS unsigned char* lds, int wid, int lane) const {
        typedef float f32x2v __attribute__((ext_vector_type(2))); typedef unsigned u32x2v __attribute__((ext_vector_type(2)));
        const PG8_LAS f32x2v* S = (const PG8_LAS f32x2v*)(lds + 8192);
        const int col0 = u.pn * BM + wc * 32 + 4 * fq;
#pragma unroll
        for (int bj = 0; bj < 2; ++bj)
#pragma unroll
            for (int n = 0; n < 2; ++n) { const f32x4 bv = bias ? *(const f32x4*)(bias + col0 + bj * HALF + n * 16) : (f32x4){0.f, 0.f, 0.f, 0.f};
#pragma unroll
                for (int ai = 0; ai < 2; ++ai)
#pragma unroll
                    for (int m = 0; m < 4; ++m) acc[ai][bj][m][n] += bv; }
        bool bad = st1.run(acc, u, wr, wc, fr, fq, lds, wid, lane) || poison != 0u;
        const float qnan = __builtin_nanf("");
#pragma unroll
        for (int ai = 0; ai < 2; ++ai)
#pragma unroll
            for (int m = 0; m < 4; ++m) { const int r = ai * HALF + wr * 64 + m * 16 + fr; const f32x2v sr = S[r]; const size_t off = (size_t)(u.pm * BM + r) * ldc + col0;
#pragma unroll
                for (int bj = 0; bj < 2; ++bj)
#pragma unroll
                    for (int n = 0; n < 2; ++n) { const f32x4 bs = *(const f32x4*)(base + off + bj * HALF + n * 16); acc[ai][bj][m][n] = bs + (acc[ai][bj][m][n] - sr.x) * sr.y; }
                asm volatile("" : "+v"(acc[ai][0][m][0]), "+v"(acc[ai][0][m][1]), "+v"(acc[ai][1][m][0]), "+v"(acc[ai][1][m][1]));
                if (m & 1) asm volatile("" ::: "memory"); }
        const bool bad1 = bad;
        bad = st2.run(acc, u, wr, wc, fr, fq, lds, wid, lane) || bad;
#pragma unroll
        for (int ai = 0; ai < 2; ++ai)
#pragma unroll
            for (int m = 0; m < 4; ++m) { const int r = ai * HALF + wr * 64 + m * 16 + fr; const f32x2v sr = S[r]; const size_t off = (size_t)(u.pm * BM + r) * ldc + col0;
#pragma unroll
                for (int bj = 0; bj < 2; ++bj)
#pragma unroll
                    for (int n = 0; n < 2; ++n) { const f32x4 x1 = acc[ai][bj][m][n]; *(f32x4*)(out + off + bj * HALF + n * 16) = bad1 ? (f32x4){qnan, qnan, qnan, qnan} : x1;
                        const f32x4 o = (x1 - sr.x) * sr.y; u32x2v w; w.x = cvt_pk_bf16(o[0], o[1]); w.y = cvt_pk_bf16(o[2], o[3]);
                        if (bad) { w.x = 0x7fc07fc0u; w.y = 0x7fc07fc0u; } *(u32x2v*)(xn + off + bj * HALF + n * 16) = w; }
                asm volatile("" ::: "memory"); }
    }
};

template <class Epi, class Sched, bool ALIGN_EPI = false, bool SP2 = false>
__device__ __forceinline__ void gemm_phase(PG8_LAS unsigned char* lds, const Gemm g, const Sched& S, const Epi& E) {
    int tid_ = threadIdx.x; asm volatile("" : "+v"(tid_));
    const int tid = tid_, wid = __builtin_amdgcn_readfirstlane(tid >> 6), lane = tid & 63, wr = wid >> 2, wc = wid & 3, fr = lane & 15, fq = lane >> 4;
    const int K = g.K, nt = K / BK;
    unsigned voffA[2], voffB[2];
#pragma unroll
    for (int i = 0; i < 2; ++i) { int R, C; stage_rc(tid * 16 + i * 8192, R, C); const int Rb = Epi::PERM ? ((R & ~31) + perm32(R & 31)) : R;
        voffA[i] = (unsigned)(R * K + C) * 2u; voffB[i] = (unsigned)(Rb * K + C) * 2u; }
    const size_t kstep = (size_t)(BK * 2);
    const size_t hstep = (size_t)HALF * K * 2;
    const size_t tstep = 2 * hstep;
    const unsigned ldsw = (unsigned)wid * 1024u;
    const int aoff = lds_byte(wr * 64 + fr, fq * 8), boff = lds_byte(wc * 32 + fr, fq * 8);
#define PG8_SA(b, h) (((b) * 2 + (h)) * HTB)
#define PG8_SB(b, h) ((4 + (b) * 2 + (h)) * HTB)
#define PG8_STAGE(bufoff, gbase, voff) do { _Pragma("unroll") for (int _i = 0; _i < 2; ++_i) \
        __builtin_amdgcn_global_load_lds((const unsigned*)((const char*)(gbase) + (voff)[_i]), (PG8_LAS unsigned*)(lds + (bufoff) + ldsw + _i * 8192), 16, 0, 0); } while (0)
#define PG8_LDA(dst, b, h) do { _Pragma("unroll") for (int m = 0; m < 4; ++m) _Pragma("unroll") for (int k = 0; k < 2; ++k) dst[m][k] = *(const PG8_LAS bf16x8*)(lds + PG8_SA(b, h) + aoff + m * 2048 + k * 1024); } while (0)
#define PG8_LDB(dst, b, h) do { _Pragma("unroll") for (int n = 0; n < 2; ++n) _Pragma("unroll") for (int k = 0; k < 2; ++k) dst[n][k] = *(const PG8_LAS bf16x8*)(lds + PG8_SB(b, h) + boff + n * 2048 + k * 1024); } while (0)
#define PG8_MMA(ai, bj, At, Bt) do { __builtin_amdgcn_s_setprio(1); _Pragma("unroll") for (int m = 0; m < 4; ++m) _Pragma("unroll") for (int n = 0; n < 2; ++n) _Pragma("unroll") for (int k = 0; k < 2; ++k) \
        acc[ai][bj][m][n] = __builtin_amdgcn_mfma_f32_16x16x32_bf16(Bt[n][k], At[m][k], acc[ai][bj][m][n], 0, 0, 0); __builtin_amdgcn_s_setprio(0); } while (0)
#define PG8_WAIT_V(n) asm volatile("s_waitcnt vmcnt(" #n ")" ::: "memory")
#define PG8_WAIT_L(n) asm volatile("s_waitcnt lgkmcnt(" #n ")" ::: "memory")
#define PG8_BAR __builtin_amdgcn_s_barrier()
#define PG8_SCHED __builtin_amdgcn_sched_barrier(0)
    Unit cur, nxt; int ui = 0;
    if (!S.next(0, cur)) return;
    f32x4 acc[2][2][4][2];
#pragma unroll
    for (int a = 0; a < 2; ++a)
#pragma unroll
        for (int b = 0; b < 2; ++b)
#pragma unroll
            for (int m = 0; m < 4; ++m)
#pragma unroll
                for (int n = 0; n < 2; ++n) acc[a][b][m][n] = (f32x4){0.f, 0.f, 0.f, 0.f};
    bf16x8 At[4][2], B0[2][2], B1[2][2];
    const char* cA = (const char*)g.A + (size_t)cur.pm * tstep; const char* cB = (const char*)g.Bt + (size_t)cur.pn * tstep;
    S.a_ready(cur);
    if constexpr (SP2) {
        PG8_STAGE(PG8_SB(0, 0), cB, voffB); PG8_STAGE(PG8_SB(0, 1), cB + hstep, voffB); PG8_STAGE(PG8_SA(0, 0), cA, voffA); PG8_STAGE(PG8_SA(0, 1), cA + hstep, voffA);
        if (wr == 1) PG8_BAR;
        PG8_WAIT_V(2); PG8_BAR;
        PG8_STAGE(PG8_SB(1, 0), cB + kstep, voffB); PG8_STAGE(PG8_SA(1, 0), cA + kstep, voffA); PG8_STAGE(PG8_SB(1, 1), cB + hstep + kstep, voffB);
        PG8_WAIT_V(6); PG8_BAR;
    } else {
        PG8_STAGE(PG8_SB(0, 0), cB, voffB); PG8_STAGE(PG8_SA(0, 0), cA, voffA); PG8_STAGE(PG8_SB(0, 1), cB + hstep, voffB); PG8_STAGE(PG8_SA(0, 1), cA + hstep, voffA);
        if (wr == 1) PG8_BAR;
        PG8_WAIT_V(4); PG8_BAR;
        PG8_STAGE(PG8_SB(1, 0), cB + kstep, voffB); PG8_STAGE(PG8_SA(1, 0), cA + kstep, voffA); PG8_STAGE(PG8_SB(1, 1), cB + hstep + kstep, voffB);
        PG8_WAIT_V(6); PG8_BAR;
    }
    for (;;) {
        const bool has_next = S.next(ui + 1, nxt);
        const char* nA = has_next ? (const char*)g.A + (size_t)nxt.pm * tstep : cA; const char* nB = has_next ? (const char*)g.Bt + (size_t)nxt.pn * tstep : cB;
        for (int t = 0; t < nt; t += 2) {
            const bool last = (t == nt - 2);
            const char* a1 = cA + (size_t)(t + 1) * kstep;
            const char* a2 = last ? nA : cA + (size_t)(t + 2) * kstep; const char* b2 = last ? nB : cB + (size_t)(t + 2) * kstep;
            const char* a3 = a2 + kstep; const char* b3 = b2 + kstep;
            if (last && has_next) S.a_ready(nxt);
            if constexpr (SP2) {
            PG8_LDB(B0, 0, 0); PG8_LDB(B1, 0, 1); PG8_SCHED; PG8_LDA(At, 0, 0); PG8_STAGE(PG8_SA(1, 1), a1 + hstep, voffA);
            PG8_WAIT_V(8); PG8_WAIT_L(0); PG8_BAR; PG8_MMA(0, 0, At, B0); PG8_MMA(0, 1, At, B1); PG8_BAR; PG8_SCHED;
            PG8_LDA(At, 0, 1); PG8_STAGE(PG8_SB(0, 0), b2, voffB); PG8_STAGE(PG8_SB(0, 1), b2 + hstep, voffB); PG8_STAGE(PG8_SA(0, 0), a2, voffA);
            PG8_WAIT_V(8); PG8_WAIT_L(0); PG8_BAR; PG8_MMA(1, 0, At, B0); PG8_MMA(1, 1, At, B1); PG8_BAR; PG8_SCHED;
            PG8_LDB(B0, 1, 0); PG8_LDB(B1, 1, 1); PG8_SCHED; PG8_LDA(At, 1, 0); PG8_STAGE(PG8_SA(0, 1), a2 + hstep, voffA);
            PG8_WAIT_V(8); PG8_WAIT_L(0); PG8_BAR; PG8_MMA(0, 0, At, B0); PG8_MMA(0, 1, At, B1); PG8_BAR; PG8_SCHED;
            PG8_LDA(At, 1, 1); PG8_STAGE(PG8_SB(1, 0), b3, voffB); PG8_STAGE(PG8_SB(1, 1), b3 + hstep, voffB); PG8_STAGE(PG8_SA(1, 0), a3, voffA);
            PG8_WAIT_V(8); PG8_WAIT_L(0); PG8_BAR; PG8_MMA(1, 0, At, B0); PG8_MMA(1, 1, At, B1); PG8_BAR; PG8_SCHED;
            } else {
            PG8_LDB(B0, 0, 0); PG8_SCHED; PG8_LDA(At, 0, 0); PG8_STAGE(PG8_SA(1, 1), a1 + hstep, voffA);
            PG8_WAIT_L(8); PG8_BAR; PG8_WAIT_L(0); PG8_MMA(0, 0, At, B0); PG8_BAR; PG8_SCHED;
            PG8_LDB(B1, 0, 1); PG8_STAGE(PG8_SB(0, 0), b2, voffB);
            PG8_BAR; PG8_WAIT_L(0); PG8_MMA(0, 1, At, B1); PG8_BAR;
            PG8_LDA(At, 0, 1); PG8_STAGE(PG8_SA(0, 0), a2, voffA);
            PG8_BAR; PG8_WAIT_L(0); PG8_MMA(1, 0, At, B0); PG8_BAR; PG8_SCHED;
            PG8_STAGE(PG8_SB(0, 1), b2 + hstep, voffB);
            PG8_WAIT_V(6); PG8_BAR; PG8_MMA(1, 1, At, B1); PG8_BAR;
            PG8_LDB(B0, 1, 0); PG8_SCHED; PG8_LDA(At, 1, 0); PG8_STAGE(PG8_SA(0, 1), a2 + hstep, voffA);
            PG8_WAIT_L(8); PG8_BAR; PG8_WAIT_L(0); PG8_MMA(0, 0, At, B0); PG8_BAR; PG8_SCHED;
            PG8_LDB(B1, 1, 1); PG8_STAGE(PG8_SB(1, 0), b3, voffB);
            PG8_BAR; PG8_WAIT_L(0); PG8_MMA(0, 1, At, B1); PG8_BAR;
            PG8_LDA(At, 1, 1); PG8_STAGE(PG8_SA(1, 0), a3, voffA);
            PG8_BAR; PG8_WAIT_L(0); PG8_MMA(1, 0, At, B0); PG8_BAR; PG8_SCHED;
            PG8_STAGE(PG8_SB(1, 1), b3 + hstep, voffB);
            PG8_WAIT_V(6); PG8_BAR; PG8_MMA(1, 1, At, B1); PG8_BAR;
            }
        }
        if constexpr (ALIGN_EPI) { if (wr == 0) PG8_BAR; }
        if constexpr (!Epi::AFTER_DRAIN) { E(acc, cur, wr, wc, fr, fq); S.done(cur); }
        if (!has_next) break;
#pragma unroll
        for (int a = 0; a < 2; ++a)
#pragma unroll
            for (int b = 0; b < 2; ++b)
#pragma unroll
                for (int m = 0; m < 4; ++m)
#pragma unroll
                    for (int n = 0; n < 2; ++n) acc[a][b][m][n] = (f32x4){0.f, 0.f, 0.f, 0.f};
        cur = nxt; cA = nA; cB = nB; ++ui;
        if constexpr (ALIGN_EPI) { if (wr == 1) PG8_BAR; }
    }
    PG8_WAIT_V(0);
    if constexpr (!ALIGN_EPI) { if (wr == 0) PG8_BAR; }
    PG8_BAR;
    if constexpr (Epi::AFTER_DRAIN) { E.fused(acc, cur, wr, wc, fr, fq, lds, wid, lane); S.done(cur); }
#undef PG8_SA
#undef PG8_SB
#undef PG8_STAGE
#undef PG8_LDA
#undef PG8_LDB
#undef PG8_MMA
#undef PG8_WAIT_V
#undef PG8_WAIT_L
#undef PG8_BAR
#undef PG8_SCHED
}
}
#ifndef PG8_SP2
#define PG8_SP2 true
#endif
#ifndef PG8_ALIGN
#define PG8_ALIGN true
#endif
namespace pg8 {
struct Unit2 { int pm, pn, bk, r0, cnt; };
struct Gemm2 { int K, lda, ldb; };
template <class Epi, class Sched, bool GATHER, bool ALIGN_EPI>
__device__ __forceinline__ void gemm_phase2(PG8_LAS unsigned char* lds, const Gemm2 g, const Sched& S, const Epi& E) {
    int tid_ = threadIdx.x; asm volatile("" : "+v"(tid_));
    const int tid = tid_, wid = __builtin_amdgcn_readfirstlane(tid >> 6), lane = tid & 63, wr = wid >> 2, wc = wid & 3, fr = lane & 15, fq = lane >> 4;
    const int K = g.K, nt = K / BK, jt = nt / 2;
    unsigned voffB[2];
#pragma unroll
    for (int i = 0; i < 2; ++i) { int R, C; stage_rc(tid * 16 + i * 8192, R, C); const int Rb = Epi::PERM ? ((R & ~31) + perm32(R & 31)) : R; voffB[i] = (unsigned)(Rb * g.ldb + C) * 2u; }
    const size_t kstep = (size_t)(BK * 2);
    const size_t hstepB = (size_t)HALF * g.ldb * 2;
    const unsigned ldsw = (unsigned)wid * 1024u;
    const int aoff = lds_byte(wr * 64 + fr, fq * 8), boff = lds_byte(wc * 32 + fr, fq * 8);
#define PG8_SA(b, h) (((b) * 2 + (h)) * HTB)
#define PG8_SB(b, h) ((4 + (b) * 2 + (h)) * HTB)
#define PG8_STAGE(bufoff, gbase, voff) do { _Pragma("unroll") for (int _i = 0; _i < 2; ++_i) \
        __builtin_amdgcn_global_load_lds((const unsigned*)((const char*)(gbase) + (voff)[_i]), (PG8_LAS unsigned*)(lds + (bufoff) + ldsw + _i * 8192), 16, 0, 0); } while (0)
#define PG8_LDA(dst, b, h) do { _Pragma("unroll") for (int m = 0; m < 4; ++m) _Pragma("unroll") for (int k = 0; k < 2; ++k) dst[m][k] = *(const PG8_LAS bf16x8*)(lds + PG8_SA(b, h) + aoff + m * 2048 + k * 1024); } while (0)
#define PG8_LDB(dst, b, h) do { _Pragma("unroll") for (int n = 0; n < 2; ++n) _Pragma("unroll") for (int k = 0; k < 2; ++k) dst[n][k] = *(const PG8_LAS bf16x8*)(lds + PG8_SB(b, h) + boff + n * 2048 + k * 1024); } while (0)
#define PG8_MMA(ai, bj, At, Bt) do { __builtin_amdgcn_s_setprio(1); _Pragma("unroll") for (int m = 0; m < 4; ++m) _Pragma("unroll") for (int n = 0; n < 2; ++n) _Pragma("unroll") for (int k = 0; k < 2; ++k) \
        acc[ai][bj][m][n] = __builtin_amdgcn_mfma_f32_16x16x32_bf16(Bt[n][k], At[m][k], acc[ai][bj][m][n], 0, 0, 0); __builtin_amdgcn_s_setprio(0); } while (0)
#define PG8_WAIT_V(n) asm volatile("s_waitcnt vmcnt(" #n ")" ::: "memory")
#define PG8_WAIT_L(n) asm volatile("s_waitcnt lgkmcnt(" #n ")" ::: "memory")
#define PG8_BAR __builtin_amdgcn_s_barrier()
#define PG8_SCHED __builtin_amdgcn_sched_barrier(0)
#define PG8_AOFF(dst0, dst1, u) do { _Pragma("unroll") for (int _i = 0; _i < 2; ++_i) { int R_, C_; stage_rc(tid * 16 + _i * 8192, R_, C_); \
        if (GATHER) { dst0[_i] = (unsigned)(S.a_row(u, R_) * g.lda + C_) * 2u; dst1[_i] = (unsigned)(S.a_row(u, HALF + R_) * g.lda + C_) * 2u; } \
        else { dst0[_i] = (unsigned)(R_ * g.lda + C_) * 2u; dst1[_i] = (unsigned)((HALF + R_) * g.lda + C_) * 2u; } } } while (0)
    Unit2 cur, nxt; int ui = 0;
    if (!S.next(0, cur)) return;
    f32x4 acc[2][2][4][2];
#pragma unroll
    for (int a = 0; a < 2; ++a)
#pragma unroll
        for (int b = 0; b < 2; ++b)
#pragma unroll
            for (int m = 0; m < 4; ++m)
#pragma unroll
                for (int n = 0; n < 2; ++n) acc[a][b][m][n] = (f32x4){0.f, 0.f, 0.f, 0.f};
    bf16x8 At[4][2], B0[2][2], B1[2][2];
    unsigned vA0[2], vA1[2], nA0[2], nA1[2];
    PG8_AOFF(vA0, vA1, cur);
    const char* cA = S.a_base(cur); const char* cB = S.b_base(cur); long cJ = S.b_jump(cur);
    PG8_STAGE(PG8_SB(0, 0), cB, voffB); PG8_STAGE(PG8_SB(0, 1), cB + hstepB, voffB); PG8_STAGE(PG8_SA(0, 0), cA, vA0); PG8_STAGE(PG8_SA(0, 1), cA, vA1);
    if (wr == 1) PG8_BAR;
    PG8_WAIT_V(2); PG8_BAR;
    PG8_STAGE(PG8_SB(1, 0), cB + kstep, voffB); PG8_STAGE(PG8_SA(1, 0), cA + kstep, vA0); PG8_STAGE(PG8_SB(1, 1), cB + hstepB + kstep, voffB);
    PG8_WAIT_V(6); PG8_BAR;
    for (;;) {
        const bool has_next = S.next(ui + 1, nxt);
        const char* nA = cA; const char* nB = cB;
        if (has_next) { nA = S.a_base(nxt); nB = S.b_base(nxt); }
        if (GATHER && has_next) { PG8_AOFF(nA0, nA1, nxt); }
        else {
#pragma unroll
            for (int i = 0; i < 2; ++i) { nA0[i] = vA0[i]; nA1[i] = vA1[i]; } }
        for (int t = 0; t < nt; t += 2) {
            const bool last = (t == nt - 2);
            const char* a1 = cA + (size_t)(t + 1) * kstep;
            const char* a2 = last ? nA : cA + (size_t)(t + 2) * kstep;
            const char* b2 = last ? nB : cB + (size_t)(t + 2) * kstep + ((t + 2) >= jt ? cJ : 0l);
            const char* a3 = a2 + kstep; const char* b3 = b2 + kstep;
            unsigned w0[2], w1[2];
#pragma unroll
            for (int i = 0; i < 2; ++i) { w0[i] = last ? nA0[i] : vA0[i]; w1[i] = last ? nA1[i] : vA1[i]; }
            PG8_LDB(B0, 0, 0); PG8_LDB(B1, 0, 1); PG8_SCHED; PG8_LDA(At, 0, 0); PG8_STAGE(PG8_SA(1, 1), a1, vA1);
            PG8_WAIT_V(8); PG8_WAIT_L(0); PG8_BAR; PG8_MMA(0, 0, At, B0); PG8_MMA(0, 1, At, B1); PG8_BAR; PG8_SCHED;
            PG8_LDA(At, 0, 1); PG8_STAGE(PG8_SB(0, 0), b2, voffB); PG8_STAGE(PG8_SB(0, 1), b2 + hstepB, voffB); PG8_STAGE(PG8_SA(0, 0), a2, w0);
            PG8_WAIT_V(8); PG8_WAIT_L(0); PG8_BAR; PG8_MMA(1, 0, At, B0); PG8_MMA(1, 1, At, B1); PG8_BAR; PG8_SCHED;
            PG8_LDB(B0, 1, 0); PG8_LDB(B1, 1, 1); PG8_SCHED; PG8_LDA(At, 1, 0); PG8_STAGE(PG8_SA(0, 1), a2, w1);
            PG8_WAIT_V(8); PG8_WAIT_L(0); PG8_BAR; PG8_MMA(0, 0, At, B0); PG8_MMA(0, 1, At, B1); PG8_BAR; PG8_SCHED;
            PG8_LDA(At, 1, 1); PG8_STAGE(PG8_SB(1, 0), b3, voffB); PG8_STAGE(PG8_SB(1, 1), b3 + hstepB, voffB); PG8_STAGE(PG8_SA(1, 0), a3, w0);
            PG8_WAIT_V(8); PG8_WAIT_L(0); PG8_BAR; PG8_MMA(1, 0, At, B0); PG8_MMA(1, 1, At, B1); PG8_BAR; PG8_SCHED;
        }
        if constexpr (ALIGN_EPI) { if (wr == 0) PG8_BAR; }
        E(acc, cur, wr, wc, fr, fq);
        if (!has_next) break;
#pragma unroll
        for (int a = 0; a < 2; ++a)
#pragma unroll
            for (int b = 0; b < 2; ++b)
#pragma unroll
                for (int m = 0; m < 4; ++m)
#pragma unroll
                    for (int n = 0; n < 2; ++n) acc[a][b][m][n] = (f32x4){0.f, 0.f, 0.f, 0.f};
        cur = nxt; cA = nA; cB = nB; cJ = S.b_jump(cur); ++ui;
#pragma unroll
        for (int i = 0; i < 2; ++i) { vA0[i] = nA0[i]; vA1[i] = nA1[i]; }
        if constexpr (ALIGN_EPI) { if (wr == 1) PG8_BAR; }
    }
    PG8_WAIT_V(0);
    if constexpr (!ALIGN_EPI) { if (wr == 0) PG8_BAR; }
    PG8_BAR;
#undef PG8_AOFF
#undef PG8_SA
#undef PG8_SB
#undef PG8_STAGE
#undef PG8_LDA
#undef PG8_LDB
#undef PG8_MMA
#undef PG8_WAIT_V
#undef PG8_WAIT_L
#undef PG8_BAR
#undef PG8_SCHED
}
}
#include <hip/hip_bf16.h>
#include <cmath>
namespace attn_body {
using bf16=__hip_bfloat16;
using bf16x8=__attribute__((ext_vector_type(8)))short;
using s16x4=__attribute__((ext_vector_type(4)))short;
using f32x16=__attribute__((ext_vector_type(16)))float;
using u32x4=__attribute__((ext_vector_type(4)))unsigned;
constexpr int BATCH=4,NHEAD=8,SEQ=4096,D=64,DM=3072,DMO=1024;
constexpr int NW=8,QBLK=32,QB=QBLK*NW,KVBLK=64,NQB=SEQ/QB;
constexpr int ATTN_PITCH=DM, ATTN_UNIT_ROWS=QB;
__device__ __forceinline__ int crow(int r,int hi){return (r&3)+8*(r>>2)+4*hi;}
#define SBAR() __builtin_amdgcn_sched_barrier(0)
__device__ __forceinline__ void bmask(f32x16&p0,f32x16&p1,unsigned lo32,unsigned hi32,int hi){
  const unsigned a=lo32>>(4*hi), b=hi32>>(4*hi);
  #pragma unroll
  for(int r=0;r<16;++r){const unsigned bit=1u<<((r&3)+8*(r>>2)); if(!(a&bit))p0[r]=-1024.0f; if(!(b&bit))p1[r]=-1024.0f;}
}
typedef unsigned u32x2m __attribute__((ext_vector_type(2)));
__device__ __forceinline__ void mload(u32x2m&dst,const unsigned long long*base,unsigned off){ asm volatile("global_load_dwordx2 %0, %1, %2":"=v"(dst):"v"(off),"s"(base):"memory"); }

constexpr int NSLOT=3, SLOTB=8192;
constexpr int LDS_K=0, LDS_V=NSLOT*SLOTB, LDS_WS=2*NSLOT*SLOTB, LDS_OST=LDS_WS+NW*64*4, LDS_BYTES=LDS_OST+NW*4096;
constexpr float C2=0.125f*1.4426950408889634f;
__device__ __forceinline__ void glds16(const void*sbase,unsigned voff,unsigned lds_dst){unsigned keep;
  asm volatile("s_mov_b32 %0, m0\n\ts_mov_b32 m0, %2\n\ts_nop 0\n\tglobal_load_lds_dwordx4 %1, %3\n\ts_mov_b32 m0, %0":"=&s"(keep):"v"(voff),"s"(lds_dst),"s"(sbase):"memory");}
__device__ __forceinline__ float max3f(float a,float b,float c){float r;asm("v_max3_f32 %0, %1, %2, %3":"=v"(r):"v"(a),"v"(b),"v"(c));return r;}
__device__ __forceinline__ float max2f(float a,float b){float r;asm("v_max_f32_e32 %0, %1, %2":"=v"(r):"v"(a),"v"(b));return r;}
__device__ __forceinline__ float fadd_s(float a,float b){float r;asm("v_add_f32_e32 %0, %1, %2":"=v"(r):"v"(a),"v"(b));return r;}
__device__ __forceinline__ float fsub_s(float a,float b){float r;asm("v_sub_f32_e32 %0, %1, %2":"=v"(r):"v"(a),"v"(b));return r;}
typedef float f32x2_t __attribute__((ext_vector_type(2))); typedef __bf16 bf16x2_t __attribute__((ext_vector_type(2)));
__device__ __forceinline__ unsigned cvtpk_s(float lo,float hi){f32x2_t v={lo,hi};bf16x2_t b=__builtin_convertvector(v,bf16x2_t);return __builtin_bit_cast(unsigned,b);}
#define WAIT_BAR(N) asm volatile("s_waitcnt vmcnt(" #N ") lgkmcnt(0)\n\ts_barrier":::"memory")

__device__ __forceinline__ void qkt(f32x16&p0,f32x16&p1,const char*Kslot,const bf16x8*qr,const f32x16&negm,int r32,int hi){
  const char*kb=Kslot+hi*1024+r32*16;
  #pragma unroll
  for(int d0=0;d0<4;++d0){
    const bf16x8 b0=*reinterpret_cast<const bf16x8*>(kb+d0*2048);
    const bf16x8 b1=*reinterpret_cast<const bf16x8*>(kb+d0*2048+512);
    if(d0==0){p0=__builtin_amdgcn_mfma_f32_32x32x16_bf16(b0,qr[0],negm,0,0,0);p1=__builtin_amdgcn_mfma_f32_32x32x16_bf16(b1,qr[0],negm,0,0,0);}
    else{p0=__builtin_amdgcn_mfma_f32_32x32x16_bf16(b0,qr[d0],p0,0,0,0);p1=__builtin_amdgcn_mfma_f32_32x32x16_bf16(b1,qr[d0],p1,0,0,0);}}
}
typedef __attribute__((address_space(3))) const char* lds_cptr;
typedef short v4i16_t __attribute__((ext_vector_type(4)));
__device__ __forceinline__ void kload8(bf16x8*kf,lds_cptr kp){
  kf[0]=*(const __attribute__((address_space(3))) bf16x8*)(kp);      kf[1]=*(const __attribute__((address_space(3))) bf16x8*)(kp+512);
  kf[2]=*(const __attribute__((address_space(3))) bf16x8*)(kp+2048); kf[3]=*(const __attribute__((address_space(3))) bf16x8*)(kp+2560);
  kf[4]=*(const __attribute__((address_space(3))) bf16x8*)(kp+4096); kf[5]=*(const __attribute__((address_space(3))) bf16x8*)(kp+4608);
  kf[6]=*(const __attribute__((address_space(3))) bf16x8*)(kp+6144); kf[7]=*(const __attribute__((address_space(3))) bf16x8*)(kp+6656);
}
__device__ __forceinline__ void kload2(bf16x8*kf,lds_cptr kp,int j){ kf[2*j]=*(const __attribute__((address_space(3))) bf16x8*)(kp+j*2048); kf[2*j+1]=*(const __attribute__((address_space(3))) bf16x8*)(kp+j*2048+512); }
__device__ __forceinline__ s16x4 vtr(lds_cptr p){ return __builtin_bit_cast(s16x4,__builtin_amdgcn_ds_read_tr16_b64_v4i16((__attribute__((address_space(3))) v4i16_t*)p)); }
__device__ __forceinline__ float rowmax(const f32x16&p0,const f32x16&p1){
  float a=max3f(p0[0],p0[1],p1[0]),b=max3f(p0[2],p0[3],p1[1]);a=max3f(a,p1[2],p1[3]);
  #pragma unroll
  for(int r=4;r<16;r+=4){a=max3f(a,p0[r],p0[r+1]);b=max3f(b,p0[r+2],p0[r+3]);a=max3f(a,p1[r],p1[r+1]);b=max3f(b,p1[r+2],p1[r+3]);}
  const float m=max2f(a,b);
  auto rr=__builtin_amdgcn_permlane32_swap(__float_as_uint(m),__float_as_uint(m),false,false);
  return max2f(__uint_as_float(rr[0]),__uint_as_float(rr[1]));
}
__device__ __forceinline__ void pv(f32x16*o,int vb,bf16x8 pa0,bf16x8 pa1,bf16x8 pa2,bf16x8 pa3){
  #pragma unroll
  for(int d0=0;d0<2;++d0){s16x4 lo[4],hi[4];
    #pragma unroll
    for(int ks=0;ks<4;++ks){
      asm volatile("ds_read_b64_tr_b16 %0,%1 offset:%c2":"=&v"(lo[ks]):"v"(vb),"i"(d0*4096+ks*1024):"memory");
      asm volatile("ds_read_b64_tr_b16 %0,%1 offset:%c2":"=&v"(hi[ks]):"v"(vb),"i"(d0*4096+ks*1024+512):"memory");}
    asm volatile("s_waitcnt lgkmcnt(0)":::"memory");SBAR();
    #define PK(k) (bf16x8){lo[k][0],lo[k][1],lo[k][2],lo[k][3],hi[k][0],hi[k][1],hi[k][2],hi[k][3]}
    o[d0]=__builtin_amdgcn_mfma_f32_32x32x16_bf16(pa0,PK(0),o[d0],0,0,0);
    o[d0]=__builtin_amdgcn_mfma_f32_32x32x16_bf16(pa1,PK(1),o[d0],0,0,0);
    o[d0]=__builtin_amdgcn_mfma_f32_32x32x16_bf16(pa2,PK(2),o[d0],0,0,0);
    o[d0]=__builtin_amdgcn_mfma_f32_32x32x16_bf16(pa3,PK(3),o[d0],0,0,0);
    #undef PK
  }
}

#ifndef ATTN_STORE16
#define ATTN_STORE16(p,v) (*(u32x4*)(p)=(v))
#endif
template<int THRL> __device__ __forceinline__ void attn_unit(int b,int h,int qb,const bf16*Q,const bf16*__restrict__ K,const bf16*__restrict__ V,bf16*O,const unsigned long long*MK,char*shm){
  int tid_=threadIdx.x; asm volatile("":"+v"(tid_));
  const int tid=tid_,lane=tid&63,r32=lane&31,hi=lane>>5; const int wid=__builtin_amdgcn_readfirstlane(tid>>6);
  const long rowbase=(long)b*SEQ; const int q0=qb*QB;
  const bf16*Qw=Q+(rowbase+q0+wid*QBLK)*DM+h*D;
  const bf16*Kh=K+rowbase*DM+h*D,*Vh=V+rowbase*DM+h*D;
  const unsigned lds0=(unsigned)(uintptr_t)shm;
  float*wsf=(float*)(shm+LDS_WS)+wid*64;
  const bf16*ksb=Kh+wid*8; const unsigned kvo=(unsigned)lane*(DM*2u);
  const bf16*vsb=Vh+(long)(16*(wid&3))*DM+(wid>>2)*32; const unsigned vvo=(unsigned)(lane>>2)*(DM*2u)+(unsigned)(lane&3)*16u;
  const unsigned kdst=lds0+LDS_K+wid*1024, vdst=lds0+LDS_V+wid*1024;
  #define DMA_K(t,slot) glds16(ksb+(long)(t)*KVBLK*DM,kvo,(unsigned)__builtin_amdgcn_readfirstlane(kdst+(slot)))
  #define DMA_V(t,slot) glds16(vsb+(long)(t)*KVBLK*DM,vvo,(unsigned)__builtin_amdgcn_readfirstlane(vdst+(slot)))
  const int vb0=(int)(lds0+LDS_V)+((lane>>4)&1)*32+(lane&3)*8+(4*hi+((lane&15)>>2))*64;
  const char*Kbase=shm+LDS_K; bf16x8 kf[8];
  const lds_cptr shm3=(lds_cptr)shm; const lds_cptr kp0=shm3+LDS_K+hi*1024+r32*16; const lds_cptr vp0=shm3+LDS_V+((lane>>4)&1)*32+(lane&3)*8+(4*hi+((lane&15)>>2))*64;
  const int NT=(q0+QB)/KVBLK;
  const unsigned long long*mbase=MK+((rowbase+q0+wid*QBLK)<<6);
  const unsigned moff=(unsigned)r32*512u;
  u32x2m mE,mO; mload(mE,mbase,moff); mload(mO,mbase,moff+8u);
  DMA_K(0,0);DMA_V(0,0);DMA_K(1,SLOTB);
  bf16x8 qr[4];
  #pragma unroll
  for(int d0=0;d0<4;++d0)qr[d0]=*reinterpret_cast<const bf16x8*>(&Qw[(long)r32*DM+d0*16+hi*8]);
  float mhat=0.f,l_reg=0.f;f32x16 o[2];o[0]=f32x16{};o[1]=f32x16{};f32x16 negm=f32x16{};asm volatile("":"+v"(negm));
  const int qrel=wid*QBLK+r32;
  #define CMASK(P0,P1,M) do{ asm volatile("":"+v"(M)); bmask(P0,P1,M[0],M[1],hi); }while(0)
  bool resc=false;
  #define START(P0,P1) do{ const float rm=rowmax(P0,P1); resc=false; \
    { const float dl=rm; mhat=fadd_s(mhat,dl); \
      _Pragma("unroll") for(int r=0;r<16;++r){P0[r]=fsub_s(P0[r],dl);P1[r]=fsub_s(P1[r],dl);} \
      _Pragma("unroll") for(int r=0;r<16;++r)negm[r]=-mhat; asm volatile("":"+v"(negm)); } \
    _Pragma("unroll") for(int r=0;r<16;++r)P0[r]=__builtin_amdgcn_exp2f(P0[r]); }while(0)
  #define RESC() do{ if(resc){ asm volatile("s_waitcnt lgkmcnt(0)":::"memory"); \
      _Pragma("unroll") for(int d_=0;d_<2;++d_) _Pragma("unroll") for(int r=0;r<16;++r)o[d_][r]*=wsf[crow(r,hi)]; } }while(0)
  f32x16 pA0,pA1,pB0,pB1;
  int sl_prev=0,sl_cur=0,sl_next=SLOTB;
  #define ROT() do{sl_prev=sl_cur;sl_cur=sl_next;sl_next=(sl_next==(NSLOT-1)*SLOTB)?0:sl_next+SLOTB;}while(0)
  DMA_K(2,2*SLOTB);
  WAIT_BAR(3);
  qkt(pA0,pA1,Kbase,qr,negm,r32,hi);asm volatile("s_nop 15\n\ts_nop 7":"+v"(pA0),"+v"(pA1));CMASK(pA0,pA1,mE);
  START(pA0,pA1);
  _Pragma("unroll") for(int r=0;r<16;++r)pA1[r]=__builtin_amdgcn_exp2f(pA1[r]);
  WAIT_BAR(0);
  DMA_K(3,0);DMA_V(1,SLOTB);
  ROT();
  kload8(kf,kp0+sl_cur);
  WAIT_BAR(2);
  s16x4 vlo[8],vhi[8]; u32x4 pw0,pw1,pw2,pw3;
  #define PKW(P,B) cvtpk_s(P[B],P[B+1])
  #define PAF(k) __builtin_bit_cast(bf16x8,pw##k)
  #define VFR(i) (bf16x8){vlo[i][0],vlo[i][1],vlo[i][2],vlo[i][3],vhi[i][0],vhi[i][1],vhi[i][2],vhi[i][3]}
  #define PIN(x) asm volatile("":"+v"(x))
  #define MX3(a,b,c) __builtin_fmaxf(__builtin_fmaxf((a),(b)),(c))
  #define GAPA(MF,A0,A1,A2,A3,W0,W1,PW) do{ MF; sacc+=A0; sacc+=A1; sacc+=A2; sacc+=A3; PIN(sacc); W0; W1; PIN(PW); SBAR(); }while(0)
  #define EX(v) __builtin_amdgcn_exp2f(v)
  #define GAPB(MF,X,B) do{ MF; X[B]=EX(X[B]); X[B+1]=EX(X[B+1]); X[B+2]=EX(X[B+2]); X[B+3]=EX(X[B+3]); PIN(X); SBAR(); }while(0)
  #define VRD(i) do{ vlo[i]=vtr(vp_+(((i)>>2)*4096+((i)&3)*1024)); vhi[i]=vtr(vp_+(((i)>>2)*4096+((i)&3)*1024+512)); }while(0)
  #define KRD(G,j) do{ if(G){ kload2(kf,kp0+sl_next,j); SBAR(); } }while(0)
  #define STEP(C0,C1,P0,P1,t,GK,GV,GL,MC,MN,GM) do{ SBAR(); \
    if(GM){ mload(MN,mbase,moff+8u*(unsigned)((t)+1)); } \
    const lds_cptr vp_=vp0+sl_prev; \
    VRD(0); SBAR(); float sacc=(P0[0]+P0[1]); \
    GAPA(C0=__builtin_amdgcn_mfma_f32_32x32x16_bf16(kf[0],qr[0],negm,0,0,0), P0[2],P0[3],P0[4],P0[5],     pw0[0]=PKW(P0,0), pw0[1]=PKW(P0,2), pw0); \
    VRD(4); SBAR(); GAPA(C1=__builtin_amdgcn_mfma_f32_32x32x16_bf16(kf[1],qr[0],negm,0,0,0), P0[6],P0[7],P0[8],P0[9],     pw0[2]=PKW(P0,4), pw0[3]=PKW(P0,6), pw0); \
    VRD(1); SBAR(); GAPA(C0=__builtin_amdgcn_mfma_f32_32x32x16_bf16(kf[2],qr[1],C0,0,0,0),   P0[10],P0[11],P0[12],P0[13], pw1[0]=PKW(P0,8), pw1[1]=PKW(P0,10), pw1); \
    VRD(5); SBAR(); GAPA(C1=__builtin_amdgcn_mfma_f32_32x32x16_bf16(kf[3],qr[1],C1,0,0,0),   P0[14],P0[15],P1[0],P1[1],   pw1[2]=PKW(P0,12),pw1[3]=PKW(P0,14), pw1); \
    VRD(2); SBAR(); GAPA(C0=__builtin_amdgcn_mfma_f32_32x32x16_bf16(kf[4],qr[2],C0,0,0,0),   P1[2],P1[3],P1[4],P1[5],     pw2[0]=PKW(P1,0), pw2[1]=PKW(P1,2), pw2); \
    VRD(6); SBAR(); GAPA(C1=__builtin_amdgcn_mfma_f32_32x32x16_bf16(kf[5],qr[2],C1,0,0,0),   P1[6],P1[7],P1[8],P1[9],     pw2[2]=PKW(P1,4), pw2[3]=PKW(P1,6), pw2); \
    VRD(3); SBAR(); GAPA(C0=__builtin_amdgcn_mfma_f32_32x32x16_bf16(kf[6],qr[3],C0,0,0,0),   P1[10],P1[11],P1[12],P1[13], pw3[0]=PKW(P1,8), pw3[1]=PKW(P1,10), pw3); \
    VRD(7); SBAR(); GAPA(C1=__builtin_amdgcn_mfma_f32_32x32x16_bf16(kf[7],qr[3],C1,0,0,0),   P1[14],P1[15],0.f,0.f,       pw3[2]=PKW(P1,12),pw3[3]=PKW(P1,14), pw3); \
    l_reg+=sacc; \
    if(GK){DMA_K((t)+3,sl_cur);} if(GV){DMA_V((t)+1,sl_next);} \
    CMASK(C0,C1,MC); \
    { float a=MX3(C0[0],C0[1],C1[0]),b=MX3(C0[2],C0[3],C1[1]); a=MX3(a,C1[2],C1[3]); \
      _Pragma("unroll") for(int r=4;r<16;r+=4){a=MX3(a,C0[r],C0[r+1]);b=MX3(b,C0[r+2],C0[r+3]);a=MX3(a,C1[r],C1[r+1]);b=MX3(b,C1[r+2],C1[r+3]);} \
      float rm=__builtin_fmaxf(a,b); { auto rr=__builtin_amdgcn_permlane32_swap(__float_as_uint(rm),__float_as_uint(rm),false,false); rm=__builtin_fmaxf(__uint_as_float(rr[0]),__uint_as_float(rr[1])); } \
      resc=false; \
      if(__builtin_expect(__any(rm>(float)THRL),0)){ const float dl=__builtin_fmaxf(rm,0.f); mhat+=dl; \
        _Pragma("unroll") for(int r=0;r<16;++r){C0[r]-=dl;C1[r]-=dl;} \
        _Pragma("unroll") for(int r=0;r<16;++r)negm[r]=-mhat; asm volatile("":"+v"(negm)); \
        const float f=__builtin_amdgcn_exp2f(-dl); l_reg*=f; if(hi==0)wsf[r32]=f; resc=true; } } \
    SBAR(); \
    GAPB(o[0]=__builtin_amdgcn_mfma_f32_32x32x16_bf16(PAF(0),VFR(0),o[0],0,0,0), C0,0); \
    GAPB(o[1]=__builtin_amdgcn_mfma_f32_32x32x16_bf16(PAF(0),VFR(4),o[1],0,0,0), C0,4); \
    KRD(GL,0); GAPB(o[0]=__builtin_amdgcn_mfma_f32_32x32x16_bf16(PAF(1),VFR(1),o[0],0,0,0), C0,8); \
    KRD(GL,1); GAPB(o[1]=__builtin_amdgcn_mfma_f32_32x32x16_bf16(PAF(1),VFR(5),o[1],0,0,0), C0,12); \
    KRD(GL,2); GAPB(o[0]=__builtin_amdgcn_mfma_f32_32x32x16_bf16(PAF(2),VFR(2),o[0],0,0,0), C1,0); \
    KRD(GL,3); GAPB(o[1]=__builtin_amdgcn_mfma_f32_32x32x16_bf16(PAF(2),VFR(6),o[1],0,0,0), C1,4); \
    GAPB(o[0]=__builtin_amdgcn_mfma_f32_32x32x16_bf16(PAF(3),VFR(3),o[0],0,0,0), C1,8); \
    GAPB(o[1]=__builtin_amdgcn_mfma_f32_32x32x16_bf16(PAF(3),VFR(7),o[1],0,0,0), C1,12); \
    }while(0)
  int t=1;
  for(;t+5<NT;t+=2){
    STEP(pB0,pB1,pA0,pA1,t,true,true,true,mO,mE,true);     WAIT_BAR(2); RESC(); ROT();
    STEP(pA0,pA1,pB0,pB1,t+1,true,true,true,mE,mO,true);   WAIT_BAR(2); RESC(); ROT();
  }
  #define ENDW(tt) do{ if((tt)+3<NT){WAIT_BAR(2);} else if((tt)+2<NT){WAIT_BAR(1);} else {WAIT_BAR(0);} }while(0)
  for(;t+1<NT;t+=2){
    STEP(pB0,pB1,pA0,pA1,t,(t+3<NT),(t+1<NT),(t+1<NT),mO,mE,true);       ENDW(t);   RESC(); ROT();
    STEP(pA0,pA1,pB0,pB1,t+1,(t+4<NT),(t+2<NT),(t+2<NT),mE,mO,true);     ENDW(t+1); RESC(); ROT();
  }
  STEP(pB0,pB1,pA0,pA1,NT-1,false,false,false,mO,mE,false); RESC();
  { float sacc=pB0[0]+pB0[1]; _Pragma("unroll") for(int r=2;r<16;++r)sacc+=pB0[r]; _Pragma("unroll") for(int r=0;r<16;++r)sacc+=pB1[r]; l_reg+=sacc;
    pw0=(u32x4){PKW(pB0,0),PKW(pB0,2),PKW(pB0,4),PKW(pB0,6)};pw1=(u32x4){PKW(pB0,8),PKW(pB0,10),PKW(pB0,12),PKW(pB0,14)};pw2=(u32x4){PKW(pB1,0),PKW(pB1,2),PKW(pB1,4),PKW(pB1,6)};pw3=(u32x4){PKW(pB1,8),PKW(pB1,10),PKW(pB1,12),PKW(pB1,14)};
    SBAR(); pv(o,vb0+sl_cur,PAF(0),PAF(1),PAF(2),PAF(3)); }
  #undef PKW
  #undef PAF
  #undef VFR
  #undef PIN
  #undef MX3
  #undef GAPA
  #undef GAPB
  #undef EX
  #undef VRD
  #undef KRD
  #undef STEP
  #undef ENDW
  {auto rr=__builtin_amdgcn_permlane32_swap(__float_as_uint(l_reg),__float_as_uint(l_reg),false,false);l_reg=__uint_as_float(rr[0])+__uint_as_float(rr[1]);}
  int lane_e=lane; asm volatile("":"+v"(lane_e));
  const int r32e=lane_e&31,hie=lane_e>>5;
  if(hie==0)wsf[32+r32e]=l_reg;asm volatile("s_waitcnt lgkmcnt(0)":::"memory");
  float rli[16];
  #pragma unroll
  for(int r=0;r<16;++r)rli[r]=__builtin_amdgcn_rcpf(wsf[32+crow(r,hie)]);
  bf16*Ow=O+(rowbase+q0+wid*QBLK)*DMO+h*D;
  { bf16*stg=(bf16*)(shm+LDS_OST)+wid*2048;
    #pragma unroll
    for(int r=0;r<16;++r){const int orow=crow(r,hie);
      #pragma unroll
      for(int d0=0;d0<2;++d0)stg[orow*64+d0*32+r32e]=__float2bfloat16(o[d0][r]*rli[r]);}
    asm volatile("s_waitcnt lgkmcnt(0)":::"memory");
    #pragma unroll
    for(int i=0;i<4;++i){const int row=i*8+(lane_e>>3),ch=lane_e&7; const u32x4 v=*(const u32x4*)(stg+row*64+ch*8); ATTN_STORE16(Ow+(long)row*DMO+ch*8,v);} }
  asm volatile("s_waitcnt lgkmcnt(0)\n\ts_barrier":::"memory");
  #undef DMA_K
  #undef DMA_V
  #undef CMASK
  #undef START
  #undef RESC
  #undef ROT
}
constexpr int ATTN_LDS_BYTES=LDS_BYTES;
struct AttnTensors { const bf16* Q; const bf16* K; const bf16* V; bf16* O; const unsigned long long* MK; };
struct AttnUnit { int bh; int qb; };
struct StaticOrder {
  int vcu;
  __device__ __forceinline__ explicit StaticOrder(int grid,int block):vcu((block%8)*(grid/8)+block/8){}
  __device__ __forceinline__ bool next(int i,AttnUnit&u)const{ if(i>=2)return false; const int s=vcu&7; u.bh=vcu>>3; u.qb=(i==0)?15-s:s; return true; }
  __device__ __forceinline__ void a_ready(const AttnUnit&)const{}
  __device__ __forceinline__ void done(const AttnUnit&)const{}
};
template<class Sched,int THRL=8> __device__ __forceinline__ void attn_phase(char*lds,const AttnTensors&T,const Sched&S){
  AttnUnit u;
  for(int i=0;S.next(i,u);++i){ S.a_ready(u); attn_unit<THRL>(u.bh/NHEAD,u.bh%NHEAD,u.qb,T.Q,T.K,T.V,T.O,T.MK,lds); S.done(u); }
}
#undef SBAR
#undef WAIT_BAR
}
#define GAS __attribute__((address_space(1)))
#define LAS __attribute__((address_space(3)))
typedef unsigned short bf16;
typedef unsigned v4u __attribute__((ext_vector_type(4)));
typedef float f32x4 __attribute__((ext_vector_type(4)));
typedef short bf16x8 __attribute__((ext_vector_type(8)));
typedef GAS unsigned gu32;
typedef GAS unsigned long long gu64;
#define RLX_AGENT __ATOMIC_RELAXED, __HIP_MEMORY_SCOPE_AGENT
#define LDS_WAIT() asm volatile("s_waitcnt lgkmcnt(0)" ::: "memory")
#define VM_WAIT() asm volatile("s_waitcnt vmcnt(0)" ::: "memory")
__device__ __forceinline__ unsigned long long rt() { return __builtin_amdgcn_s_memrealtime(); }
__device__ __forceinline__ unsigned f2bf(float f) { unsigned u = __builtin_bit_cast(unsigned, f); return (u + 0x7fffu + ((u >> 16) & 1u)) >> 16; }
__device__ __forceinline__ unsigned pk2(float lo, float hi) { return f2bf(lo) | (f2bf(hi) << 16); }

#define XB_TMO      128
#define XB_XCNT(j)  (256  + 64 * (j))
#define XB_XSUB(j)  (1280 + 64 * (j))
#define XB_XGEN(j)  (2304 + 64 * (j))
#define XB_TOP      3328
#define XB_TOPGEN   3392
#define XCD_BAR_WORDS 3456
#define XB_SPIN_CAP (1u << 18)

__device__ __forceinline__ unsigned xb_ld(unsigned* p)              { return __hip_atomic_load(p, __ATOMIC_RELAXED, __HIP_MEMORY_SCOPE_AGENT); }
__device__ __forceinline__ unsigned xb_add(unsigned* p, unsigned v) { return __hip_atomic_fetch_add(p, v, __ATOMIC_RELAXED, __HIP_MEMORY_SCOPE_AGENT); }
__device__ __forceinline__ unsigned xb_xcc_id() { return (unsigned)__builtin_amdgcn_s_getreg((3 << 11) | 20) & 0xFu; }
#define XB_SPIN(cond, bar) do { unsigned _sp = 0; while (cond) { __builtin_amdgcn_s_sleep(1); \
    if ((++_sp & 255u) == 0u) { if (xb_ld(&(bar)[XB_TMO])) break; if (_sp > XB_SPIN_CAP) { atomicAdd(&(bar)[XB_TMO], 1u); break; } } } } while (0)

struct XcdBarrier {
    unsigned* bar; unsigned x;
    volatile LAS unsigned* st;
};

__device__ __forceinline__ XcdBarrier xcd_barrier_post(unsigned* bar, volatile LAS unsigned* st) {
    XcdBarrier b; b.bar = bar; b.x = xb_xcc_id(); b.st = st;
    if (threadIdx.x == 0) (void)xb_add(&bar[XB_XCNT(b.x)], 1u);
    return b;
}
__device__ __forceinline__ void xcd_barrier_complete(unsigned* bar, unsigned x, unsigned& nloc, unsigned& nx) {
    const unsigned G = gridDim.x * gridDim.y * gridDim.z;
    unsigned sum, cnt, mine, sp = 0u;
    for (;;) {
        sum = 0u; cnt = 0u; mine = 0u;
#pragma unroll
        for (unsigned j = 0; j < 16; ++j) { const unsigned c = xb_ld(&bar[XB_XCNT(j)]); sum += c; cnt += (c > 0u) ? 1u : 0u; mine = (j == x) ? c : mine; }
        if (sum == G) break;
        __builtin_amdgcn_s_sleep(1);
        if ((++sp & 255u) == 0u) { if (xb_ld(&bar[XB_TMO])) break; if (sp > XB_SPIN_CAP) { atomicAdd(&bar[XB_TMO], 1u); break; } }
    }
    nloc = mine > 0u ? mine : 1u; nx = cnt > 0u ? cnt : 1u;
}

__device__ __forceinline__ void xcd_barrier(const XcdBarrier& b) {
    asm volatile("s_waitcnt vmcnt(0)" ::: "memory");
    __syncthreads();
    if (threadIdx.x == 0) {
        unsigned* bar = b.bar;
        __builtin_amdgcn_s_waitcnt(0);
        unsigned nloc = b.st[0], nx = b.st[1];
        if (nloc == 0u) { xcd_barrier_complete(bar, b.x, nloc, nx); b.st[0] = nloc; b.st[1] = nx; }
        const unsigned old = xb_add(&bar[XB_XSUB(b.x)], 1u);
        const unsigned gen = old / nloc;
        if (old + 1u == (gen + 1u) * nloc) {
            __builtin_amdgcn_fence(__ATOMIC_RELEASE, "agent");
            asm volatile("s_waitcnt vmcnt(0)" ::: "memory");
            const unsigned og = xb_add(&bar[XB_TOP], 1u);
            const unsigned tg = og / nx;
            if (og + 1u == (tg + 1u) * nx) xb_add(&bar[XB_TOPGEN], 1u);
            else XB_SPIN(xb_ld(&bar[XB_TOPGEN]) == tg, bar);
            __builtin_amdgcn_fence(__ATOMIC_ACQUIRE, "agent");
            xb_add(&bar[XB_XGEN(b.x)], 1u);
            asm volatile("s_waitcnt vmcnt(0)" ::: "memory");
        } else {
            XB_SPIN(xb_ld(&bar[XB_XGEN(b.x)]) == gen, bar);
            __builtin_amdgcn_fence(__ATOMIC_ACQUIRE, "agent");
            asm volatile("s_waitcnt vmcnt(0)" ::: "memory");
        }
    }
    __syncthreads();
}
constexpr int NWAVES = 8;
constexpr int BATCH = 4, SEQ = 4096, T = BATCH * SEQ, D = 1024, DEPTH = 2;
constexpr int NIN = 2888, NP = 3072;
constexpr int PC_Q = 0, PC_K = 512, PC_V = 1024, PC_QI = 1536, PC_POOL = 2048, PC_CA = 2304, PC_CG = 2560, PC_KI = 2816, PC_WI = 2880;
constexpr int SC_KI = 2048, SC_WI = 2112, SC_POOL = 2120, SC_CONV = 2376;
constexpr float RMS_EPS = 1e-6f;
constexpr float C2 = 0.125f * 1.4426950408889634f;

constexpr size_t MiB = 1u << 20;
constexpr size_t WS_CTL = 0, CTL_ZERO_BYTES = 1 * MiB;
constexpr size_t WS_WIN = 2 * MiB;
constexpr size_t WS_WOUT = 14 * MiB;
constexpr size_t WS_WGU = 18 * MiB;
constexpr size_t WS_WD = 82 * MiB;
constexpr size_t WS_SMALL = 114 * MiB;
constexpr size_t WS_POOLWT = WS_SMALL, WS_PWWT = WS_SMALL + 64 * 1024;
constexpr size_t WS_ROUTE_E = WS_SMALL + 512 * 1024;
constexpr size_t WS_ROUTE_W = WS_SMALL + 768 * 1024;
constexpr size_t WS_KIF = 116 * MiB;
constexpr size_t WS_HB = 118 * MiB;
constexpr size_t WS_PB = 150 * MiB;
constexpr size_t WS_MASK = 246 * MiB;
constexpr size_t WS_BLIST = 254 * MiB;
constexpr size_t WS_BW = 256 * MiB;
constexpr size_t WS_END = 260 * MiB;

constexpr int CW_TMO = 0, CW_CODE = 1;
constexpr int CW_BAR = 4096;
constexpr int CW_BCNT = 131072;

constexpr int RING_OFF = 0, RING_BYTES = 131072;
constexpr int LDSCTL_OFF = RING_BYTES, MISC_OFF = LDSCTL_OFF + 320;
constexpr int LDS_BYTES = 163840;

struct Args { const float* in[21]; float* out; unsigned char* ws; int ph_lo, ph_hi, li, pad; };
struct Frame {
    LAS unsigned char* lds;
    volatile LAS unsigned* MISC;
    gu32* ctl;
    int tid, lane, wave;
    int vcu, G;
    float* out;
    unsigned char* ws;
};
enum { I_X = 0, I_N1G, I_WIN, I_POOLW, I_POOLS, I_DWW, I_DWB, I_LNG, I_LNB, I_PWW, I_PWB, I_WOUT, I_N2G, I_RGW, I_RGB, I_REW, I_REB, I_WG, I_WU, I_WDN, I_FG };

__device__ __forceinline__ float wave_sum(float v, int lane) {
#pragma unroll
    for (int o = 1; o < 64; o <<= 1) v += __int_as_float(__builtin_amdgcn_ds_bpermute((lane ^ o) << 2, __float_as_int(v)));
    return v;
}
__device__ __forceinline__ float bf2f(unsigned short b) { return __uint_as_float((unsigned)b << 16); }

__device__ __forceinline__ void p0_transpose_item(const float* W, int ldw, int c0, int Kd, bf16* WT, int row_off, int row_mul, LAS float* scr, int kb, int nb, int lane) {
    const int k0 = 64 * kb, n0 = 32 * nb;
#pragma unroll 8
    for (int i = 0; i < 32; ++i) { const int kk = 2 * i + (lane >> 5); scr[kk * 33 + (lane & 31)] = W[(size_t)(k0 + kk) * ldw + c0 + n0 + (lane & 31)]; }
    LDS_WAIT(); asm volatile("" ::: "memory");
    const int c = lane & 7;
#pragma unroll
    for (int j = 0; j < 4; ++j) { const int n = (lane >> 3) + 8 * j; const LAS float* s = scr + (8 * c) * 33 + n;
        v4u o; o.x = pk2(s[0 * 33], s[1 * 33]); o.y = pk2(s[2 * 33], s[3 * 33]); o.z = pk2(s[4 * 33], s[5 * 33]); o.w = pk2(s[6 * 33], s[7 * 33]);
        *(GAS v4u*)(WT + (size_t)(row_off + (n0 + n) * row_mul) * Kd + k0 + 8 * c) = o; }
    LDS_WAIT(); asm volatile("" ::: "memory");
}
__device__ __forceinline__ void rms_row_to_bf16(const float* xrow, const float* g, bf16* orow, int lane) {
    const GAS f32x4* xr = (const GAS f32x4*)xrow + lane; const GAS f32x4* gr = (const GAS f32x4*)g + lane;
    f32x4 v[4]; float s = 0.f;
#pragma unroll
    for (int j = 0; j < 4; ++j) { v[j] = xr[64 * j]; s += (v[j].x * v[j].x + v[j].y * v[j].y) + (v[j].z * v[j].z + v[j].w * v[j].w); }
    const float rstd = 1.f / sqrtf(wave_sum(s, lane) * (1.f / D) + RMS_EPS);
    GAS unsigned long long* o8 = (GAS unsigned long long*)orow + lane;
#pragma unroll
    for (int j = 0; j < 4; ++j) { const f32x4 gv = gr[64 * j];
        o8[64 * j] = (unsigned long long)pk2(v[j].x * rstd * gv.x, v[j].y * rstd * gv.y) | ((unsigned long long)pk2(v[j].z * rstd * gv.z, v[j].w * rstd * gv.w) << 32); }
}
__device__ __forceinline__ void rms_row_f32(float* xrow, const float* g, int lane) {
    GAS f32x4* xr = (GAS f32x4*)xrow + lane; const GAS f32x4* gr = (const GAS f32x4*)g + lane;
    f32x4 v[4]; float s = 0.f;
#pragma unroll
    for (int j = 0; j < 4; ++j) { v[j] = xr[64 * j]; s += (v[j].x * v[j].x + v[j].y * v[j].y) + (v[j].z * v[j].z + v[j].w * v[j].w); }
    const float rstd = 1.f / sqrtf(wave_sum(s, lane) * (1.f / D) + RMS_EPS);
#pragma unroll
    for (int j = 0; j < 4; ++j) { const f32x4 gv = gr[64 * j]; xr[64 * j] = (f32x4){v[j].x * rstd * gv.x, v[j].y * rstd * gv.y, v[j].z * rstd * gv.z, v[j].w * rstd * gv.w}; }
}

__device__ __forceinline__ void p0_prologue(Frame& F, const Args& A) {
    LAS float* scr = (LAS float*)(F.lds + RING_OFF + F.wave * 16384);
    const int gw = F.vcu * NWAVES + F.wave, NGW = F.G * NWAVES, lane = F.lane;
    bf16* Win_t = (bf16*)(F.ws + WS_WIN); bf16* Wout_t = (bf16*)(F.ws + WS_WOUT); bf16* Wgu_t = (bf16*)(F.ws + WS_WGU); bf16* Wd_t = (bf16*)(F.ws + WS_WD);
    bf16* pool_wt = (bf16*)(F.ws + WS_POOLWT); bf16* pw_wt = (bf16*)(F.ws + WS_PWWT);
    constexpr int I_IN0 = 16 * 64, I_IN1 = 16 * 8, I_IN2 = 16 * 16, I_IN3 = 16 * 2;
    constexpr int I_OUT = 16 * 32, I_G = 16 * 256, I_U = 16 * 256, I_DN = 16 * 256, I_PL = 4 * 2, I_PW = 4 * 8;
    constexpr int PER_L = I_IN0 + I_IN1 + I_IN2 + I_IN3 + I_OUT + I_G + I_U + I_DN + I_PL + I_PW;
    for (int it = gw; it < DEPTH * PER_L; it += NGW) {
        const int l = it / PER_L; int r = it % PER_L;
        const float* w_in = A.in[I_WIN] + (size_t)l * D * NIN; bf16* wt = Win_t + (size_t)l * NP * D;
        if (r < I_IN0) { p0_transpose_item(w_in, NIN, 0, D, wt, 0, 1, scr, r / 64, r % 64, lane); continue; } r -= I_IN0;
        if (r < I_IN1) { p0_transpose_item(w_in, NIN, SC_POOL, D, wt, PC_POOL, 1, scr, r / 8, r % 8, lane); continue; } r -= I_IN1;
        if (r < I_IN2) { p0_transpose_item(w_in, NIN, SC_CONV, D, wt, PC_CA, 1, scr, r / 16, r % 16, lane); continue; } r -= I_IN2;
        if (r < I_IN3) { p0_transpose_item(w_in, NIN, SC_KI, D, wt, PC_KI, 1, scr, r / 2, r % 2, lane); continue; } r -= I_IN3;
        if (r < I_OUT) { p0_transpose_item(A.in[I_WOUT] + (size_t)l * D * D, D, 0, D, Wout_t + (size_t)l * D * D, 0, 1, scr, r / 32, r % 32, lane); continue; } r -= I_OUT;
        if (r < I_G) { const int e = r / 256, q = r % 256; p0_transpose_item(A.in[I_WG] + ((size_t)l * 16 + e) * 1024 * 512, 512, 0, 1024, Wgu_t + ((size_t)l * 16 + e) * 1024 * 1024, 0, 2, scr, q / 16, q % 16, lane); continue; } r -= I_G;
        if (r < I_U) { const int e = r / 256, q = r % 256; p0_transpose_item(A.in[I_WU] + ((size_t)l * 16 + e) * 1024 * 512, 512, 0, 1024, Wgu_t + ((size_t)l * 16 + e) * 1024 * 1024, 1, 2, scr, q / 16, q % 16, lane); continue; } r -= I_U;
        if (r < I_DN) { const int e = r / 256, q = r % 256; p0_transpose_item(A.in[I_WDN] + ((size_t)l * 16 + e) * 512 * 1024, 1024, 0, 512, Wd_t + ((size_t)l * 16 + e) * 1024 * 512, 0, 1, scr, q / 32, q % 32, lane); continue; } r -= I_DN;
        if (r < I_PL) { const int g = r / 2; p0_transpose_item(A.in[I_POOLW] + ((size_t)l * 4 + g) * 64 * 64, 64, 0, 64, pool_wt + ((size_t)l * 4 + g) * 64 * 64, 0, 1, scr, 0, r % 2, lane); continue; } r -= I_PL;
        p0_transpose_item(A.in[I_PWW] + (size_t)l * 256 * 256, 256, 0, 256, pw_wt + (size_t)l * 256 * 256, 0, 1, scr, r / 8, r % 8, lane);
    }
    for (int it = gw; it < DEPTH * 192; it += NGW) {
        const int l = it / 192, rr = it % 192;
        bf16* dst = Win_t + ((size_t)l * NP + PC_WI + rr) * D;
        const float* w_in = A.in[I_WIN] + (size_t)l * D * NIN;
#pragma unroll
        for (int j = 0; j < 16; ++j) { const int k = lane + 64 * j; dst[k] = (rr < 8) ? (bf16)f2bf(w_in[(size_t)k * NIN + SC_WI + rr]) : (bf16)0; }
    }
    bf16* HB = (bf16*)(F.ws + WS_HB);
    for (int m = gw; m < T; m += NGW) rms_row_to_bf16(A.in[I_X] + (size_t)m * D, A.in[I_N1G], HB + (size_t)m * D, lane);
}

struct EpiResF32 {
    static constexpr bool PERM = false, AFTER_DRAIN = false;
    const float* base; float* out; int ldc;
    __device__ __forceinline__ void operator()(const pg8::f32x4 (&acc)[2][2][4][2], const pg8::Unit& u, int wr, int wc, int fr, int fq) const {
        const int col0 = u.pn * pg8::BM + wc * 32 + 4 * fq;
#pragma unroll
        for (int ai = 0; ai < 2; ++ai)
#pragma unroll
            for (int m = 0; m < 4; ++m) { const size_t off = (size_t)(u.pm * pg8::BM + ai * pg8::HALF + wr * 64 + m * 16 + fr) * ldc + col0;
#pragma unroll
                for (int bj = 0; bj < 2; ++bj)
#pragma unroll
                    for (int n = 0; n < 2; ++n) { const pg8::f32x4 bs = *(const pg8::f32x4*)(base + off + bj * pg8::HALF + n * 16); *(pg8::f32x4*)(out + off + bj * pg8::HALF + n * 16) = bs + acc[ai][bj][m][n]; } }
    }
};


constexpr int MOE_TAB_OFF = LDSCTL_OFF + 1024;
__device__ __forceinline__ int pair_lo(int p) { return p < 3 ? 0 : (p < 5 ? 1 : 2); }
__device__ __forceinline__ int pair_hi(int p) { return p < 3 ? p + 1 : (p < 5 ? p - 1 : 3); }

__device__ __forceinline__ void r2_router(Frame& F, const Args& A, int l) {
    LAS float* Wt = (LAS float*)(F.lds + RING_OFF);
    const float* rg = A.in[I_RGW] + (size_t)l * D * 4; const float* re = A.in[I_REW] + (size_t)l * D * 16;
    for (int e = F.tid; e < D * 4; e += NWAVES * 64) Wt[(e & 3) * 1024 + (e >> 2)] = rg[e];
    for (int e = F.tid; e < D * 16; e += NWAVES * 64) Wt[(4 + (e & 15)) * 1024 + (e >> 4)] = re[e];
    __syncthreads();
    const int gw = F.vcu * NWAVES + F.wave, NGW = F.G * NWAVES, lane = F.lane;
    bf16* HB = (bf16*)(F.ws + WS_HB); int* blist = (int*)(F.ws + WS_BLIST); float* bw = (float*)(F.ws + WS_BW);
    const float* g2 = A.in[I_N2G] + (size_t)l * D; const float* rgb = A.in[I_RGB] + l * 4; const float* reb = A.in[I_REB] + l * 16;
    for (int m = gw; m < T; m += NGW) {
        const GAS f32x4* xr = (const GAS f32x4*)(F.out + (size_t)m * D) + lane; const GAS f32x4* gr = (const GAS f32x4*)g2 + lane;
        f32x4 v[4]; float s = 0.f;
#pragma unroll
        for (int j = 0; j < 4; ++j) { v[j] = xr[64 * j]; s += (v[j].x * v[j].x + v[j].y * v[j].y) + (v[j].z * v[j].z + v[j].w * v[j].w); }
        const float rstd = 1.f / sqrtf(wave_sum(s, lane) * (1.f / D) + RMS_EPS);
        GAS unsigned long long* o8 = (GAS unsigned long long*)(HB + (size_t)m * D) + lane;
#pragma unroll
        for (int j = 0; j < 4; ++j) { const f32x4 gv = gr[64 * j]; v[j] = (f32x4){v[j].x * rstd * gv.x, v[j].y * rstd * gv.y, v[j].z * rstd * gv.z, v[j].w * rstd * gv.w};
            o8[64 * j] = (unsigned long long)pk2(v[j].x, v[j].y) | ((unsigned long long)pk2(v[j].z, v[j].w) << 32); }
        float lg[20];
#pragma unroll
        for (int q = 0; q < 20; ++q) { float a = 0.f;
#pragma unroll
            for (int j = 0; j < 4; ++j) { const f32x4 w = *(const LAS f32x4*)(Wt + q * 1024 + 4 * lane + 256 * j); a += (v[j].x * w.x + v[j].y * w.y) + (v[j].z * w.z + v[j].w * w.w); }
            lg[q] = wave_sum(a, lane); __builtin_amdgcn_sched_barrier(0); }
        float gl[4];
#pragma unroll
        for (int j = 0; j < 4; ++j) gl[j] = lg[j] + rgb[j];
        int gs = 0; float gm = gl[0];
#pragma unroll
        for (int j = 1; j < 4; ++j) if (gl[j] > gm) { gm = gl[j]; gs = j; }
        float gsum = 0.f;
#pragma unroll
        for (int j = 0; j < 4; ++j) gsum += expf(gl[j] - gm);
        const float pg = 1.0f / gsum;
        float el[4];
#pragma unroll
        for (int j = 0; j < 4; ++j) { const float e0 = lg[4 + j] + reb[j], e1 = lg[8 + j] + reb[4 + j], e2 = lg[12 + j] + reb[8 + j], e3 = lg[16 + j] + reb[12 + j]; el[j] = gs == 0 ? e0 : (gs == 1 ? e1 : (gs == 2 ? e2 : e3)); }
        float em = fmaxf(fmaxf(el[0], el[1]), fmaxf(el[2], el[3]));
        float ep[4], esum = 0.f;
#pragma unroll
        for (int j = 0; j < 4; ++j) { ep[j] = expf(el[j] - em); esum += ep[j]; }
#pragma unroll
        for (int j = 0; j < 4; ++j) ep[j] /= esum;
        int i1 = 0; float p1 = ep[0];
#pragma unroll
        for (int j = 1; j < 4; ++j) if (ep[j] > p1) { p1 = ep[j]; i1 = j; }
        int i2 = -1; float p2 = -1.f;
#pragma unroll
        for (int j = 0; j < 4; ++j) if (j != i1 && ep[j] > p2) { p2 = ep[j]; i2 = j; }
        const float den = p1 + p2; const float w1 = pg * (p1 / den), w2 = pg * (p2 / den);
        const int lo = i1 < i2 ? i1 : i2, hi = i1 < i2 ? i2 : i1;
        const int pidx = lo == 0 ? hi - 1 : (lo == 1 ? hi + 1 : 5);
        const int bk = gs * 6 + pidx;
        if (lane == 0) {
            const unsigned pos = __hip_atomic_fetch_add((unsigned*)(F.ctl + CW_BCNT + (l * 24 + bk) * 64), 1u, __ATOMIC_RELAXED, __HIP_MEMORY_SCOPE_AGENT);
            blist[(size_t)bk * T + pos] = m;
            bw[((size_t)bk * T + pos) * 2] = i1 < i2 ? w1 : w2; bw[((size_t)bk * T + pos) * 2 + 1] = i1 < i2 ? w2 : w1;
        }
    }
}
__device__ __forceinline__ void moe_build_table(Frame& F, int l) {
    LAS int* tab = (LAS int*)(F.lds + MOE_TAB_OFF);
    if (F.tid == 0) {
        int nt = 0;
        for (int b = 0; b < 24; ++b) {
            const int c = (int)__hip_atomic_load((unsigned*)(F.ctl + CW_BCNT + (l * 24 + b) * 64), __ATOMIC_RELAXED, __HIP_MEMORY_SCOPE_AGENT);
            tab[128 + b] = c;
            const int ntb = (c + 255) >> 8;
            for (int i = 0; i < ntb && nt < 96; ++i) tab[8 + nt++] = (b << 16) | i;
        }
        tab[0] = nt;
    }
    __syncthreads();
}
struct MoeSched {
    const LAS int* tab; int ntiles, ntx, npn, xcd, j, mode;
    const int* blist; const char* Abase; const char* Bbase;
    __device__ __forceinline__ bool next(int i, pg8::Unit2& u) const {
        const int m = i * 32 + j, tl = m / npn, tg = xcd * ntx + tl;
        if (tl >= ntx || tg >= ntiles) return false;
        const int e = __builtin_amdgcn_readfirstlane(tab[8 + tg]);
        u.pm = tg; u.pn = m % npn; u.bk = e >> 16; u.r0 = (e & 0xffff) * 256; u.cnt = __builtin_amdgcn_readfirstlane(tab[128 + (e >> 16)]);
        return true;
    }
    __device__ __forceinline__ int expert(const pg8::Unit2& u, int which) const { const int g = u.bk / 6, p = u.bk % 6; return g * 4 + (which ? pair_hi(p) : pair_lo(p)); }
    __device__ __forceinline__ const char* a_base(const pg8::Unit2& u) const { return mode == 1 ? Abase : Abase + (size_t)u.pm * 256 * 1024 * 2; }
    __device__ __forceinline__ const char* b_base(const pg8::Unit2& u) const {
        if (mode == 1) return Bbase + ((size_t)expert(u, u.pn >> 2) * 1024 + (size_t)(u.pn & 3) * 256) * 1024 * 2;
        return Bbase + ((size_t)expert(u, 0) * 1024 + (size_t)u.pn * 256) * 512 * 2;
    }
    __device__ __forceinline__ long b_jump(const pg8::Unit2& u) const { return mode == 1 ? 0l : (long)(expert(u, 1) - expert(u, 0)) * 1024 * 512 * 2 - 8 * 128; }
    __device__ __forceinline__ int a_row(const pg8::Unit2& u, int r) const { int q = u.r0 + r; q = q < u.cnt ? q : u.cnt - 1; return blist[(size_t)u.bk * T + q]; }
};
__device__ __forceinline__ float silu_f(float a) { return a * __builtin_amdgcn_rcpf(1.0f + __builtin_amdgcn_exp2f(-1.4426950408889634f * a)); }
struct EpiSwiGLU {
    static constexpr bool PERM = true;
    bf16* HID; const float* bw;
    __device__ __forceinline__ void operator()(const pg8::f32x4 (&acc)[2][2][4][2], const pg8::Unit2& u, int wr, int wc, int fr, int fq) const {
        const int half = u.pn >> 2, hc0 = half * 512 + (u.pn & 3) * 128 + wc * 16 + 4 * fq;
#pragma unroll
        for (int ai = 0; ai < 2; ++ai)
#pragma unroll
            for (int m = 0; m < 4; ++m) { const int r = ai * 128 + wr * 64 + m * 16 + fr; int q = u.r0 + r; q = q < u.cnt ? q : u.cnt - 1;
                const float w = bw[((size_t)u.bk * T + q) * 2 + half];
                bf16* rowp = HID + (size_t)(u.pm * 256 + r) * 1024 + hc0;
#pragma unroll
                for (int bj = 0; bj < 2; ++bj) { const pg8::f32x4 v0 = acc[ai][bj][m][0], v1 = acc[ai][bj][m][1];
                    const float h0 = silu_f(v0[0]) * v0[1] * w, h1 = silu_f(v0[2]) * v0[3] * w, h2 = silu_f(v1[0]) * v1[1] * w, h3 = silu_f(v1[2]) * v1[3] * w;
                    *(uint2*)(rowp + bj * 64) = make_uint2(pg8::cvt_pk_bf16(h0, h1), pg8::cvt_pk_bf16(h2, h3)); } }
    }
};
struct EpiScatter {
    static constexpr bool PERM = false;
    float* out; const int* blist;
    __device__ __forceinline__ void operator()(const pg8::f32x4 (&acc)[2][2][4][2], const pg8::Unit2& u, int wr, int wc, int fr, int fq) const {
        const int col0 = u.pn * 256 + wc * 32 + 4 * fq;
#pragma unroll
        for (int ai = 0; ai < 2; ++ai)
#pragma unroll
            for (int m = 0; m < 4; ++m) { const int r = ai * 128 + wr * 64 + m * 16 + fr; const int q = u.r0 + r;
                if (q < u.cnt) { const int tok = blist[(size_t)u.bk * T + q]; float* rowp = out + (size_t)tok * D + col0;
#pragma unroll
                    for (int bj = 0; bj < 2; ++bj)
#pragma unroll
                        for (int n = 0; n < 2; ++n) { pg8::f32x4* p = (pg8::f32x4*)(rowp + bj * 128 + n * 16); *p = *p + acc[ai][bj][m][n]; } } }
    }
};

#ifndef MK_PROBE
#define MK_PROBE 0
#endif
#define PROBE_T0(id) unsigned long long pt0_##id = 0; if (MK_PROBE == (id)) pt0_##id = __builtin_amdgcn_s_memrealtime()
#define PROBE_T1(id) do { if (MK_PROBE == (id)) { const unsigned long long pt1_ = __builtin_amdgcn_s_memrealtime(); if (blockIdx.x == 4 && threadIdx.x == 0) { gu32* w_ = F.ctl + 3; *(volatile GAS unsigned*)w_ = *(volatile GAS unsigned*)w_ + (unsigned)(pt1_ - pt0_##id); } } } while (0)
typedef float f32x16 __attribute__((ext_vector_type(16)));
typedef unsigned u32x2 __attribute__((ext_vector_type(2)));
constexpr int SC_OFF = RING_OFF;
constexpr int HIST_OFF = LDSCTL_OFF + 2560;
constexpr int MM_OFF = LDSCTL_OFF + 1792;
constexpr int QST_OFF = HIST_OFF + 8192;
constexpr int CAND_OFF = HIST_OFF;
__device__ __forceinline__ int bperm_i(int v, int srclane) { return __builtin_amdgcn_ds_bpermute(srclane << 2, v); }
__device__ __forceinline__ float shxr_f(float v, int lane, int o) { return __int_as_float(bperm_i(__float_as_int(v), lane ^ o)); }
__device__ __forceinline__ float bcast_f(float v, int src) { return __int_as_float(__builtin_amdgcn_readlane(__float_as_int(v), src)); }
__device__ __forceinline__ int bcast_i(int v, int src) { return __builtin_amdgcn_readlane(v, src); }
typedef float f32x2c __attribute__((ext_vector_type(2)));
__device__ __forceinline__ unsigned wave_sum_u(unsigned x) {
    x += (unsigned)__builtin_amdgcn_update_dpp(0, (int)x, 0xB1, 0xf, 0xf, false);
    x += (unsigned)__builtin_amdgcn_update_dpp(0, (int)x, 0x4E, 0xf, 0xf, false);
    x += (unsigned)__builtin_amdgcn_update_dpp(0, (int)x, 0x141, 0xf, 0xf, false);
    x += (unsigned)__builtin_amdgcn_update_dpp(0, (int)x, 0x140, 0xf, 0xf, false);
    return (unsigned)(__builtin_amdgcn_readlane((int)x, 0) + __builtin_amdgcn_readlane((int)x, 16) + __builtin_amdgcn_readlane((int)x, 32) + __builtin_amdgcn_readlane((int)x, 48));
}
__device__ __forceinline__ unsigned wave_excl_scan_u(unsigned x, int lane) {
    unsigned s = x;
#pragma unroll
    for (int o = 1; o < 64; o <<= 1) { const unsigned t = (unsigned)bperm_i((int)s, (lane - o) & 63); if (lane >= o) s += t; }
    return s - x;
}
struct TkOps { bf16x8 af[2][4]; bf16x8 wv[2][2]; };
struct TkStage { v4u q; v4u w; };
__device__ __forceinline__ void topk_stage_load(TkStage& s, const GAS bf16* PBg, size_t tb, int t0, int tid) {
    s.q = *(const GAS v4u*)(PBg + (tb + t0 + (tid >> 6)) * NP + PC_QI + (tid & 63) * 8);
    s.w = (v4u){0u, 0u, 0u, 0u};
    if (tid < 8) s.w = *(const GAS v4u*)(PBg + (tb + t0 + tid) * NP + PC_WI);
}
__device__ __forceinline__ void topk_stage_store(const TkStage& s, LAS unsigned char* qst, int tid) {
    *(LAS v4u*)(qst + (tid >> 6) * 1056 + (tid & 63) * 16) = s.q;
    if (tid < 8) *(LAS v4u*)(qst + tid * 1056 + 1024) = s.w;
}
__device__ __forceinline__ void topk_ops_load(TkOps& o, const LAS unsigned char* qst, int lane) {
    const int r = lane & 31, hb = lane >> 5;
    const int a_ = r >> 3, hi_ = (r >> 2) & 1, i_ = r & 3;
    const int ql = 2 * (a_ >> 1) + hi_, head = 4 * (a_ & 1) + i_;
#pragma unroll
    for (int rt = 0; rt < 2; ++rt)
#pragma unroll
        for (int ks = 0; ks < 4; ++ks) o.af[rt][ks] = *(const LAS bf16x8*)(qst + (rt * 4 + ql) * 1056 + head * 128 + hb * 64 + ks * 16);
#pragma unroll
    for (int rt = 0; rt < 2; ++rt)
#pragma unroll
        for (int s = 0; s < 2; ++s) o.wv[rt][s] = *(const LAS bf16x8*)(qst + (rt * 4 + 2 * s + hb) * 1056 + 1024);
}
__device__ __forceinline__ void topk_unit(Frame& F, int b, int t0, int nt0, int dbg) {
    const GAS bf16* PBg = (const GAS bf16*)(F.ws + WS_PB);
    GAS unsigned long long* MASK = (GAS unsigned long long*)(F.ws + WS_MASK);
    int lane_ = F.lane; asm volatile("" : "+v"(lane_));
    const int lane = lane_, wave = F.wave;
    const int c = t0 >> 6, n = (c + 1) * 64;
    const size_t tb = (size_t)b * SEQ;
    LAS unsigned char* qst = F.lds + QST_OFF;
    if (n <= 256) {
        const unsigned long long w = (lane <= c) ? ~0ull : 0ull;
        MASK[(tb + t0 + wave) * 64 + lane] = w;
        if (nt0 >= 0) { TkStage st; topk_stage_load(st, PBg, tb, nt0, F.tid); topk_stage_store(st, qst, F.tid); LDS_WAIT(); __syncthreads(); }
        return;
    }
    LAS float* sc = (LAS float*)(F.lds + SC_OFF);
    LAS float* mm = (LAS float*)(F.lds + MM_OFF);
    PROBE_T0(1); PROBE_T0(3);
    {
        TkOps ops; topk_ops_load(ops, qst, lane);
        const int r = lane & 31, hb = lane >> 5;
        float wq[2][2][8];
#pragma unroll
        for (int rt = 0; rt < 2; ++rt)
#pragma unroll
            for (int s = 0; s < 2; ++s)
#pragma unroll
                for (int h = 0; h < 8; ++h) wq[rt][s][h] = bf2f((unsigned short)ops.wv[rt][s][h]);
        float qmn[4], qmx[4];
#pragma unroll
        for (int s = 0; s < 4; ++s) { qmn[s] = INFINITY; qmx[s] = -INFINITY; }
        const int nkt = n >> 5;
        const GAS bf16* kbase = (const GAS bf16*)(F.ws + WS_KIF) + (tb >> 5) * 2048 + lane * 8;
#define TK_LOAD(dst, kt) do { int kc_ = (kt); kc_ = kc_ < nkt ? kc_ : nkt - 1; const GAS bf16* kp_ = kbase + (size_t)kc_ * 2048; _Pragma("unroll") for (int ks = 0; ks < 4; ++ks) dst[ks] = *(const GAS bf16x8*)(kp_ + ks * 512); } while (0)
#define TK_RELU16(A) asm volatile("s_nop 15\n\ts_nop 3\n\tv_max_f32_e32 %0, 0, %0\n\tv_max_f32_e32 %1, 0, %1\n\tv_max_f32_e32 %2, 0, %2\n\tv_max_f32_e32 %3, 0, %3\n\tv_max_f32_e32 %4, 0, %4\n\tv_max_f32_e32 %5, 0, %5\n\tv_max_f32_e32 %6, 0, %6\n\tv_max_f32_e32 %7, 0, %7\n\t" \
            "v_max_f32_e32 %8, 0, %8\n\tv_max_f32_e32 %9, 0, %9\n\tv_max_f32_e32 %10, 0, %10\n\tv_max_f32_e32 %11, 0, %11\n\tv_max_f32_e32 %12, 0, %12\n\tv_max_f32_e32 %13, 0, %13\n\tv_max_f32_e32 %14, 0, %14\n\tv_max_f32_e32 %15, 0, %15" \
            : "+v"(A[0]), "+v"(A[1]), "+v"(A[2]), "+v"(A[3]), "+v"(A[4]), "+v"(A[5]), "+v"(A[6]), "+v"(A[7]), "+v"(A[8]), "+v"(A[9]), "+v"(A[10]), "+v"(A[11]), "+v"(A[12]), "+v"(A[13]), "+v"(A[14]), "+v"(A[15]))
#define TK_COMP(src, kt) do { _Pragma("unroll") for (int rt = 0; rt < 2; ++rt) { f32x16 acc = {}; \
            _Pragma("unroll") for (int ks = 0; ks < 4; ++ks) acc = __builtin_amdgcn_mfma_f32_32x32x16_bf16(ops.af[rt][ks], src[ks], acc, 0, 0, 0); \
            float e_[16]; _Pragma("unroll") for (int h = 0; h < 16; ++h) e_[h] = acc[h]; \
            TK_RELU16(e_); \
            float s0 = e_[0] * wq[rt][0][0], s1 = e_[8] * wq[rt][1][0]; \
            _Pragma("unroll") for (int h = 1; h < 8; ++h) { s0 = __builtin_fmaf(e_[h], wq[rt][0][h], s0); s1 = __builtin_fmaf(e_[8 + h], wq[rt][1][h], s1); } \
            sc[(rt * 4 + hb) * SEQ + (kt) * 32 + r] = s0; sc[(rt * 4 + 2 + hb) * SEQ + (kt) * 32 + r] = s1; \
            qmn[rt * 2] = fminf(qmn[rt * 2], s0); qmx[rt * 2] = fmaxf(qmx[rt * 2], s0); qmn[rt * 2 + 1] = fminf(qmn[rt * 2 + 1], s1); qmx[rt * 2 + 1] = fmaxf(qmx[rt * 2 + 1], s1); } } while (0)
        bf16x8 kb0[4], kb1[4], kb2[4], kb3[4];
        int kt = wave;
        TK_LOAD(kb0, kt); TK_LOAD(kb1, kt + 8); TK_LOAD(kb2, kt + 16);
        for (; kt < nkt; kt += 32) {
            TK_LOAD(kb3, kt + 24);
            TK_COMP(kb0, kt);
            TK_LOAD(kb0, kt + 32); if (kt + 8 < nkt) TK_COMP(kb1, kt + 8);
            TK_LOAD(kb1, kt + 40); if (kt + 16 < nkt) TK_COMP(kb2, kt + 16);
            TK_LOAD(kb2, kt + 48); if (kt + 24 < nkt) TK_COMP(kb3, kt + 24);
        }
#undef TK_LOAD
#undef TK_COMP
#undef TK_RELU16
#pragma unroll
        for (int s = 0; s < 4; ++s) {
#pragma unroll
            for (int o = 1; o < 32; o <<= 1) { qmn[s] = fminf(qmn[s], shxr_f(qmn[s], lane, o)); qmx[s] = fmaxf(qmx[s], shxr_f(qmx[s], lane, o)); }
            if (r == 0) { const int q = (s >> 1) * 4 + 2 * (s & 1) + hb; mm[(wave * 8 + q) * 2] = qmn[s]; mm[(wave * 8 + q) * 2 + 1] = qmx[s]; }
        }
    }
    __syncthreads();
    TkStage nst; if (nt0 >= 0) topk_stage_load(nst, PBg, tb, nt0, F.tid);
    PROBE_T1(1); PROBE_T0(2);
    if (!(dbg & 4)) {
        asm volatile("; TK_P2_BEGIN");
        const LAS float* row = sc + wave * SEQ;
        LAS float* cand = (LAS float*)(F.lds + CAND_OFF) + wave * 256;
        float lo = INFINITY, hi = -INFINITY;
#pragma unroll
        for (int w = 0; w < 8; ++w) { lo = fminf(lo, mm[(w * 8 + wave) * 2]); hi = fmaxf(hi, mm[(w * 8 + wave) * 2 + 1]); }
        GAS unsigned long long* mrow = MASK + (tb + t0 + wave) * 64;
        const int nj = n >> 6;
        float v[64];
#pragma unroll
        for (int jb = 0; jb < 4; ++jb) {
#pragma unroll
            for (int j = jb * 16; j < jb * 16 + 16; ++j) v[j] = -INFINITY;
            if (jb * 16 < nj) {
#pragma unroll
                for (int j = jb * 16; j < jb * 16 + 16; ++j) if (j < nj) v[j] = row[j * 64 + lane]; } }
#define TK_COUNT_GT(P, OUT) do { unsigned c_ = 0u; _Pragma("unroll") for (int jb = 0; jb < 4; ++jb) { if (jb * 16 < nj) { _Pragma("unroll") for (int j = jb * 16; j < jb * 16 + 16; ++j) c_ += (v[j] > (P)) ? 1u : 0u; } } OUT = (int)wave_sum_u(c_); } while (0)
        float a = lo, bb = hi; int ga, gb = 0;
        TK_COUNT_GT(a, ga);
        float thr = 0.f; int ithr = -1, need_eq = 0; bool tie = false, have = false;
        if (ga < 256) { thr = a; need_eq = 256 - ga; tie = true; have = true; }
        for (int it = 0; it < 48 && !have; ++it) {
            if (ga - gb <= 64) break;
            const float mid = a + 0.5f * (bb - a);
            if (!(mid > a && mid < bb)) { thr = bb; need_eq = 256 - gb; tie = true; have = true; break; }
            int g; TK_COUNT_GT(mid, g);
            if (g >= 256) { a = mid; ga = g; } else { bb = mid; gb = g; }
        }
        if (!have) {
            const int hcount = ga - gb, need2 = 256 - gb;
            unsigned mycnt = 0u;
#pragma unroll
            for (int jb = 0; jb < 4; ++jb) { if (jb * 16 < nj) {
#pragma unroll
                for (int j = jb * 16; j < jb * 16 + 16; ++j) mycnt += (v[j] > a && v[j] <= bb) ? 1u : 0u; } }
            unsigned pos = wave_excl_scan_u(mycnt, lane);
            LAS float* dump = cand + 128 + 2 * lane;
#pragma unroll
            for (int jb = 0; jb < 4; ++jb) { if (jb * 16 < nj) {
#pragma unroll
                for (int j = jb * 16; j < jb * 16 + 16; ++j) { const bool m = v[j] > a && v[j] <= bb; LAS float* dst = (m && pos < 64u) ? cand + 2 * pos : dump;
                    *(LAS f32x2c*)dst = (f32x2c){v[j], __int_as_float(j * 64 + lane)}; pos += m ? 1u : 0u; } } }
            LDS_WAIT();
            float ms = -INFINITY; int mi = 0x7fffffff;
            if (lane < hcount) { ms = cand[2 * lane]; mi = __float_as_int(cand[2 * lane + 1]); }
            int rank = 0;
            for (int j = 0; j < hcount; ++j) { const float sj = bcast_f(ms, j); const int ij = bcast_i(mi, j); rank += (sj > ms || (sj == ms && ij < mi)) ? 1 : 0; }
            const unsigned long long tb2 = __ballot(lane < hcount && rank == need2 - 1);
            const int s2 = __builtin_amdgcn_readfirstlane(tb2 != 0ull ? __ffsll((long long)tb2) - 1 : 0);
            thr = bcast_f(ms, s2); ithr = bcast_i(mi, s2);
        }
#undef TK_COUNT_GT
        int wlo = 0, whi = 0;
        if (!tie) {
            unsigned ceq = 0u;
#pragma unroll
            for (int jb = 0; jb < 4; ++jb) { if (jb * 16 < nj) {
#pragma unroll
                for (int j = jb * 16; j < jb * 16 + 16; ++j) ceq += (v[j] == thr) ? 1u : 0u; } }
            if (wave_sum_u(ceq) == 1u) {
#pragma unroll
                for (int jb = 0; jb < 4; ++jb) { if (jb * 16 < nj) {
#pragma unroll
                    for (int j = jb * 16; j < jb * 16 + 16; ++j) { const unsigned long long w = __ballot(v[j] >= thr);
                        if (lane == j) { wlo = (int)(unsigned)w; whi = (int)(unsigned)(w >> 32); } } } }
            } else {
#pragma unroll
                for (int jb = 0; jb < 4; ++jb) { if (jb * 16 < nj) {
#pragma unroll
                    for (int j = jb * 16; j < jb * 16 + 16; ++j) { const float s = v[j]; const int irel = ithr - j * 64; const bool sel = s > thr || (s == thr && lane <= irel);
                        const unsigned long long w = __ballot(sel);
                        if (lane == j) { wlo = (int)(unsigned)w; whi = (int)(unsigned)(w >> 32); } } } }
            }
        } else {
            int run_eq = 0;
#pragma unroll
            for (int jb = 0; jb < 4; ++jb) { if (jb * 16 < nj) {
#pragma unroll
                for (int j = jb * 16; j < jb * 16 + 16; ++j) { const float s = v[j]; const bool eq = s == thr;
                    const unsigned long long em = __ballot(eq); const int rank = run_eq + __popcll(em & ((1ull << lane) - 1ull));
                    const unsigned long long w = __ballot(s > thr || (eq && rank < need_eq));
                    if (lane == j) { wlo = (int)(unsigned)w; whi = (int)(unsigned)(w >> 32); } run_eq += __popcll(em); } } }
        }
        const unsigned long long myword = ((unsigned long long)(unsigned)whi << 32) | (unsigned)wlo;
        mrow[lane] = myword;
        asm volatile("; TK_P2_END");
    }
    if (nt0 >= 0) { topk_stage_store(nst, qst, F.tid); LDS_WAIT(); }
    __syncthreads();
    PROBE_T1(2); PROBE_T1(3);
}

__device__ __forceinline__ void poolconv_tile(Frame& F, const Args& A, int l, int tile) {
    const bf16* PB = (const bf16*)(F.ws + WS_PB); bf16* YB = (bf16*)(F.ws + WS_HB);
    const int tid = F.tid, lane = F.lane, wave = F.wave;
    const int t0 = (tile & 63) * 64; const size_t tb = (size_t)(tile >> 6) * SEQ;
    LAS bf16* glu = (LAS bf16*)(F.lds + RING_OFF);
    LAS float* hbuf = (LAS float*)(F.lds + RING_OFF + 49152);
    LAS bf16* dpl = (LAS bf16*)(F.lds + RING_OFF + 49152 + 65536);
    const int ch = tid & 255, th = tid >> 8;
    for (int e = tid; e < 94 * 128; e += NWAVES * 64) { const int rr = e >> 7, c2 = (e & 127) * 2; const int t = t0 - 30 + rr;
        unsigned o = 0u;
        if (t >= 0) { const unsigned av = *(const unsigned*)(PB + (tb + t) * NP + PC_CA + c2), gv = *(const unsigned*)(PB + (tb + t) * NP + PC_CG + c2);
            const float a0 = bf2f((unsigned short)(av & 0xffff)), a1 = bf2f((unsigned short)(av >> 16)), g0 = bf2f((unsigned short)(gv & 0xffff)), g1 = bf2f((unsigned short)(gv >> 16));
            o = pk2(a0 / (1.0f + expf(-g0)), a1 / (1.0f + expf(-g1))); }
        *(LAS unsigned*)(glu + rr * 256 + c2) = o; }
    __syncthreads();
    {
        const float* dw = A.in[I_DWW] + (size_t)l * 31 * 256; float wt[31];
#pragma unroll
        for (int j = 0; j < 31; ++j) wt[j] = dw[j * 256 + ch];
        const float bias = A.in[I_DWB][l * 256 + ch];
        for (int tt = 0; tt < 32; ++tt) { const int tr = th * 32 + tt; float acc = bias;
#pragma unroll
            for (int j = 0; j < 31; ++j) acc += bf2f(glu[(tr + j) * 256 + ch]) * wt[j];
            hbuf[tr * 256 + ch] = acc; }
    }
    __syncthreads();
    LAS bf16* act = glu;
    {
        const f32x4 g4 = *(const f32x4*)(A.in[I_LNG] + l * 256 + 4 * lane), b4 = *(const f32x4*)(A.in[I_LNB] + l * 256 + 4 * lane);
        for (int tr = wave; tr < 64; tr += NWAVES) { const f32x4 v = *(const LAS f32x4*)(hbuf + tr * 256 + 4 * lane);
            const float mu = wave_sum((v.x + v.y) + (v.z + v.w), lane) * (1.0f / 256.0f);
            const f32x4 d = v - mu; const float var = wave_sum((d.x * d.x + d.y * d.y) + (d.z * d.z + d.w * d.w), lane) * (1.0f / 256.0f);
            const float rs = 1.0f / sqrtf(var + RMS_EPS);
            f32x4 y = d * rs * g4 + b4;
            y.x = y.x / (1.0f + expf(-y.x)); y.y = y.y / (1.0f + expf(-y.y)); y.z = y.z / (1.0f + expf(-y.z)); y.w = y.w / (1.0f + expf(-y.w));
            *(LAS u32x2*)(act + tr * 264 + 4 * lane) = (u32x2){pk2(y.x, y.y), pk2(y.z, y.w)}; }
    }
    __syncthreads();
    {
        const bf16* pw = (const bf16*)(F.ws + WS_PWWT) + (size_t)l * 256 * 256;
        f32x4 acc[2][4];
#pragma unroll
        for (int a = 0; a < 2; ++a)
#pragma unroll
            for (int t = 0; t < 4; ++t) acc[a][t] = (f32x4){0.f, 0.f, 0.f, 0.f};
        const int fr = lane & 15, fq = lane >> 4;
#pragma unroll
        for (int ks = 0; ks < 8; ++ks) {
            bf16x8 af[2], bfv[4];
#pragma unroll
            for (int a = 0; a < 2; ++a) af[a] = *(const bf16x8*)(pw + (size_t)((2 * wave + a) * 16 + fr) * 256 + ks * 32 + 8 * fq);
#pragma unroll
            for (int t = 0; t < 4; ++t) bfv[t] = *(const LAS bf16x8*)(act + (t * 16 + fr) * 264 + ks * 32 + 8 * fq);
#pragma unroll
            for (int a = 0; a < 2; ++a)
#pragma unroll
                for (int t = 0; t < 4; ++t) acc[a][t] = __builtin_amdgcn_mfma_f32_16x16x32_bf16(af[a], bfv[t], acc[a][t], 0, 0, 0);
        }
#pragma unroll
        for (int a = 0; a < 2; ++a) { const int n0 = (2 * wave + a) * 16 + 4 * fq; const f32x4 pb4 = *(const f32x4*)(A.in[I_PWB] + l * 256 + n0);
#pragma unroll
            for (int t = 0; t < 4; ++t) { const f32x4 o = acc[a][t] + pb4;
                *(uint2*)(YB + (tb + t0 + t * 16 + fr) * D + 768 + n0) = make_uint2(pk2(o.x, o.y), pk2(o.z, o.w)); } }
    }
    __syncthreads();
    LAS bf16* dp = (LAS bf16*)hbuf;
    {
        const int win = 2 << (ch >> 6);
        float u[47];
#pragma unroll
        for (int i = 0; i < 47; ++i) { const int t = t0 + th * 32 - 15 + i; u[i] = (t >= 0) ? bf2f(PB[(tb + (t >= 0 ? t : 0)) * NP + PC_POOL + ch]) : 0.f; }
#pragma unroll
        for (int tt = 0; tt < 32; ++tt) { const int t = t0 + th * 32 + tt; float s = 0.f;
#pragma unroll
            for (int j = 0; j < 16; ++j) if (j < win) s += u[15 + tt - j];
            const int cnt = (t + 1 < win) ? (t + 1) : win;
            dp[(th * 32 + tt) * 264 + ch] = (bf16)f2bf(s / (float)cnt - u[15 + tt]); }
    }
    __syncthreads();
    {
        const int g = wave >> 1; const bf16* pwt = (const bf16*)(F.ws + WS_POOLWT) + ((size_t)l * 4 + g) * 64 * 64;
        f32x4 acc[2][4];
#pragma unroll
        for (int a = 0; a < 2; ++a)
#pragma unroll
            for (int t = 0; t < 4; ++t) acc[a][t] = (f32x4){0.f, 0.f, 0.f, 0.f};
        const int fr = lane & 15, fq = lane >> 4;
#pragma unroll
        for (int ks = 0; ks < 2; ++ks) {
            bf16x8 af[2], bfv[4];
#pragma unroll
            for (int a = 0; a < 2; ++a) af[a] = *(const bf16x8*)(pwt + (size_t)((2 * (wave & 1) + a) * 16 + fr) * 64 + ks * 32 + 8 * fq);
#pragma unroll
            for (int t = 0; t < 4; ++t) bfv[t] = *(const LAS bf16x8*)(dp + (t * 16 + fr) * 264 + g * 64 + ks * 32 + 8 * fq);
#pragma unroll
            for (int a = 0; a < 2; ++a)
#pragma unroll
                for (int t = 0; t < 4; ++t) acc[a][t] = __builtin_amdgcn_mfma_f32_16x16x32_bf16(af[a], bfv[t], acc[a][t], 0, 0, 0);
        }
#pragma unroll
        for (int a = 0; a < 2; ++a) { const int n0 = g * 64 + (2 * (wave & 1) + a) * 16 + 4 * fq; const f32x4 ps4 = *(const f32x4*)(A.in[I_POOLS] + l * 256 + n0);
#pragma unroll
            for (int t = 0; t < 4; ++t) { const f32x4 o = acc[a][t] * ps4;
                *(uint2*)(YB + (tb + t0 + t * 16 + fr) * D + 512 + n0) = make_uint2(pk2(o.x, o.y), pk2(o.z, o.w)); } }
    }
    __syncthreads();
}
__device__ __forceinline__ void phaseB(Frame& F, const Args& A, int l) {
    if (!(A.pad & 1)) {
    const int b = F.vcu & 3, j = F.vcu >> 2;
    {
#define TK_T0(i) ((((i) < 4) ? j : 63 - j) * 64 + (i) * 8)
        { TkStage st; topk_stage_load(st, (const GAS bf16*)(F.ws + WS_PB), (size_t)b * SEQ, TK_T0(0), F.tid); topk_stage_store(st, F.lds + QST_OFF, F.tid); LDS_WAIT(); __syncthreads(); }
        for (int i = 0; i < 8; ++i) topk_unit(F, b, TK_T0(i), (i + 1 < 8) ? TK_T0(i + 1) : -1, A.pad);
#undef TK_T0
    }
    }
    if (!(A.pad & 2)) { PROBE_T0(4); poolconv_tile(F, A, l, F.vcu); PROBE_T1(4); }
}

struct EpiInProj {
    static constexpr bool PERM = true, AFTER_DRAIN = false;
    bf16* O; bf16* KIF; float scale0;
    __device__ __forceinline__ void operator()(const pg8::f32x4 (&acc)[2][2][4][2], const pg8::Unit& u, int wr, int wc, int fr, int fq) const {
        const int row0 = u.pm * pg8::BM + wr * 64 + fr; const int colt = u.pn * pg8::BM;
        const float sc = colt < 512 ? scale0 : 1.f;
        const int col0 = colt + wc * 32 + 8 * fq;
        const bool kif = (u.pn == 11) && (wc < 2);
        const int chunk = wc * 4 + fq;
#pragma unroll
        for (int ai = 0; ai < 2; ++ai)
#pragma unroll
            for (int m = 0; m < 4; ++m) { const int row = row0 + ai * pg8::HALF + m * 16; bf16* rowp = O + (size_t)row * NP + col0;
#pragma unroll
                for (int bj = 0; bj < 2; ++bj) { pg8::f32x4 v0 = acc[ai][bj][m][0] * sc, v1 = acc[ai][bj][m][1] * sc;
                    pg8::u32x4 w; w.x = pg8::cvt_pk_bf16(v0[0], v0[1]); w.y = pg8::cvt_pk_bf16(v0[2], v0[3]); w.z = pg8::cvt_pk_bf16(v1[0], v1[1]); w.w = pg8::cvt_pk_bf16(v1[2], v1[3]);
                    *(pg8::u32x4*)(rowp + bj * pg8::HALF) = w;
                    if (bj == 0 && kif) *(pg8::u32x4*)((char*)KIF + (size_t)(row >> 5) * 4096 + (chunk & 3) * 1024 + ((chunk >> 2) * 32 + (row & 31)) * 16) = w; } }
    }
};

constexpr int N_PHASES = 17;
__global__ void __launch_bounds__(NWAVES * 64, 2) skel_fwd(Args args) {
    extern __shared__ __attribute__((aligned(16))) unsigned char lds[];
    Frame F;
    F.lds = (LAS unsigned char*)lds;
    F.MISC = (volatile LAS unsigned*)(F.lds + MISC_OFF);
    F.tid = threadIdx.x; F.lane = F.tid & 63; F.wave = __builtin_amdgcn_readfirstlane(F.tid >> 6);
    F.G = gridDim.x; { const int bx = blockIdx.x; F.vcu = (F.G % 8 == 0) ? (bx % 8) * (F.G / 8) + bx / 8 : bx; }
    F.ws = args.ws; F.out = args.out; F.ctl = (gu32*)(args.ws + WS_CTL);
    for (int u = F.tid; u < (LDS_BYTES - LDSCTL_OFF) / 4; u += NWAVES * 64) ((LAS unsigned*)(F.lds + LDSCTL_OFF))[u] = 0u;
    __syncthreads();
    const int lo = args.ph_lo, hi = args.ph_hi;
    const bool multi = (hi - lo) > 1;
    XcdBarrier bar; bar.bar = (unsigned*)(F.ctl + CW_BAR) + args.li * XCD_BAR_WORDS; bar.x = 0; bar.st = nullptr;
    if (multi) bar = xcd_barrier_post((unsigned*)(F.ctl + CW_BAR) + args.li * XCD_BAR_WORDS, F.MISC + 8);
#define FRESH() do { int t_ = threadIdx.x; asm volatile("" : "+v"(t_)); F.tid = t_; F.lane = t_ & 63; F.wave = __builtin_amdgcn_readfirstlane(t_ >> 6); } while (0)
#ifndef MK_REP
#define MK_REP (-1)
#endif
#define REPS(k) for (int rep_ = 0; rep_ < ((MK_REP) == (k) ? 2 : 1); ++rep_)
#define IN(k) (lo <= (k) && (k) < hi)
#define SEAM(k) do { if (IN(k) && IN((k) + 1)) xcd_barrier(bar); } while (0)

    if (IN(0)) { REPS(0) { FRESH(); p0_prologue(F, args); } SEAM(0); }
    for (int l = 0; l < DEPTH; ++l) {
        const int pb = 1 + 8 * l;
        bf16* HB = (bf16*)(F.ws + WS_HB); bf16* PB = (bf16*)(F.ws + WS_PB);
        if (IN(pb + 0)) {
            pg8::Gemm g{HB, (const bf16*)(F.ws + WS_WIN) + (size_t)l * NP * D, T, NP, D}; pg8::StaticOrder S; S.init(T, NP, F.G, (int)blockIdx.x);
            EpiInProj E{PB, (bf16*)(F.ws + WS_KIF), C2};
            REPS(pb + 0) pg8::gemm_phase<EpiInProj, pg8::StaticOrder, PG8_ALIGN, PG8_SP2>(F.lds + RING_OFF, g, S, E);
            SEAM(pb + 0);
        }
        if (IN(pb + 1)) { REPS(pb + 1) { FRESH(); phaseB(F, args, l); } SEAM(pb + 1); }
#ifndef MK_NO_ATTN
        if (IN(pb + 2)) {
            const attn_body::AttnTensors AT{(const attn_body::bf16*)(PB + PC_Q), (const attn_body::bf16*)(PB + PC_K), (const attn_body::bf16*)(PB + PC_V), (attn_body::bf16*)HB, (const unsigned long long*)(F.ws + WS_MASK)};
            const attn_body::StaticOrder S((int)F.G, (int)blockIdx.x);
            REPS(pb + 2) attn_body::attn_phase<attn_body::StaticOrder>((char*)lds + RING_OFF, AT, S);
            SEAM(pb + 2);
        }
#endif
        if (IN(pb + 3)) {
            pg8::Gemm g{HB, (const bf16*)(F.ws + WS_WOUT) + (size_t)l * D * D, T, D, D}; pg8::StaticOrder S; S.init(T, D, F.G, (int)blockIdx.x);
            EpiResF32 E{l == 0 ? args.in[I_X] : F.out, F.out, D};
            REPS(pb + 3) pg8::gemm_phase<EpiResF32, pg8::StaticOrder, PG8_ALIGN, PG8_SP2>(F.lds + RING_OFF, g, S, E);
            SEAM(pb + 3);
        }
#ifndef MK_NO_R2
        if (IN(pb + 4)) { FRESH(); r2_router(F, args, l); SEAM(pb + 4); }
#endif
        if (IN(pb + 5) || IN(pb + 6)) {
            FRESH(); moe_build_table(F, l);
            MoeSched S; S.tab = (const LAS int*)(F.lds + MOE_TAB_OFF); S.ntiles = __builtin_amdgcn_readfirstlane(S.tab[0]); S.ntx = (S.ntiles + 7) / 8; S.xcd = F.vcu / 32; S.j = F.vcu % 32;
            S.blist = (const int*)(F.ws + WS_BLIST);
            bf16* HID = PB;
#ifndef MK_NO_D1
            if (IN(pb + 5)) {
                S.mode = 1; S.npn = 8; S.Abase = (const char*)HB; S.Bbase = (const char*)(F.ws + WS_WGU) + (size_t)l * 16 * 1024 * 1024 * 2;
                pg8::Gemm2 g{1024, 1024, 1024}; EpiSwiGLU E{HID, (const float*)(F.ws + WS_BW)};
                REPS(pb + 5) pg8::gemm_phase2<EpiSwiGLU, MoeSched, true, PG8_ALIGN>(F.lds + RING_OFF, g, S, E);
                SEAM(pb + 5);
            }
#endif
#ifndef MK_NO_D2
            if (IN(pb + 6)) {
                S.mode = 2; S.npn = 4; S.Abase = (const char*)HID; S.Bbase = (const char*)(F.ws + WS_WD) + (size_t)l * 16 * 1024 * 512 * 2;
                pg8::Gemm2 g{1024, 1024, 512}; EpiScatter E{F.out, (const int*)(F.ws + WS_BLIST)};
                pg8::gemm_phase2<EpiScatter, MoeSched, false, PG8_ALIGN>(F.lds + RING_OFF, g, S, E);
                SEAM(pb + 6);
            }
#endif
        }
        if (IN(pb + 7)) {
            FRESH(); const int gw = F.vcu * NWAVES + F.wave, NGW = F.G * NWAVES;
            if (l + 1 < DEPTH) { REPS(pb + 7) for (int m = gw; m < T; m += NGW) rms_row_to_bf16(F.out + (size_t)m * D, args.in[I_N1G] + (size_t)(l + 1) * D, HB + (size_t)m * D, F.lane); }
            else { for (int m = gw; m < T; m += NGW) rms_row_f32(F.out + (size_t)m * D, args.in[I_FG], F.lane);
#if MK_PROBE
                { VM_WAIT(); __syncthreads(); const float dl = sqrtf((float)__hip_atomic_load(F.ctl + 3, RLX_AGENT) * 1e-4f);
                  for (int m = gw; m < T; m += NGW) { GAS f32x4* xr = (GAS f32x4*)(F.out + (size_t)m * D) + F.lane; for (int j = 0; j < 4; ++j) xr[64 * j] = xr[64 * j] + dl; } }
#endif
            }
            SEAM(pb + 7);
        }
    }
#undef IN
#undef SEAM
}
namespace nv {
__device__ __forceinline__ float wave_max(float v) {
#pragma unroll
    for (int o = 1; o < 64; o <<= 1) v = fmaxf(v, __shfl_xor(v, o));
    return v;
}
__device__ __forceinline__ float block_sum256(float v, float* red) {
    v = wave_sum(v, threadIdx.x & 63);
    __syncthreads();
    if ((threadIdx.x & 63) == 0) red[threadIdx.x >> 6] = v;
    __syncthreads();
    return (red[0] + red[1]) + (red[2] + red[3]);
}
__device__ __forceinline__ float ldb(const bf16* p) { return bf2f(*p); }

__global__ void __launch_bounds__(256) k_index_topk(const bf16* __restrict__ PB, unsigned* __restrict__ mask) {
    __shared__ float qi[512];
    __shared__ float w[8];
    __shared__ float sc[SEQ];
    const int tok = blockIdx.x, b = tok / SEQ, t = tok % SEQ, tid = threadIdx.x, lane = tid & 63, wv = tid >> 6;
    const int n = ((t >> 6) + 1) * 64;
    const bf16* prow = PB + (size_t)tok * NP;
    qi[tid] = ldb(prow + PC_QI + tid); qi[tid + 256] = ldb(prow + PC_QI + 256 + tid);
    if (tid < 8) w[tid] = ldb(prow + PC_WI + tid);
    __syncthreads();
    for (int s = tid; s < n; s += 256) {
        const bf16* kr = PB + (size_t)(b * SEQ + s) * NP + PC_KI;
        float kv[64];
#pragma unroll
        for (int d = 0; d < 64; ++d) kv[d] = ldb(kr + d);
        float score = 0.f;
        for (int h = 0; h < 8; ++h) {
            float dsum = 0.f;
#pragma unroll
            for (int d = 0; d < 64; ++d) dsum += qi[h * 64 + d] * kv[d];
            score += fmaxf(dsum, 0.f) * w[h];
        }
        sc[s] = score;
    }
    __syncthreads();
    unsigned* mrow = mask + (size_t)tok * 128;
    for (int base = 0; base < SEQ; base += 256) {
        const int s = base + wv * 64 + lane;
        bool sel = false;
        if (s < n) {
            if (n <= 256) sel = true;
            else {
                const float v = sc[s];
                int rank = 0;
                for (int j = 0; j < n; ++j) { const float u = sc[j]; rank += (u > v || (u == v && j < s)) ? 1 : 0; }
                sel = rank < 256;
            }
        }
        const unsigned long long bal = __ballot(sel);
        if (lane == 0) { mrow[(base + wv * 64) / 32] = (unsigned)bal; mrow[(base + wv * 64) / 32 + 1] = (unsigned)(bal >> 32); }
    }
}

__global__ void __launch_bounds__(256) k_attn(const bf16* __restrict__ PB, const unsigned* __restrict__ mask, bf16* __restrict__ YB) {
    __shared__ float q[512];
    __shared__ int sel[256];
    __shared__ int pre[129];
    __shared__ float lg[8][256];
    __shared__ float rs[8];
    const int tok = blockIdx.x, b = tok / SEQ, tid = threadIdx.x, lane = tid & 63, wv = tid >> 6;
    const bf16* prow = PB + (size_t)tok * NP;
    q[tid] = ldb(prow + PC_Q + tid); q[tid + 256] = ldb(prow + PC_Q + 256 + tid);
    const unsigned* mrow = mask + (size_t)tok * 128;
    unsigned mw = 0;
    if (tid < 128) mw = mrow[tid];
    if (tid < 128) pre[tid + 1] = __popc(mw);
    if (tid == 0) pre[0] = 0;
    __syncthreads();
    if (tid == 0) { for (int i = 1; i <= 128; ++i) pre[i] += pre[i - 1]; }
    __syncthreads();
    if (tid < 128) { int p = pre[tid]; unsigned m = mw; while (m) { const int bit = __ffs(m) - 1; m &= m - 1; if (p < 256) sel[p] = tid * 32 + bit; ++p; } }
    __syncthreads();
    int cnt = pre[128]; if (cnt > 256) cnt = 256;
    if (tid < cnt) {
        const bf16* kr = PB + (size_t)(b * SEQ + sel[tid]) * NP + PC_K;
        for (int h = 0; h < 8; ++h) {
            float dsum = 0.f;
#pragma unroll
            for (int d = 0; d < 64; ++d) dsum += q[h * 64 + d] * ldb(kr + h * 64 + d);
            lg[h][tid] = dsum;
        }
    }
    __syncthreads();
    for (int hh = 0; hh < 2; ++hh) {
        const int h = wv * 2 + hh;
        float m = -INFINITY;
        for (int j = lane; j < cnt; j += 64) m = fmaxf(m, lg[h][j]);
        m = wave_max(m);
        float s = 0.f;
        for (int j = lane; j < cnt; j += 64) { const float e = exp2f(lg[h][j] - m); lg[h][j] = e; s += e; }
        s = wave_sum(s, lane);
        if (lane == 0) rs[h] = 1.0f / s;
    }
    __syncthreads();
    for (int oo = 0; oo < 2; ++oo) {
        const int o = tid + oo * 256, h = o >> 6;
        float acc = 0.f;
        for (int j = 0; j < cnt; ++j) acc += lg[h][j] * ldb(PB + (size_t)(b * SEQ + sel[j]) * NP + PC_V + o);
        YB[(size_t)tok * D + o] = (bf16)f2bf(acc * rs[h]);
    }
}

__global__ void __launch_bounds__(256) k_pool(const bf16* __restrict__ PB, const float* __restrict__ pw, const float* __restrict__ ps, bf16* __restrict__ YB) {
    __shared__ float d[256];
    const int tok = blockIdx.x, t = tok % SEQ, c = threadIdx.x, g = c >> 6;
    const int win = 2 << g;
    const int cntw = (t + 1 < win) ? (t + 1) : win;
    float s = 0.f;
    for (int j = 0; j < cntw; ++j) s += ldb(PB + (size_t)(tok - j) * NP + PC_POOL + c);
    d[c] = s / (float)cntw - ldb(PB + (size_t)tok * NP + PC_POOL + c);
    __syncthreads();
    const int dout = c & 63;
    float acc = 0.f;
    for (int cc = 0; cc < 64; ++cc) acc += d[g * 64 + cc] * pw[(size_t)(g * 64 + cc) * 64 + dout];
    YB[(size_t)tok * D + 512 + c] = (bf16)f2bf(acc * ps[c]);
}

__global__ void __launch_bounds__(256) k_conv(const bf16* __restrict__ PB, const float* __restrict__ dw_w, const float* __restrict__ dw_b, const float* __restrict__ ln_g,
                                              const float* __restrict__ ln_b, const float* __restrict__ pw_w, const float* __restrict__ pw_b, bf16* __restrict__ YB) {
    __shared__ float sh[256];
    __shared__ float red[4];
    const int tok = blockIdx.x, t = tok % SEQ, c = threadIdx.x;
    float h = dw_b[c];
    for (int j = 0; j < 31; ++j) {
        const int tt = t - 30 + j;
        if (tt >= 0) {
            const bf16* pr = PB + (size_t)(tok - 30 + j) * NP;
            const float a = ldb(pr + PC_CA + c), gt = ldb(pr + PC_CG + c);
            h += a * (1.0f / (1.0f + expf(-gt))) * dw_w[j * 256 + c];
        }
    }
    const float mu = block_sum256(h, red) * (1.0f / 256.0f);
    const float dv = h - mu;
    const float var = block_sum256(dv * dv, red) * (1.0f / 256.0f);
    float y = dv * (1.0f / sqrtf(var + RMS_EPS)) * ln_g[c] + ln_b[c];
    y = y / (1.0f + expf(-y));
    __syncthreads();
    sh[c] = y;
    __syncthreads();
    float acc = pw_b[c];
    for (int k = 0; k < 256; ++k) acc += sh[k] * pw_w[k * 256 + c];
    YB[(size_t)tok * D + 768 + c] = (bf16)f2bf(acc);
}

__global__ void __launch_bounds__(256) k_router(const float* __restrict__ X1, const float* __restrict__ g2, const float* __restrict__ rg_w, const float* __restrict__ rg_b,
                                                const float* __restrict__ re_w, const float* __restrict__ re_b, bf16* __restrict__ H2, int* __restrict__ route_e, float* __restrict__ route_w) {
    __shared__ float red[4];
    __shared__ float part[20][4];
    const int tok = blockIdx.x, tid = threadIdx.x, lane = tid & 63, wv = tid >> 6;
    const float4 v = ((const float4*)(X1 + (size_t)tok * D))[tid];
    float s = v.x * v.x + v.y * v.y + v.z * v.z + v.w * v.w;
    s = block_sum256(s, red);
    const float r = 1.0f / sqrtf(s * (1.0f / D) + RMS_EPS);
    const float4 gv = ((const float4*)g2)[tid];
    float hv[4] = {v.x * r * gv.x, v.y * r * gv.y, v.z * r * gv.z, v.w * r * gv.w};
    ((uint2*)(H2 + (size_t)tok * D))[tid] = make_uint2(pk2(hv[0], hv[1]), pk2(hv[2], hv[3]));
    float lg[20];
#pragma unroll
    for (int j = 0; j < 20; ++j) lg[j] = 0.f;
#pragma unroll
    for (int i = 0; i < 4; ++i) {
        const int k = tid * 4 + i;
#pragma unroll
        for (int j = 0; j < 4; ++j) lg[j] += hv[i] * rg_w[k * 4 + j];
#pragma unroll
        for (int j = 0; j < 16; ++j) lg[4 + j] += hv[i] * re_w[k * 16 + j];
    }
#pragma unroll
    for (int j = 0; j < 20; ++j) { const float x = wave_sum(lg[j], lane); if (lane == 0) part[j][wv] = x; }
    __syncthreads();
    if (tid == 0) {
        float gl[4], el[16];
        for (int j = 0; j < 4; ++j) gl[j] = (part[j][0] + part[j][1]) + (part[j][2] + part[j][3]) + rg_b[j];
        for (int j = 0; j < 16; ++j) el[j] = (part[4 + j][0] + part[4 + j][1]) + (part[4 + j][2] + part[4 + j][3]) + re_b[j];
        int gs = 0; float gm = gl[0];
        for (int j = 1; j < 4; ++j) if (gl[j] > gm) { gm = gl[j]; gs = j; }
        float gsum = 0.f;
        for (int j = 0; j < 4; ++j) gsum += expf(gl[j] - gm);
        const float pg = 1.0f / gsum;
        float em = el[gs * 4];
        for (int j = 1; j < 4; ++j) em = fmaxf(em, el[gs * 4 + j]);
        float ep[4], esum = 0.f;
        for (int j = 0; j < 4; ++j) { ep[j] = expf(el[gs * 4 + j] - em); esum += ep[j]; }
        for (int j = 0; j < 4; ++j) ep[j] /= esum;
        int i1 = 0; for (int j = 1; j < 4; ++j) if (ep[j] > ep[i1]) i1 = j;
        int i2 = -1; for (int j = 0; j < 4; ++j) if (j != i1 && (i2 < 0 || ep[j] > ep[i2])) i2 = j;
        const float den = ep[i1] + ep[i2];
        route_e[tok * 2] = gs * 4 + i1; route_e[tok * 2 + 1] = gs * 4 + i2;
        route_w[tok * 2] = pg * (ep[i1] / den); route_w[tok * 2 + 1] = pg * (ep[i2] / den);
    }
}

__global__ void __launch_bounds__(256) k_moe(const bf16* __restrict__ H2, const int* __restrict__ route_e, const float* __restrict__ route_w,
                                             const float* __restrict__ w_gate, const float* __restrict__ w_up, const float* __restrict__ w_down,
                                             const float* Xin, float* Xout) {
    __shared__ float xs[1024];
    __shared__ float hid[2][512];
    const int tok = blockIdx.x, tid = threadIdx.x;
#pragma unroll
    for (int i = 0; i < 4; ++i) xs[tid + 256 * i] = ldb(H2 + (size_t)tok * D + tid + 256 * i);
    __syncthreads();
    for (int s = 0; s < 2; ++s) {
        const int e = route_e[tok * 2 + s]; const float gw = route_w[tok * 2 + s];
        const float* Wg = w_gate + (size_t)e * 1024 * 512; const float* Wu = w_up + (size_t)e * 1024 * 512;
        for (int hh = 0; hh < 2; ++hh) {
            const int h = tid + hh * 256;
            float a = 0.f, bb = 0.f;
            for (int k = 0; k < 1024; ++k) { const float x = xs[k]; a += x * Wg[(size_t)k * 512 + h]; bb += x * Wu[(size_t)k * 512 + h]; }
            hid[s][h] = (a / (1.0f + expf(-a))) * bb * gw;
        }
    }
    __syncthreads();
    float acc[4] = {0.f, 0.f, 0.f, 0.f};
    for (int s = 0; s < 2; ++s) {
        const int e = route_e[tok * 2 + s];
        const float* Wd = w_down + (size_t)e * 512 * 1024;
        for (int h = 0; h < 512; ++h) {
            const float hv = hid[s][h];
#pragma unroll
            for (int i = 0; i < 4; ++i) acc[i] += hv * Wd[(size_t)h * 1024 + tid + i * 256];
        }
    }
#pragma unroll
    for (int i = 0; i < 4; ++i) Xout[(size_t)tok * D + tid + i * 256] = Xin[(size_t)tok * D + tid + i * 256] + acc[i];
}
}
#ifndef MK_NAIVE_MASK
#define MK_NAIVE_MASK 0u
#endif
#ifndef MK_HOSTREP_FLAGS
#define MK_HOSTREP_FLAGS 0
#endif
#ifndef MK_FUSE
#define MK_FUSE 1
#endif
static void launch_naive_phase(int ph, void* const* d_in, float* out, unsigned char* ws, hipStream_t stream) {
    const int l = (ph - 1) / 8, k = (ph - 1) % 8;
    const bf16* PB = (const bf16*)(ws + WS_PB); bf16* HB = (bf16*)(ws + WS_HB); unsigned* mask = (unsigned*)(ws + WS_MASK);
    int* route_e = (int*)(ws + WS_ROUTE_E); float* route_w = (float*)(ws + WS_ROUTE_W);
    const float* const* in = (const float* const*)d_in;
    switch (k) {
    case 1:
        nv::k_index_topk<<<T, 256, 0, stream>>>(PB, mask);
        nv::k_pool<<<T, 256, 0, stream>>>(PB, in[I_POOLW] + (size_t)l * 4 * 64 * 64, in[I_POOLS] + (size_t)l * 256, HB);
        nv::k_conv<<<T, 256, 0, stream>>>(PB, in[I_DWW] + (size_t)l * 31 * 256, in[I_DWB] + (size_t)l * 256, in[I_LNG] + (size_t)l * 256, in[I_LNB] + (size_t)l * 256,
                                          in[I_PWW] + (size_t)l * 256 * 256, in[I_PWB] + (size_t)l * 256, HB);
        break;
    case 2: nv::k_attn<<<T, 256, 0, stream>>>(PB, mask, HB); break;
    case 4: nv::k_router<<<T, 256, 0, stream>>>(out, in[I_N2G] + (size_t)l * D, in[I_RGW] + (size_t)l * D * 4, in[I_RGB] + (size_t)l * 4, in[I_REW] + (size_t)l * D * 16, in[I_REB] + (size_t)l * 16, HB, route_e, route_w); break;
    case 5: break;
    case 6: nv::k_moe<<<T, 256, 0, stream>>>(HB, route_e, route_w, in[I_WG] + (size_t)l * 16 * 1024 * 512, in[I_WU] + (size_t)l * 16 * 1024 * 512, in[I_WDN] + (size_t)l * 16 * 512 * 1024, out, out); break;
    default: break;
    }
}
extern "C" void kernel_launch(void* const* d_in, const int* in_sizes, int n_in, void* d_out, int out_size, void* d_ws, size_t ws_size, hipStream_t stream) {
    static int grid = 0;
    if (grid == 0) {
        if (n_in != 21 || in_sizes[0] != T * D || out_size != T * D || ws_size < WS_END) { fprintf(stderr, "kernel_launch: unexpected shapes / workspace (%d inputs, ws %zu)\n", n_in, ws_size); grid = -1; return; }
        int dev = 0, cus = 0, per_cu = 0;
        if (hipGetDevice(&dev) != hipSuccess || hipDeviceGetAttribute(&cus, hipDeviceAttributeMultiprocessorCount, dev) != hipSuccess) { grid = -1; return; }
        if (hipFuncSetAttribute((const void*)skel_fwd, hipFuncAttributeMaxDynamicSharedMemorySize, LDS_BYTES) != hipSuccess) { fprintf(stderr, "kernel_launch: hipFuncSetAttribute failed\n"); grid = -1; return; }
        if (hipOccupancyMaxActiveBlocksPerMultiprocessor(&per_cu, (const void*)skel_fwd, NWAVES * 64, LDS_BYTES) != hipSuccess || per_cu < 1)
            fprintf(stderr, "kernel_launch: note: occupancy query reports %d workgroups per CU\n", per_cu);
        (void)hipGetLastError();
        grid = cus;
    }
    if (grid < 0) return;
    if (hipMemsetAsync((char*)d_ws + WS_CTL, 0, CTL_ZERO_BYTES, stream) != hipSuccess) return;
    Args a{};
    for (int i = 0; i < 21; ++i) a.in[i] = (const float*)d_in[i];
    a.out = (float*)d_out; a.ws = (unsigned char*)d_ws;
    int ph = 0, li = 0;
    while (ph < N_PHASES) {
        if ((MK_NAIVE_MASK >> ph) & 1u) { launch_naive_phase(ph, d_in, (float*)d_out, (unsigned char*)d_ws, stream); ++ph; continue; }
        int hi = ph + 1;
        if (MK_FUSE) while (hi < N_PHASES && !((MK_NAIVE_MASK >> hi) & 1u)) ++hi;
        a.ph_lo = ph; a.ph_hi = hi; a.li = li++;
        hipLaunchKernelGGL(skel_fwd, dim3(grid), dim3(NWAVES * 64), LDS_BYTES, stream, a);
#ifdef MK_HOSTREP
        if (ph == MK_HOSTREP && hi == ph + 1) { a.pad = MK_HOSTREP_FLAGS; for (int r_ = 1; r_ < MK_HOSTREP_N; ++r_) hipLaunchKernelGGL(skel_fwd, dim3(grid), dim3(NWAVES * 64), LDS_BYTES, stream, a); a.pad = 0; }
#endif
        ph = hi;
    }
}
```

```cpp
#include <hip/hip_runtime.h>
#include <cstdio>
#include <cstdint>
#include <cmath>
#define MK_NAIVE_MASK 0x0u
#define MK_FUSE 1
namespace pg8 {
#define PG8_LAS __attribute__((address_space(3)))
typedef unsigned short bf16_t;
typedef short bf16x8 __attribute__((ext_vector_type(8)));
typedef float f32x4 __attribute__((ext_vector_type(4)));
typedef unsigned u32x4 __attribute__((ext_vector_type(4)));
constexpr int BM = 256, BK = 64, HALF = 128, HTB = HALF * BK * 2  , STAGE_BYTES = 8 * HTB, NXCD = 8, WGM = 8;

__host__ __device__ __forceinline__ int lds_byte(int r, int c) { const int st = (r >> 4) * 2 + (c >> 5), rr = r & 15, cc = c & 31, ob = rr * 64 + cc * 2; return st * 1024 + (ob ^ (((ob >> 9) & 1) << 5)); }
__host__ __device__ __forceinline__ void stage_rc(int b, int& R, int& C) { const int st = b / 1024, sb = b % 1024, swz = sb ^ (((sb >> 9) & 1) << 5); R = (st >> 1) * 16 + swz / 64; C = (st & 1) * 32 + (swz % 64) / 2; }
__host__ __device__ __forceinline__ int perm32(int rho) { const int n = rho >> 4, i = rho & 15; return 8 * (i >> 2) + 4 * n + (i & 3); }

struct Unit { int pm, pn; };
struct Gemm { const bf16_t* A; const bf16_t* Bt; int M, N, K; };

struct StaticOrder {
    int nM, nN, nwg, G, c;
    __host__ __device__ void init(int M, int N, int G_, int c_) { nM = M / BM; nN = N / BM; nwg = nM * nN; G = G_; c = c_; }
    __host__ __device__ bool next(int i, Unit& u) const {
        const long L = (long)i * G + c; if (L >= nwg) return false;
        int wgid = (int)L; { const int q = nwg / NXCD, r = nwg % NXCD, xcd = wgid % NXCD, off = wgid / NXCD; wgid = (xcd < r ? xcd * (q + 1) : r * (q + 1) + (xcd - r) * q) + off; }
        const int nig = WGM * nN, gid = wgid / nig, fm = gid * WGM, gsz = (nM - fm) < WGM ? (nM - fm) : WGM;
        u.pm = fm + ((wgid % nig) % gsz); u.pn = (wgid % nig) / gsz; return true;
    }
    __device__ __forceinline__ void a_ready(const Unit&) const {}
    __device__ __forceinline__ void done(const Unit&) const {}
};

__device__ __forceinline__ unsigned cvt_pk_bf16(float lo, float hi) { unsigned r; asm volatile("v_cvt_pk_bf16_f32 %0, %1, %2" : "=v"(r) : "v"(lo), "v"(hi)); return r; }
typedef float f32x2 __attribute__((ext_vector_type(2)));
__device__ __forceinline__ f32x2 gelu_pk(f32x2 v) {
    const f32x2 av = __builtin_elementwise_abs(v), d = av * 0.2316418882f + 1.0f;
    f32x2 t; t.x = __builtin_amdgcn_rcpf(d.x); t.y = __builtin_amdgcn_rcpf(d.y);
    f32x2 q = t * 0.5307027145f + (-0.7265760135f); q = q * t + 0.7107068705f; q = q * t + (-0.142248368f); q = q * t + 0.127414796f; q = q * t;
    const f32x2 s = (v * v) * (-0.72134752044f);
    f32x2 e; e.x = __builtin_amdgcn_exp2f(s.x); e.y = __builtin_amdgcn_exp2f(s.y);
    const f32x2 m = v * (q * e), r = v - m;
    f32x2 o; o.x = v.x < 0.f ? m.x : r.x; o.y = v.y < 0.f ? m.y : r.y; return o;
}

template <int ACT  > struct EpiBf16 {
    static constexpr bool PERM = true, AFTER_DRAIN = false; static_assert(ACT == 0 || ACT == 1, "EpiBf16: ACT is 0 (none) or 1 (gelu_pk)");
    bf16_t* O; int ldc; const float* bias; int split_cols; size_t split_stride; float scale0;
    __device__ __forceinline__ void operator()(const f32x4 (&acc)[2][2][4][2], const Unit& u, int wr, int wc, int fr, int fq) const {
        const int row0 = u.pm * BM + wr * 64 + fr; int colt = u.pn * BM; bf16_t* base = O;
        float sc = 1.f; if (split_cols) { const int t = colt / split_cols; base += (size_t)t * split_stride; colt -= t * split_cols; if (t == 0) sc = scale0; }
        const int col0 = colt + wc * 32 + 8 * fq, bcol0 = u.pn * BM + wc * 32 + 8 * fq;
        f32x4 bv[2][2];
#pragma unroll
        for (int bj = 0; bj < 2; ++bj)
#pragma unroll
            for (int n = 0; n < 2; ++n) bv[bj][n] = bias ? *(const f32x4*)(bias + bcol0 + bj * HALF + 4 * n) : (f32x4){0.f, 0.f, 0.f, 0.f};
#pragma unroll
        for (int ai = 0; ai < 2; ++ai)
#pragma unroll
            for (int m = 0; m < 4; ++m) { bf16_t* rowp = base + (size_t)(row0 + ai * HALF + m * 16) * ldc + col0;
#pragma unroll
                for (int bj = 0; bj < 2; ++bj) { f32x4 v0 = acc[ai][bj][m][0] + bv[bj][0], v1 = acc[ai][bj][m][1] + bv[bj][1];
                    if (ACT == 1) { f32x2 a = gelu_pk((f32x2){v0[0], v0[1]}), b = gelu_pk((f32x2){v0[2], v0[3]}), c = gelu_pk((f32x2){v1[0], v1[1]}), d = gelu_pk((f32x2){v1[2], v1[3]});
                        v0 = (f32x4){a.x, a.y, b.x, b.y}; v1 = (f32x4){c.x, c.y, d.x, d.y}; }
                    v0 = v0 * sc; v1 = v1 * sc; u32x4 w; w.x = cvt_pk_bf16(v0[0], v0[1]); w.y = cvt_pk_bf16(v0[2], v0[3]); w.z = cvt_pk_bf16(v1[0], v1[1]); w.w = cvt_pk_bf16(v1[2], v1[3]);
                    *(u32x4*)(rowp + bj * HALF) = w; } }
    }
};

struct PanelStats {
    unsigned* xbuf;
    unsigned* cnt;
    unsigned* tmo;
    int ntn; float eps;
    unsigned code;
    __device__ __forceinline__ bool run(const f32x4 (&v)[2][2][4][2], const Unit& u, int wr, int wc, int fr, int fq, PG8_LAS unsigned char* lds, int wid, int lane) const {
        typedef float f32x2v __attribute__((ext_vector_type(2)));
        PG8_LAS f32x2v* P = (PG8_LAS f32x2v*)lds;
        PG8_LAS f32x2v* S = (PG8_LAS f32x2v*)(lds + 8192);
        PG8_LAS unsigned* flag = (PG8_LAS unsigned*)(lds + 8192 + 2048);
#pragma unroll
        for (int ai = 0; ai < 2; ++ai)
#pragma unroll
            for (int m = 0; m < 4; ++m) {
                float s = 0.f;
#pragma unroll
                for (int bj = 0; bj < 2; ++bj)
#pragma unroll
                    for (int n = 0; n < 2; ++n) { const f32x4 x = v[ai][bj][m][n]; s += (x[0] + x[1]) + (x[2] + x[3]); }
                s += __shfl_xor(s, 16); s += __shfl_xor(s, 32);
                const float mw = s * (1.0f / 64.0f); float q = 0.f;
#pragma unroll
                for (int bj = 0; bj < 2; ++bj)
#pragma unroll
                    for (int n = 0; n < 2; ++n) { const f32x4 d = v[ai][bj][m][n] - mw; q += (d[0] * d[0] + d[1] * d[1]) + (d[2] * d[2] + d[3] * d[3]); }
                q += __shfl_xor(q, 16); q += __shfl_xor(q, 32);
                if (fq == 0) P[(ai * HALF + wr * 64 + m * 16 + fr) * 4 + wc] = (f32x2v){mw, q};
            }
        asm volatile("s_waitcnt lgkmcnt(0)" ::: "memory"); __builtin_amdgcn_s_barrier(); asm volatile("" ::: "memory");
#if defined(BROKEN_EXCHANGE_NO_WAIT)
#warning BROKEN CONTROL BUILD: the row-statistics exchange does not wait; results are wrong by design
        if (blockIdx.x >= 64) { const long long t0_ = clock64(); while (clock64() - t0_ < 60000) __builtin_amdgcn_s_sleep(8); }
#endif
        const int row = wid * 32 + (lane & 31);
        if (lane < 32) {
            const f32x2v a = P[row * 4 + 0], b = P[row * 4 + 1], c = P[row * 4 + 2], d = P[row * 4 + 3];
            const float mt = (a.x + b.x + c.x + d.x) * 0.25f;
            const float da = a.x - mt, db = b.x - mt, dc = c.x - mt, dd = d.x - mt;
            const float m2 = (a.y + b.y) + (c.y + d.y) + 64.0f * ((da * da + db * db) + (dc * dc + dd * dd));
            unsigned long long* slot = (unsigned long long*)xbuf + ((size_t)(u.pm * BM + row) * 4 + u.pn);
            __hip_atomic_store(slot, ((unsigned long long)__float_as_uint(m2) << 32) | __float_as_uint(mt), __ATOMIC_RELAXED, __HIP_MEMORY_SCOPE_AGENT);
        }
        asm volatile("s_waitcnt vmcnt(0)" ::: "memory");
        if (lane == 0) __hip_atomic_fetch_add(cnt + 64 * u.pm, 1u, __ATOMIC_RELAXED, __HIP_MEMORY_SCOPE_AGENT);
        if (wid == 0) {
            bool dead = false; const unsigned long long t0 = __builtin_amdgcn_s_memrealtime(); const unsigned want = 8u * (unsigned)ntn;
            for (;;) {
#if defined(BROKEN_EXCHANGE_NO_WAIT)
                break;
#endif
                if ((unsigned)__builtin_amdgcn_readfirstlane(__hip_atomic_load(cnt + 64 * u.pm, __ATOMIC_RELAXED, __HIP_MEMORY_SCOPE_AGENT)) >= want) break;
                if (__builtin_amdgcn_s_memrealtime() - t0 > 2000000ull) {
                    if (lane == 0) { unsigned expect = 0u; __hip_atomic_compare_exchange_strong(tmo + 1, &expect, code | (unsigned)(u.pm & 0xff), __ATOMIC_RELAXED, __ATOMIC_RELAXED, __HIP_MEMORY_SCOPE_AGENT);
                                     __hip_atomic_store(tmo, 1u, __ATOMIC_RELAXED, __HIP_MEMORY_SCOPE_AGENT); }
                    dead = true; break; }
                __builtin_amdgcn_s_sleep(2);
            }
            __builtin_amdgcn_fence(__ATOMIC_ACQUIRE, "agent");
            if (lane == 0) flag[0] = dead ? 1u : 0u;
        }
        asm volatile("s_waitcnt vmcnt(0) lgkmcnt(0)" ::: "memory"); __builtin_amdgcn_s_barrier(); asm volatile("" ::: "memory");
        const bool bad = flag[0] != 0u;
        if (lane < 32) {
            const unsigned long long* slot = (const unsigned long long*)xbuf + (size_t)(u.pm * BM + row) * 4; float mt[4], m2[4]; float ms = 0.f;
#pragma unroll
            for (int t = 0; t < 4; ++t) { if (t < ntn) { const unsigned long long w = __hip_atomic_load(slot + t, __ATOMIC_RELAXED, __HIP_MEMORY_SCOPE_AGENT); mt[t] = __uint_as_float((unsigned)w); m2[t] = __uint_as_float((unsigned)(w >> 32)); } else { mt[t] = 0.f; m2[t] = 0.f; } ms += mt[t]; }
            const float mean = ms / (float)ntn; float q = 0.f;
#pragma unroll
            for (int t = 0; t < 4; ++t) if (t < ntn) { const float dm = mt[t] - mean; q += m2[t] + 256.0f * dm * dm; }
            S[row] = (f32x2v){mean, 1.0f / sqrtf(q / (256.0f * (float)ntn) + eps)};
        }
        asm volatile("s_waitcnt lgkmcnt(0)" ::: "memory"); __builtin_amdgcn_s_barrier(); asm volatile("" ::: "memory");
        return bad;
    }
};
struct EpiLnRes {
    static constexpr bool PERM = false, AFTER_DRAIN = true;
    const float* base; float* out; int ldc; const float* bias; PanelStats st; unsigned poison;
    __device__ __forceinline__ void fused(f32x4 (&acc)[2][2][4][2], const Unit& u, int wr, int wc, int fr, int fq, PG8_LAS unsigned char* lds, int wid, int lane) const {
        typedef float f32x2v __attribute__((ext_vector_type(2)));
        const PG8_LAS f32x2v* S = (const PG8_LAS f32x2v*)(lds + 8192);
        const int col0 = u.pn * BM + wc * 32 + 4 * fq;
#pragma unroll
        for (int bj = 0; bj < 2; ++bj)
#pragma unroll
            for (int n = 0; n < 2; ++n) { const f32x4 bv = bias ? *(const f32x4*)(bias + col0 + bj * HALF + n * 16) : (f32x4){0.f, 0.f, 0.f, 0.f};
#pragma unroll
                for (int ai = 0; ai < 2; ++ai)
#pragma unroll
                    for (int m = 0; m < 4; ++m) acc[ai][bj][m][n] += bv; }
        f32x4 pre[4][2][2];
#pragma unroll
        for (int m = 0; m < 4; ++m) { const size_t off = (size_t)(u.pm * BM + wr * 64 + m * 16 + fr) * ldc + col0;
#pragma unroll
            for (int bj = 0; bj < 2; ++bj)
#pragma unroll
                for (int n = 0; n < 2; ++n) pre[m][bj][n] = *(const f32x4*)(base + off + bj * HALF + n * 16); }
        const bool bad = st.run(acc, u, wr, wc, fr, fq, lds, wid, lane) || poison != 0u;
        const float qnan = __builtin_nanf("");
#pragma unroll
        for (int ai = 0; ai < 2; ++ai)
#pragma unroll
            for (int m = 0; m < 4; ++m) { const int r = ai * HALF + wr * 64 + m * 16 + fr; const f32x2v sr = S[r]; const size_t off = (size_t)(u.pm * BM + r) * ldc + col0;
#pragma unroll
                for (int bj = 0; bj < 2; ++bj)
#pragma unroll
                    for (int n = 0; n < 2; ++n) { const f32x4 bs = ai == 0 ? pre[m][bj][n] : *(const f32x4*)(base + off + bj * HALF + n * 16); f32x4 o = bs + (acc[ai][bj][m][n] - sr.x) * sr.y;
                        if (bad) o = (f32x4){qnan, qnan, qnan, qnan}; *(f32x4*)(out + off + bj * HALF + n * 16) = o; }
                if (m & 1) asm volatile("" ::: "memory"); }
    }
};
struct EpiLnResLn {
    static constexpr bool PERM = false, AFTER_DRAIN = true;
    const float* base; float* out; bf16_t* xn; int ldc; const float* bias; PanelStats st1, st2; unsigned poison;
    __device__ __forceinline__ void fused(f32x4 (&acc)[2][2][4][2], const Unit& u, int wr, int wc, int fr, int fq, PG8_LAS unsigned char* lds, int wid, int lane) const {
        typedef float f32x2v __attribute__((ext_vector_type(2))); typedef unsigned u32x2v __attribute__((ext_vector_type(2)));
        const PG8_LAS f32x2v* S = (const PG8_LAS f32x2v*)(lds + 8192);
        const int col0 = u.pn * BM + wc * 32 + 4 * fq;
#pragma unroll
        for (int bj = 0; bj < 2; ++bj)
#pragma unroll
            for (int n = 0; n < 2; ++n) { const f32x4 bv = bias ? *(const f32x4*)(bias + col0 + bj * HALF + n * 16) : (f32x4){0.f, 0.f, 0.f, 0.f};
#pragma unroll
                for (int ai = 0; ai < 2; ++ai)
#pragma unroll
                    for (int m = 0; m < 4; ++m) acc[ai][bj][m][n] += bv; }
        bool bad = st1.run(acc, u, wr, wc, fr, fq, lds, wid, lane) || poison != 0u;
        const float qnan = __builtin_nanf("");
#pragma unroll
        for (int ai = 0; ai < 2; ++ai)
#pragma unroll
            for (int m = 0; m < 4; ++m) { const int r = ai * HALF + wr * 64 + m * 16 + fr; const f32x2v sr = S[r]; const size_t off = (size_t)(u.pm * BM + r) * ldc + col0;
#pragma unroll
                for (int bj = 0; bj < 2; ++bj)
#pragma unroll
                    for (int n = 0; n < 2; ++n) { const f32x4 bs = *(const f32x4*)(base + off + bj * HALF + n * 16); acc[ai][bj][m][n] = bs + (acc[ai][bj][m][n] - sr.x) * sr.y; }
                asm volatile("" : "+v"(acc[ai][0][m][0]), "+v"(acc[ai][0][m][1]), "+v"(acc[ai][1][m][0]), "+v"(acc[ai][1][m][1]));
                if (m & 1) asm volatile("" ::: "memory"); }
        const bool bad1 = bad;
        bad = st2.run(acc, u, wr, wc, fr, fq, lds, wid, lane) || bad;
#pragma unroll
        for (int ai = 0; ai < 2; ++ai)
#pragma unroll
            for (int m = 0; m < 4; ++m) { const int r = ai * HALF + wr * 64 + m * 16 + fr; const f32x2v sr = S[r]; const size_t off = (size_t)(u.pm * BM + r) * ldc + col0;
#pragma unroll
                for (int bj = 0; bj < 2; ++bj)
#pragma unroll
                    for (int n = 0; n < 2; ++n) { const f32x4 x1 = acc[ai][bj][m][n]; *(f32x4*)(out + off + bj * HALF + n * 16) = bad1 ? (f32x4){qnan, qnan, qnan, qnan} : x1;
                        const f32x4 o = (x1 - sr.x) * sr.y; u32x2v w; w.x = cvt_pk_bf16(o[0], o[1]); w.y = cvt_pk_bf16(o[2], o[3]);
                        if (bad) { w.x = 0x7fc07fc0u; w.y = 0x7fc07fc0u; } *(u32x2v*)(xn + off + bj * HALF + n * 16) = w; }
                asm volatile("" ::: "memory"); }
    }
};

template <class Epi, class Sched, bool ALIGN_EPI = false, bool SP2 = false>
__device__ __forceinline__ void gemm_phase(PG8_LAS unsigned char* lds, const Gemm g, const Sched& S, const Epi& E) {
    int tid_ = threadIdx.x; asm volatile("" : "+v"(tid_));
    const int tid = tid_, wid = __builtin_amdgcn_readfirstlane(tid >> 6), lane = tid & 63, wr = wid >> 2, wc = wid & 3, fr = lane & 15, fq = lane >> 4;
    const int K = g.K, nt = K / BK;
    unsigned voffA[2], voffB[2];
#pragma unroll
    for (int i = 0; i < 2; ++i) { int R, C; stage_rc(tid * 16 + i * 8192, R, C); const int Rb = Epi::PERM ? ((R & ~31) + perm32(R & 31)) : R;
        voffA[i] = (unsigned)(R * K + C) * 2u; voffB[i] = (unsigned)(Rb * K + C) * 2u; }
    const size_t kstep = (size_t)(BK * 2);
    const size_t hstep = (size_t)HALF * K * 2;
    const size_t tstep = 2 * hstep;
    const unsigned ldsw = (unsigned)wid * 1024u;
    const int aoff = lds_byte(wr * 64 + fr, fq * 8), boff = lds_byte(wc * 32 + fr, fq * 8);
#define PG8_SA(b, h) (((b) * 2 + (h)) * HTB)
#define PG8_SB(b, h) ((4 + (b) * 2 + (h)) * HTB)
#define PG8_STAGE(bufoff, gbase, voff) do { _Pragma("unroll") for (int _i = 0; _i < 2; ++_i) \
        __builtin_amdgcn_global_load_lds((const unsigned*)((const char*)(gbase) + (voff)[_i]), (PG8_LAS unsigned*)(lds + (bufoff) + ldsw + _i * 8192), 16, 0, 0); } while (0)
#define PG8_LDA(dst, b, h) do { _Pragma("unroll") for (int m = 0; m < 4; ++m) _Pragma("unroll") for (int k = 0; k < 2; ++k) dst[m][k] = *(const PG8_LAS bf16x8*)(lds + PG8_SA(b, h) + aoff + m * 2048 + k * 1024); } while (0)
#define PG8_LDB(dst, b, h) do { _Pragma("unroll") for (int n = 0; n < 2; ++n) _Pragma("unroll") for (int k = 0; k < 2; ++k) dst[n][k] = *(const PG8_LAS bf16x8*)(lds + PG8_SB(b, h) + boff + n * 2048 + k * 1024); } while (0)
#define PG8_MMA(ai, bj, At, Bt) do { __builtin_amdgcn_s_setprio(1); _Pragma("unroll") for (int m = 0; m < 4; ++m) _Pragma("unroll") for (int n = 0; n < 2; ++n) _Pragma("unroll") for (int k = 0; k < 2; ++k) \
        acc[ai][bj][m][n] = __builtin_amdgcn_mfma_f32_16x16x32_bf16(Bt[n][k], At[m][k], acc[ai][bj][m][n], 0, 0, 0); __builtin_amdgcn_s_setprio(0); } while (0)
#define PG8_WAIT_V(n) asm volatile("s_waitcnt vmcnt(" #n ")" ::: "memory")
#define PG8_WAIT_L(n) asm volatile("s_waitcnt lgkmcnt(" #n ")" ::: "memory")
#define PG8_BAR __builtin_amdgcn_s_barrier()
#define PG8_SCHED __builtin_amdgcn_sched_barrier(0)
    Unit cur, nxt; int ui = 0;
    if (!S.next(0, cur)) return;
    f32x4 acc[2][2][4][2];
#pragma unroll
    for (int a = 0; a < 2; ++a)
#pragma unroll
        for (int b = 0; b < 2; ++b)
#pragma unroll
            for (int m = 0; m < 4; ++m)
#pragma unroll
                for (int n = 0; n < 2; ++n) acc[a][b][m][n] = (f32x4){0.f, 0.f, 0.f, 0.f};
    bf16x8 At[4][2], B0[2][2], B1[2][2];
    const char* cA = (const char*)g.A + (size_t)cur.pm * tstep; const char* cB = (const char*)g.Bt + (size_t)cur.pn * tstep;
    S.a_ready(cur);
    if constexpr (SP2) {
        PG8_STAGE(PG8_SB(0, 0), cB, voffB); PG8_STAGE(PG8_SB(0, 1), cB + hstep, voffB); PG8_STAGE(PG8_SA(0, 0), cA, voffA); PG8_STAGE(PG8_SA(0, 1), cA + hstep, voffA);
        if (wr == 1) PG8_BAR;
        PG8_WAIT_V(2); PG8_BAR;
        PG8_STAGE(PG8_SB(1, 0), cB + kstep, voffB); PG8_STAGE(PG8_SA(1, 0), cA + kstep, voffA); PG8_STAGE(PG8_SB(1, 1), cB + hstep + kstep, voffB);
        PG8_WAIT_V(6); PG8_BAR;
    } else {
        PG8_STAGE(PG8_SB(0, 0), cB, voffB); PG8_STAGE(PG8_SA(0, 0), cA, voffA); PG8_STAGE(PG8_SB(0, 1), cB + hstep, voffB); PG8_STAGE(PG8_SA(0, 1), cA + hstep, voffA);
        if (wr == 1) PG8_BAR;
        PG8_WAIT_V(4); PG8_BAR;
        PG8_STAGE(PG8_SB(1, 0), cB + kstep, voffB); PG8_STAGE(PG8_SA(1, 0), cA + kstep, voffA); PG8_STAGE(PG8_SB(1, 1), cB + hstep + kstep, voffB);
        PG8_WAIT_V(6); PG8_BAR;
    }
    for (;;) {
        const bool has_next = S.next(ui + 1, nxt);
        const char* nA = has_next ? (const char*)g.A + (size_t)nxt.pm * tstep : cA; const char* nB = has_next ? (const char*)g.Bt + (size_t)nxt.pn * tstep : cB;
        for (int t = 0; t < nt; t += 2) {
            const bool last = (t == nt - 2);
            const char* a1 = cA + (size_t)(t + 1) * kstep;
            const char* a2 = last ? nA : cA + (size_t)(t + 2) * kstep; const char* b2 = last ? nB : cB + (size_t)(t + 2) * kstep;
            const char* a3 = a2 + kstep; const char* b3 = b2 + kstep;
            if (last && has_next) S.a_ready(nxt);
            if constexpr (SP2) {
            PG8_LDB(B0, 0, 0); PG8_LDB(B1, 0, 1); PG8_SCHED; PG8_LDA(At, 0, 0); PG8_STAGE(PG8_SA(1, 1), a1 + hstep, voffA);
            PG8_WAIT_V(8); PG8_WAIT_L(0); PG8_BAR; PG8_MMA(0, 0, At, B0); PG8_MMA(0, 1, At, B1); PG8_BAR; PG8_SCHED;
            PG8_LDA(At, 0, 1); PG8_STAGE(PG8_SB(0, 0), b2, voffB); PG8_STAGE(PG8_SB(0, 1), b2 + hstep, voffB); PG8_STAGE(PG8_SA(0, 0), a2, voffA);
            PG8_WAIT_V(8); PG8_WAIT_L(0); PG8_BAR; PG8_MMA(1, 0, At, B0); PG8_MMA(1, 1, At, B1); PG8_BAR; PG8_SCHED;
            PG8_LDB(B0, 1, 0); PG8_LDB(B1, 1, 1); PG8_SCHED; PG8_LDA(At, 1, 0); PG8_STAGE(PG8_SA(0, 1), a2 + hstep, voffA);
            PG8_WAIT_V(8); PG8_WAIT_L(0); PG8_BAR; PG8_MMA(0, 0, At, B0); PG8_MMA(0, 1, At, B1); PG8_BAR; PG8_SCHED;
            PG8_LDA(At, 1, 1); PG8_STAGE(PG8_SB(1, 0), b3, voffB); PG8_STAGE(PG8_SB(1, 1), b3 + hstep, voffB); PG8_STAGE(PG8_SA(1, 0), a3, voffA);
            PG8_WAIT_V(8); PG8_WAIT_L(0); PG8_BAR; PG8_MMA(1, 0, At, B0); PG8_MMA(1, 1, At, B1); PG8_BAR; PG8_SCHED;
            } else {
            PG8_LDB(B0, 0, 0); PG8_SCHED; PG8_LDA(At, 0, 0); PG8_STAGE(PG8_SA(1, 1), a1 + hstep, voffA);
            PG8_WAIT_L(8); PG8_BAR; PG8_WAIT_L(0); PG8_MMA(0, 0, At, B0); PG8_BAR; PG8_SCHED;
            PG8_LDB(B1, 0, 1); PG8_STAGE(PG8_SB(0, 0), b2, voffB);
            PG8_BAR; PG8_WAIT_L(0); PG8_MMA(0, 1, At, B1); PG8_BAR;
            PG8_LDA(At, 0, 1); PG8_STAGE(PG8_SA(0, 0), a2, voffA);
            PG8_BAR; PG8_WAIT_L(0); PG8_MMA(1, 0, At, B0); PG8_BAR; PG8_SCHED;
            PG8_STAGE(PG8_SB(0, 1), b2 + hstep, voffB);
            PG8_WAIT_V(6); PG8_BAR; PG8_MMA(1, 1, At, B1); PG8_BAR;
            PG8_LDB(B0, 1, 0); PG8_SCHED; PG8_LDA(At, 1, 0); PG8_STAGE(PG8_SA(0, 1), a2 + hstep, voffA);
            PG8_WAIT_L(8); PG8_BAR; PG8_WAIT_L(0); PG8_MMA(0, 0, At, B0); PG8_BAR; PG8_SCHED;
            PG8_LDB(B1, 1, 1); PG8_STAGE(PG8_SB(1, 0), b3, voffB);
            PG8_BAR; PG8_WAIT_L(0); PG8_MMA(0, 1, At, B1); PG8_BAR;
            PG8_LDA(At, 1, 1); PG8_STAGE(PG8_SA(1, 0), a3, voffA);
            PG8_BAR; PG8_WAIT_L(0); PG8_MMA(1, 0, At, B0); PG8_BAR; PG8_SCHED;
            PG8_STAGE(PG8_SB(1, 1), b3 + hstep, voffB);
            PG8_WAIT_V(6); PG8_BAR; PG8_MMA(1, 1, At, B1); PG8_BAR;
            }
        }
        if constexpr (ALIGN_EPI) { if (wr == 0) PG8_BAR; }
        if constexpr (!Epi::AFTER_DRAIN) { E(acc, cur, wr, wc, fr, fq); S.done(cur); }
        if (!has_next) break;
#pragma unroll
        for (int a = 0; a < 2; ++a)
#pragma unroll
            for (int b = 0; b < 2; ++b)
#pragma unroll
                for (int m = 0; m < 4; ++m)
#pragma unroll
                    for (int n = 0; n < 2; ++n) acc[a][b][m][n] = (f32x4){0.f, 0.f, 0.f, 0.f};
        cur = nxt; cA = nA; cB = nB; ++ui;
        if constexpr (ALIGN_EPI) { if (wr == 1) PG8_BAR; }
    }
    PG8_WAIT_V(0);
    if constexpr (!ALIGN_EPI) { if (wr == 0) PG8_BAR; }
    PG8_BAR;
    if constexpr (Epi::AFTER_DRAIN) { E.fused(acc, cur, wr, wc, fr, fq, lds, wid, lane); S.done(cur); }
#undef PG8_SA
#undef PG8_SB
#undef PG8_STAGE
#undef PG8_LDA
#undef PG8_LDB
#undef PG8_MMA
#undef PG8_WAIT_V
#undef PG8_WAIT_L
#undef PG8_BAR
#undef PG8_SCHED
}
}
#ifndef PG8_SP2
#define PG8_SP2 true
#endif
#ifndef PG8_ALIGN
#define PG8_ALIGN true
#endif
namespace pg8 {
struct Unit2 { int pm, pn, bk, r0, cnt; };
struct Gemm2 { int K, lda, ldb; };
template <class Epi, class Sched, bool GATHER, bool ALIGN_EPI>
__device__ __forceinline__ void gemm_phase2(PG8_LAS unsigned char* lds, const Gemm2 g, const Sched& S, const Epi& E) {
    int tid_ = threadIdx.x; asm volatile("" : "+v"(tid_));
    const int tid = tid_, wid = __builtin_amdgcn_readfirstlane(tid >> 6), lane = tid & 63, wr = wid >> 2, wc = wid & 3, fr = lane & 15, fq = lane >> 4;
    const int K = g.K, nt = K / BK, jt = nt / 2;
    unsigned voffB[2];
#pragma unroll
    for (int i = 0; i < 2; ++i) { int R, C; stage_rc(tid * 16 + i * 8192, R, C); const int Rb = Epi::PERM ? ((R & ~31) + perm32(R & 31)) : R; voffB[i] = (unsigned)(Rb * g.ldb + C) * 2u; }
    const size_t kstep = (size_t)(BK * 2);
    const size_t hstepB = (size_t)HALF * g.ldb * 2;
    const unsigned ldsw = (unsigned)wid * 1024u;
    const int aoff = lds_byte(wr * 64 + fr, fq * 8), boff = lds_byte(wc * 32 + fr, fq * 8);
#define PG8_SA(b, h) (((b) * 2 + (h)) * HTB)
#define PG8_SB(b, h) ((4 + (b) * 2 + (h)) * HTB)
#define PG8_STAGE(bufoff, gbase, voff) do { _Pragma("unroll") for (int _i = 0; _i < 2; ++_i) \
        __builtin_amdgcn_global_load_lds((const unsigned*)((const char*)(gbase) + (voff)[_i]), (PG8_LAS unsigned*)(lds + (bufoff) + ldsw + _i * 8192), 16, 0, 0); } while (0)
#define PG8_LDA(dst, b, h) do { _Pragma("unroll") for (int m = 0; m < 4; ++m) _Pragma("unroll") for (int k = 0; k < 2; ++k) dst[m][k] = *(const PG8_LAS bf16x8*)(lds + PG8_SA(b, h) + aoff + m * 2048 + k * 1024); } while (0)
#define PG8_LDB(dst, b, h) do { _Pragma("unroll") for (int n = 0; n < 2; ++n) _Pragma("unroll") for (int k = 0; k < 2; ++k) dst[n][k] = *(const PG8_LAS bf16x8*)(lds + PG8_SB(b, h) + boff + n * 2048 + k * 1024); } while (0)
#define PG8_MMA(ai, bj, At, Bt) do { __builtin_amdgcn_s_setprio(1); _Pragma("unroll") for (int m = 0; m < 4; ++m) _Pragma("unroll") for (int n = 0; n < 2; ++n) _Pragma("unroll") for (int k = 0; k < 2; ++k) \
        acc[ai][bj][m][n] = __builtin_amdgcn_mfma_f32_16x16x32_bf16(Bt[n][k], At[m][k], acc[ai][bj][m][n], 0, 0, 0); __builtin_amdgcn_s_setprio(0); } while (0)
#define PG8_WAIT_V(n) asm volatile("s_waitcnt vmcnt(" #n ")" ::: "memory")
#define PG8_WAIT_L(n) asm volatile("s_waitcnt lgkmcnt(" #n ")" ::: "memory")
#define PG8_BAR __builtin_amdgcn_s_barrier()
#define PG8_SCHED __builtin_amdgcn_sched_barrier(0)
#define PG8_AOFF(dst0, dst1, u) do { _Pragma("unroll") for (int _i = 0; _i < 2; ++_i) { int R_, C_; stage_rc(tid * 16 + _i * 8192, R_, C_); \
        if (GATHER) { dst0[_i] = (unsigned)(S.a_row(u, R_) * g.lda + C_) * 2u; dst1[_i] = (unsigned)(S.a_row(u, HALF + R_) * g.lda + C_) * 2u; } \
        else { dst0[_i] = (unsigned)(R_ * g.lda + C_) * 2u; dst1[_i] = (unsigned)((HALF + R_) * g.lda + C_) * 2u; } } } while (0)
    Unit2 cur, nxt; int ui = 0;
    if (!S.next(0, cur)) return;
    f32x4 acc[2][2][4][2];
#pragma unroll
    for (int a = 0; a < 2; ++a)
#pragma unroll
        for (int b = 0; b < 2; ++b)
#pragma unroll
            for (int m = 0; m < 4; ++m)
#pragma unroll
                for (int n = 0; n < 2; ++n) acc[a][b][m][n] = (f32x4){0.f, 0.f, 0.f, 0.f};
    bf16x8 At[4][2], B0[2][2], B1[2][2];
    unsigned vA0[2], vA1[2], nA0[2], nA1[2];
    PG8_AOFF(vA0, vA1, cur);
    const char* cA = S.a_base(cur); const char* cB = S.b_base(cur); long cJ = S.b_jump(cur);
    PG8_STAGE(PG8_SB(0, 0), cB, voffB); PG8_STAGE(PG8_SB(0, 1), cB + hstepB, voffB); PG8_STAGE(PG8_SA(0, 0), cA, vA0); PG8_STAGE(PG8_SA(0, 1), cA, vA1);
    if (wr == 1) PG8_BAR;
    PG8_WAIT_V(2); PG8_BAR;
    PG8_STAGE(PG8_SB(1, 0), cB + kstep, voffB); PG8_STAGE(PG8_SA(1, 0), cA + kstep, vA0); PG8_STAGE(PG8_SB(1, 1), cB + hstepB + kstep, voffB);
    PG8_WAIT_V(6); PG8_BAR;
    for (;;) {
        const bool has_next = S.next(ui + 1, nxt);
        const char* nA = cA; const char* nB = cB;
        if (has_next) { nA = S.a_base(nxt); nB = S.b_base(nxt); }
        if (GATHER && has_next) { PG8_AOFF(nA0, nA1, nxt); }
        else {
#pragma unroll
            for (int i = 0; i < 2; ++i) { nA0[i] = vA0[i]; nA1[i] = vA1[i]; } }
        for (int t = 0; t < nt; t += 2) {
            const bool last = (t == nt - 2);
            const char* a1 = cA + (size_t)(t + 1) * kstep;
            const char* a2 = last ? nA : cA + (size_t)(t + 2) * kstep;
            const char* b2 = last ? nB : cB + (size_t)(t + 2) * kstep + ((t + 2) >= jt ? cJ : 0l);
            const char* a3 = a2 + kstep; const char* b3 = b2 + kstep;
            unsigned w0[2], w1[2];
#pragma unroll
            for (int i = 0; i < 2; ++i) { w0[i] = last ? nA0[i] : vA0[i]; w1[i] = last ? nA1[i] : vA1[i]; }
            PG8_LDB(B0, 0, 0); PG8_LDB(B1, 0, 1); PG8_SCHED; PG8_LDA(At, 0, 0); PG8_STAGE(PG8_SA(1, 1), a1, vA1);
            PG8_WAIT_V(8); PG8_WAIT_L(0); PG8_BAR; PG8_MMA(0, 0, At, B0); PG8_MMA(0, 1, At, B1); PG8_BAR; PG8_SCHED;
            PG8_LDA(At, 0, 1); PG8_STAGE(PG8_SB(0, 0), b2, voffB); PG8_STAGE(PG8_SB(0, 1), b2 + hstepB, voffB); PG8_STAGE(PG8_SA(0, 0), a2, w0);
            PG8_WAIT_V(8); PG8_WAIT_L(0); PG8_BAR; PG8_MMA(1, 0, At, B0); PG8_MMA(1, 1, At, B1); PG8_BAR; PG8_SCHED;
            PG8_LDB(B0, 1, 0); PG8_LDB(B1, 1, 1); PG8_SCHED; PG8_LDA(At, 1, 0); PG8_STAGE(PG8_SA(0, 1), a2, w1);
            PG8_WAIT_V(8); PG8_WAIT_L(0); PG8_BAR; PG8_MMA(0, 0, At, B0); PG8_MMA(0, 1, At, B1); PG8_BAR; PG8_SCHED;
            PG8_LDA(At, 1, 1); PG8_STAGE(PG8_SB(1, 0), b3, voffB); PG8_STAGE(PG8_SB(1, 1), b3 + hstepB, voffB); PG8_STAGE(PG8_SA(1, 0), a3, w0);
            PG8_WAIT_V(8); PG8_WAIT_L(0); PG8_BAR; PG8_MMA(1, 0, At, B0); PG8_MMA(1, 1, At, B1); PG8_BAR; PG8_SCHED;
        }
        if constexpr (ALIGN_EPI) { if (wr == 0) PG8_BAR; }
        E(acc, cur, wr, wc, fr, fq);
        if (!has_next) break;
#pragma unroll
        for (int a = 0; a < 2; ++a)
#pragma unroll
            for (int b = 0; b < 2; ++b)
#pragma unroll
                for (int m = 0; m < 4; ++m)
#pragma unroll
                    for (int n = 0; n < 2; ++n) acc[a][b][m][n] = (f32x4){0.f, 0.f, 0.f, 0.f};
        cur = nxt; cA = nA; cB = nB; cJ = S.b_jump(cur); ++ui;
#pragma unroll
        for (int i = 0; i < 2; ++i) { vA0[i] = nA0[i]; vA1[i] = nA1[i]; }
        if constexpr (ALIGN_EPI) { if (wr == 1) PG8_BAR; }
    }
    PG8_WAIT_V(0);
    if constexpr (!ALIGN_EPI) { if (wr == 0) PG8_BAR; }
    PG8_BAR;
#undef PG8_AOFF
#undef PG8_SA
#undef PG8_SB
#undef PG8_STAGE
#undef PG8_LDA
#undef PG8_LDB
#undef PG8_MMA
#undef PG8_WAIT_V
#undef PG8_WAIT_L
#undef PG8_BAR
#undef PG8_SCHED
}
}
#include <hip/hip_bf16.h>
#include <cmath>
namespace attn_body {
using bf16=__hip_bfloat16;
using bf16x8=__attribute__((ext_vector_type(8)))short;
using s16x4=__attribute__((ext_vector_type(4)))short;
using f32x16=__attribute__((ext_vector_type(16)))float;
using u32x4=__attribute__((ext_vector_type(4)))unsigned;
constexpr int BATCH=4,NHEAD=8,SEQ=4096,D=64,DM=3072,DMO=1024;
constexpr int NW=8,QBLK=32,QB=QBLK*NW,KVBLK=64,NQB=SEQ/QB;
constexpr int ATTN_PITCH=DM, ATTN_UNIT_ROWS=QB;
__device__ __forceinline__ int crow(int r,int hi){return (r&3)+8*(r>>2)+4*hi;}
#define SBAR() __builtin_amdgcn_sched_barrier(0)
__device__ __forceinline__ void bmask(f32x16&p0,f32x16&p1,unsigned lo32,unsigned hi32,int hi){
  const unsigned a=lo32>>(4*hi), b=hi32>>(4*hi);
  #pragma unroll
  for(int r=0;r<16;++r){const unsigned bit=1u<<((r&3)+8*(r>>2)); if(!(a&bit))p0[r]=-1024.0f; if(!(b&bit))p1[r]=-1024.0f;}
}
typedef unsigned u32x2m __attribute__((ext_vector_type(2)));
__device__ __forceinline__ void mload(u32x2m&dst,const unsigned long long*base,unsigned off){ asm volatile("global_load_dwordx2 %0, %1, %2":"=v"(dst):"v"(off),"s"(base):"memory"); }

constexpr int NSLOT=3, SLOTB=8192;
constexpr int LDS_K=0, LDS_V=NSLOT*SLOTB, LDS_WS=2*NSLOT*SLOTB, LDS_OST=LDS_WS+NW*64*4, LDS_BYTES=LDS_OST+NW*4096;
constexpr float C2=0.125f*1.4426950408889634f;
__device__ __forceinline__ void glds16(const void*sbase,unsigned voff,unsigned lds_dst){unsigned keep;
  asm volatile("s_mov_b32 %0, m0\n\ts_mov_b32 m0, %2\n\ts_nop 0\n\tglobal_load_lds_dwordx4 %1, %3\n\ts_mov_b32 m0, %0":"=&s"(keep):"v"(voff),"s"(lds_dst),"s"(sbase):"memory");}
__device__ __forceinline__ float max3f(float a,float b,float c){float r;asm("v_max3_f32 %0, %1, %2, %3":"=v"(r):"v"(a),"v"(b),"v"(c));return r;}
__device__ __forceinline__ float max2f(float a,float b){float r;asm("v_max_f32_e32 %0, %1, %2":"=v"(r):"v"(a),"v"(b));return r;}
__device__ __forceinline__ float fadd_s(float a,float b){float r;asm("v_add_f32_e32 %0, %1, %2":"=v"(r):"v"(a),"v"(b));return r;}
__device__ __forceinline__ float fsub_s(float a,float b){float r;asm("v_sub_f32_e32 %0, %1, %2":"=v"(r):"v"(a),"v"(b));return r;}
typedef float f32x2_t __attribute__((ext_vector_type(2))); typedef __bf16 bf16x2_t __attribute__((ext_vector_type(2)));
__device__ __forceinline__ unsigned cvtpk_s(float lo,float hi){f32x2_t v={lo,hi};bf16x2_t b=__builtin_convertvector(v,bf16x2_t);return __builtin_bit_cast(unsigned,b);}
#define WAIT_BAR(N) asm volatile("s_waitcnt vmcnt(" #N ") lgkmcnt(0)\n\ts_barrier":::"memory")

__device__ __forceinline__ void qkt(f32x16&p0,f32x16&p1,const char*Kslot,const bf16x8*qr,const f32x16&negm,int r32,int hi){
  const char*kb=Kslot+hi*1024+r32*16;
  #pragma unroll
  for(int d0=0;d0<4;++d0){
    const bf16x8 b0=*reinterpret_cast<const bf16x8*>(kb+d0*2048);
    const bf16x8 b1=*reinterpret_cast<const bf16x8*>(kb+d0*2048+512);
    if(d0==0){p0=__builtin_amdgcn_mfma_f32_32x32x16_bf16(b0,qr[0],negm,0,0,0);p1=__builtin_amdgcn_mfma_f32_32x32x16_bf16(b1,qr[0],negm,0,0,0);}
    else{p0=__builtin_amdgcn_mfma_f32_32x32x16_bf16(b0,qr[d0],p0,0,0,0);p1=__builtin_amdgcn_mfma_f32_32x32x16_bf16(b1,qr[d0],p1,0,0,0);}}
}
typedef __attribute__((address_space(3))) const char* lds_cptr;
typedef short v4i16_t __attribute__((ext_vector_type(4)));
__device__ __forceinline__ void kload8(bf16x8*kf,lds_cptr kp){
  kf[0]=*(const __attribute__((address_space(3))) bf16x8*)(kp);      kf[1]=*(const __attribute__((address_space(3))) bf16x8*)(kp+512);
  kf[2]=*(const __attribute__((address_space(3))) bf16x8*)(kp+2048); kf[3]=*(const __attribute__((address_space(3))) bf16x8*)(kp+2560);
  kf[4]=*(const __attribute__((address_space(3))) bf16x8*)(kp+4096); kf[5]=*(const __attribute__((address_space(3))) bf16x8*)(kp+4608);
  kf[6]=*(const __attribute__((address_space(3))) bf16x8*)(kp+6144); kf[7]=*(const __attribute__((address_space(3))) bf16x8*)(kp+6656);
}
__device__ __forceinline__ void kload2(bf16x8*kf,lds_cptr kp,int j){ kf[2*j]=*(const __attribute__((address_space(3))) bf16x8*)(kp+j*2048); kf[2*j+1]=*(const __attribute__((address_space(3))) bf16x8*)(kp+j*2048+512); }
__device__ __forceinline__ s16x4 vtr(lds_cptr p){ return __builtin_bit_cast(s16x4,__builtin_amdgcn_ds_read_tr16_b64_v4i16((__attribute__((address_space(3))) v4i16_t*)p)); }
__device__ __forceinline__ float rowmax(const f32x16&p0,const f32x16&p1){
  float a=max3f(p0[0],p0[1],p1[0]),b=max3f(p0[2],p0[3],p1[1]);a=max3f(a,p1[2],p1[3]);
  #pragma unroll
  for(int r=4;r<16;r+=4){a=max3f(a,p0[r],p0[r+1]);b=max3f(b,p0[r+2],p0[r+3]);a=max3f(a,p1[r],p1[r+1]);b=max3f(b,p1[r+2],p1[r+3]);}
  const float m=max2f(a,b);
  auto rr=__builtin_amdgcn_permlane32_swap(__float_as_uint(m),__float_as_uint(m),false,false);
  return max2f(__uint_as_float(rr[0]),__uint_as_float(rr[1]));
}
__device__ __forceinline__ void pv(f32x16*o,int vb,bf16x8 pa0,bf16x8 pa1,bf16x8 pa2,bf16x8 pa3){
  #pragma unroll
  for(int d0=0;d0<2;++d0){s16x4 lo[4],hi[4];
    #pragma unroll
    for(int ks=0;ks<4;++ks){
      asm volatile("ds_read_b64_tr_b16 %0,%1 offset:%c2":"=&v"(lo[ks]):"v"(vb),"i"(d0*4096+ks*1024):"memory");
      asm volatile("ds_read_b64_tr_b16 %0,%1 offset:%c2":"=&v"(hi[ks]):"v"(vb),"i"(d0*4096+ks*1024+512):"memory");}
    asm volatile("s_waitcnt lgkmcnt(0)":::"memory");SBAR();
    #define PK(k) (bf16x8){lo[k][0],lo[k][1],lo[k][2],lo[k][3],hi[k][0],hi[k][1],hi[k][2],hi[k][3]}
    o[d0]=__builtin_amdgcn_mfma_f32_32x32x16_bf16(pa0,PK(0),o[d0],0,0,0);
    o[d0]=__builtin_amdgcn_mfma_f32_32x32x16_bf16(pa1,PK(1),o[d0],0,0,0);
    o[d0]=__builtin_amdgcn_mfma_f32_32x32x16_bf16(pa2,PK(2),o[d0],0,0,0);
    o[d0]=__builtin_amdgcn_mfma_f32_32x32x16_bf16(pa3,PK(3),o[d0],0,0,0);
    #undef PK
  }
}

#ifndef ATTN_STORE16
#define ATTN_STORE16(p,v) (*(u32x4*)(p)=(v))
#endif
template<int THRL> __device__ __forceinline__ void attn_unit(int b,int h,int qb,const bf16*Q,const bf16*__restrict__ K,const bf16*__restrict__ V,bf16*O,const unsigned long long*MK,char*shm){
  int tid_=threadIdx.x; asm volatile("":"+v"(tid_));
  const int tid=tid_,lane=tid&63,r32=lane&31,hi=lane>>5; const int wid=__builtin_amdgcn_readfirstlane(tid>>6);
  const long rowbase=(long)b*SEQ; const int q0=qb*QB;
  const bf16*Qw=Q+(rowbase+q0+wid*QBLK)*DM+h*D;
  const bf16*Kh=K+rowbase*DM+h*D,*Vh=V+rowbase*DM+h*D;
  const unsigned lds0=(unsigned)(uintptr_t)shm;
  float*wsf=(float*)(shm+LDS_WS)+wid*64;
  const bf16*ksb=Kh+wid*8; const unsigned kvo=(unsigned)lane*(DM*2u);
  const bf16*vsb=Vh+(long)(16*(wid&3))*DM+(wid>>2)*32; const unsigned vvo=(unsigned)(lane>>2)*(DM*2u)+(unsigned)(lane&3)*16u;
  const unsigned kdst=lds0+LDS_K+wid*1024, vdst=lds0+LDS_V+wid*1024;
  #define DMA_K(t,slot) glds16(ksb+(long)(t)*KVBLK*DM,kvo,(unsigned)__builtin_amdgcn_readfirstlane(kdst+(slot)))
  #define DMA_V(t,slot) glds16(vsb+(long)(t)*KVBLK*DM,vvo,(unsigned)__builtin_amdgcn_readfirstlane(vdst+(slot)))
  const int vb0=(int)(lds0+LDS_V)+((lane>>4)&1)*32+(lane&3)*8+(4*hi+((lane&15)>>2))*64;
  const char*Kbase=shm+LDS_K; bf16x8 kf[8];
  const lds_cptr shm3=(lds_cptr)shm; const lds_cptr kp0=shm3+LDS_K+hi*1024+r32*16; const lds_cptr vp0=shm3+LDS_V+((lane>>4)&1)*32+(lane&3)*8+(4*hi+((lane&15)>>2))*64;
  const int NT=(q0+QB)/KVBLK;
  const unsigned long long*mbase=MK+((rowbase+q0+wid*QBLK)<<6);
  const unsigned moff=(unsigned)r32*512u;
  u32x2m mE,mO; mload(mE,mbase,moff); mload(mO,mbase,moff+8u);
  DMA_K(0,0);DMA_V(0,0);DMA_K(1,SLOTB);
  bf16x8 qr[4];
  #pragma unroll
  for(int d0=0;d0<4;++d0)qr[d0]=*reinterpret_cast<const bf16x8*>(&Qw[(long)r32*DM+d0*16+hi*8]);
  float mhat=0.f,l_reg=0.f;f32x16 o[2];o[0]=f32x16{};o[1]=f32x16{};f32x16 negm=f32x16{};asm volatile("":"+v"(negm));
  const int qrel=wid*QBLK+r32;
  #define CMASK(P0,P1,M) do{ asm volatile("":"+v"(M)); bmask(P0,P1,M[0],M[1],hi); }while(0)
  bool resc=false;
  #define START(P0,P1) do{ const float rm=rowmax(P0,P1); resc=false; \
    { const float dl=rm; mhat=fadd_s(mhat,dl); \
      _Pragma("unroll") for(int r=0;r<16;++r){P0[r]=fsub_s(P0[r],dl);P1[r]=fsub_s(P1[r],dl);} \
      _Pragma("unroll") for(int r=0;r<16;++r)negm[r]=-mhat; asm volatile("":"+v"(negm)); } \
    _Pragma("unroll") for(int r=0;r<16;++r)P0[r]=__builtin_amdgcn_exp2f(P0[r]); }while(0)
  #define RESC() do{ if(resc){ asm volatile("s_waitcnt lgkmcnt(0)":::"memory"); \
      _Pragma("unroll") for(int d_=0;d_<2;++d_) _Pragma("unroll") for(int r=0;r<16;++r)o[d_][r]*=wsf[crow(r,hi)]; } }while(0)
  f32x16 pA0,pA1,pB0,pB1;
  int sl_prev=0,sl_cur=0,sl_next=SLOTB;
  #define ROT() do{sl_prev=sl_cur;sl_cur=sl_next;sl_next=(sl_next==(NSLOT-1)*SLOTB)?0:sl_next+SLOTB;}while(0)
  DMA_K(2,2*SLOTB);
  WAIT_BAR(3);
  qkt(pA0,pA1,Kbase,qr,negm,r32,hi);asm volatile("s_nop 15\n\ts_nop 7":"+v"(pA0),"+v"(pA1));CMASK(pA0,pA1,mE);
  START(pA0,pA1);
  _Pragma("unroll") for(int r=0;r<16;++r)pA1[r]=__builtin_amdgcn_exp2f(pA1[r]);
  WAIT_BAR(0);
  DMA_K(3,0);DMA_V(1,SLOTB);
  ROT();
  kload8(kf,kp0+sl_cur);
  WAIT_BAR(2);
  s16x4 vlo[8],vhi[8]; u32x4 pw0,pw1,pw2,pw3;
  #define PKW(P,B) cvtpk_s(P[B],P[B+1])
  #define PAF(k) __builtin_bit_cast(bf16x8,pw##k)
  #define VFR(i) (bf16x8){vlo[i][0],vlo[i][1],vlo[i][2],vlo[i][3],vhi[i][0],vhi[i][1],vhi[i][2],vhi[i][3]}
  #define PIN(x) asm volatile("":"+v"(x))
  #define MX3(a,b,c) __builtin_fmaxf(__builtin_fmaxf((a),(b)),(c))
  #define GAPA(MF,A0,A1,A2,A3,W0,W1,PW) do{ MF; sacc+=A0; sacc+=A1; sacc+=A2; sacc+=A3; PIN(sacc); W0; W1; PIN(PW); SBAR(); }while(0)
  #define EX(v) __builtin_amdgcn_exp2f(v)
  #define GAPB(MF,X,B) do{ MF; X[B]=EX(X[B]); X[B+1]=EX(X[B+1]); X[B+2]=EX(X[B+2]); X[B+3]=EX(X[B+3]); PIN(X); SBAR(); }while(0)
  #define VRD(i) do{ vlo[i]=vtr(vp_+(((i)>>2)*4096+((i)&3)*1024)); vhi[i]=vtr(vp_+(((i)>>2)*4096+((i)&3)*1024+512)); }while(0)
  #define KRD(G,j) do{ if(G){ kload2(kf,kp0+sl_next,j); SBAR(); } }while(0)
  #define STEP(C0,C1,P0,P1,t,GK,GV,GL,MC,MN,GM) do{ SBAR(); \
    if(GM){ mload(MN,mbase,moff+8u*(unsigned)((t)+1)); } \
    const lds_cptr vp_=vp0+sl_prev; \
    VRD(0); SBAR(); float sacc=(P0[0]+P0[1]); \
    GAPA(C0=__builtin_amdgcn_mfma_f32_32x32x16_bf16(kf[0],qr[0],negm,0,0,0), P0[2],P0[3],P0[4],P0[5],     pw0[0]=PKW(P0,0), pw0[1]=PKW(P0,2), pw0); \
    VRD(4); SBAR(); GAPA(C1=__builtin_amdgcn_mfma_f32_32x32x16_bf16(kf[1],qr[0],negm,0,0,0), P0[6],P0[7],P0[8],P0[9],     pw0[2]=PKW(P0,4), pw0[3]=PKW(P0,6), pw0); \
    VRD(1); SBAR(); GAPA(C0=__builtin_amdgcn_mfma_f32_32x32x16_bf16(kf[2],qr[1],C0,0,0,0),   P0[10],P0[11],P0[12],P0[13], pw1[0]=PKW(P0,8), pw1[1]=PKW(P0,10), pw1); \
    VRD(5); SBAR(); GAPA(C1=__builtin_amdgcn_mfma_f32_32x32x16_bf16(kf[3],qr[1],C1,0,0,0),   P0[14],P0[15],P1[0],P1[1],   pw1[2]=PKW(P0,12),pw1[3]=PKW(P0,14), pw1); \
    VRD(2); SBAR(); GAPA(C0=__builtin_amdgcn_mfma_f32_32x32x16_bf16(kf[4],qr[2],C0,0,0,0),   P1[2],P1[3],P1[4],P1[5],     pw2[0]=PKW(P1,0), pw2[1]=PKW(P1,2), pw2); \
    VRD(6); SBAR(); GAPA(C1=__builtin_amdgcn_mfma_f32_32x32x16_bf16(kf[5],qr[2],C1,0,0,0),   P1[6],P1[7],P1[8],P1[9],     pw2[2]=PKW(P1,4), pw2[3]=PKW(P1,6), pw2); \
    VRD(3); SBAR(); GAPA(C0=__builtin_amdgcn_mfma_f32_32x32x16_bf16(kf[6],qr[3],C0,0,0,0),   P1[10],P1[11],P1[12],P1[13], pw3[0]=PKW(P1,8), pw3[1]=PKW(P1,10), pw3); \
    VRD(7); SBAR(); GAPA(C1=__builtin_amdgcn_mfma_f32_32x32x16_bf16(kf[7],qr[3],C1,0,0,0),   P1[14],P1[15],0.f,0.f,       pw3[2]=PKW(P1,12),pw3[3]=PKW(P1,14), pw3); \
    l_reg+=sacc; \
    if(GK){DMA_K((t)+3,sl_cur);} if(GV){DMA_V((t)+1,sl_next);} \
    CMASK(C0,C1,MC); \
    { float a=MX3(C0[0],C0[1],C1[0]),b=MX3(C0[2],C0[3],C1[1]); a=MX3(a,C1[2],C1[3]); \
      _Pragma("unroll") for(int r=4;r<16;r+=4){a=MX3(a,C0[r],C0[r+1]);b=MX3(b,C0[r+2],C0[r+3]);a=MX3(a,C1[r],C1[r+1]);b=MX3(b,C1[r+2],C1[r+3]);} \
      float rm=__builtin_fmaxf(a,b); { auto rr=__builtin_amdgcn_permlane32_swap(__float_as_uint(rm),__float_as_uint(rm),false,false); rm=__builtin_fmaxf(__uint_as_float(rr[0]),__uint_as_float(rr[1])); } \
      resc=false; \
      if(__builtin_expect(__any(rm>(float)THRL),0)){ const float dl=__builtin_fmaxf(rm,0.f); mhat+=dl; \
        _Pragma("unroll") for(int r=0;r<16;++r){C0[r]-=dl;C1[r]-=dl;} \
        _Pragma("unroll") for(int r=0;r<16;++r)negm[r]=-mhat; asm volatile("":"+v"(negm)); \
        const float f=__builtin_amdgcn_exp2f(-dl); l_reg*=f; if(hi==0)wsf[r32]=f; resc=true; } } \
    SBAR(); \
    GAPB(o[0]=__builtin_amdgcn_mfma_f32_32x32x16_bf16(PAF(0),VFR(0),o[0],0,0,0), C0,0); \
    GAPB(o[1]=__builtin_amdgcn_mfma_f32_32x32x16_bf16(PAF(0),VFR(4),o[1],0,0,0), C0,4); \
    KRD(GL,0); GAPB(o[0]=__builtin_amdgcn_mfma_f32_32x32x16_bf16(PAF(1),VFR(1),o[0],0,0,0), C0,8); \
    KRD(GL,1); GAPB(o[1]=__builtin_amdgcn_mfma_f32_32x32x16_bf16(PAF(1),VFR(5),o[1],0,0,0), C0,12); \
    KRD(GL,2); GAPB(o[0]=__builtin_amdgcn_mfma_f32_32x32x16_bf16(PAF(2),VFR(2),o[0],0,0,0), C1,0); \
    KRD(GL,3); GAPB(o[1]=__builtin_amdgcn_mfma_f32_32x32x16_bf16(PAF(2),VFR(6),o[1],0,0,0), C1,4); \
    GAPB(o[0]=__builtin_amdgcn_mfma_f32_32x32x16_bf16(PAF(3),VFR(3),o[0],0,0,0), C1,8); \
    GAPB(o[1]=__builtin_amdgcn_mfma_f32_32x32x16_bf16(PAF(3),VFR(7),o[1],0,0,0), C1,12); \
    }while(0)
  int t=1;
  for(;t+5<NT;t+=2){
    STEP(pB0,pB1,pA0,pA1,t,true,true,true,mO,mE,true);     WAIT_BAR(2); RESC(); ROT();
    STEP(pA0,pA1,pB0,pB1,t+1,true,true,true,mE,mO,true);   WAIT_BAR(2); RESC(); ROT();
  }
  #define ENDW(tt) do{ if((tt)+3<NT){WAIT_BAR(2);} else if((tt)+2<NT){WAIT_BAR(1);} else {WAIT_BAR(0);} }while(0)
  for(;t+1<NT;t+=2){
    STEP(pB0,pB1,pA0,pA1,t,(t+3<NT),(t+1<NT),(t+1<NT),mO,mE,true);       ENDW(t);   RESC(); ROT();
    STEP(pA0,pA1,pB0,pB1,t+1,(t+4<NT),(t+2<NT),(t+2<NT),mE,mO,true);     ENDW(t+1); RESC(); ROT();
  }
  STEP(pB0,pB1,pA0,pA1,NT-1,false,false,false,mO,mE,false); RESC();
  { float sacc=pB0[0]+pB0[1]; _Pragma("unroll") for(int r=2;r<16;++r)sacc+=pB0[r]; _Pragma("unroll") for(int r=0;r<16;++r)sacc+=pB1[r]; l_reg+=sacc;
    pw0=(u32x4){PKW(pB0,0),PKW(pB0,2),PKW(pB0,4),PKW(pB0,6)};pw1=(u32x4){PKW(pB0,8),PKW(pB0,10),PKW(pB0,12),PKW(pB0,14)};pw2=(u32x4){PKW(pB1,0),PKW(pB1,2),PKW(pB1,4),PKW(pB1,6)};pw3=(u32x4){PKW(pB1,8),PKW(pB1,10),PKW(pB1,12),PKW(pB1,14)};
    SBAR(); pv(o,vb0+sl_cur,PAF(0),PAF(1),PAF(2),PAF(3)); }
  #undef PKW
  #undef PAF
  #undef VFR
  #undef PIN
  #undef MX3
  #undef GAPA
  #undef GAPB
  #undef EX
  #undef VRD
  #undef KRD
  #undef STEP
  #undef ENDW
  {auto rr=__builtin_amdgcn_permlane32_swap(__float_as_uint(l_reg),__float_as_uint(l_reg),false,false);l_reg=__uint_as_float(rr[0])+__uint_as_float(rr[1]);}
  int lane_e=lane; asm volatile("":"+v"(lane_e));
  const int r32e=lane_e&31,hie=lane_e>>5;
  if(hie==0)wsf[32+r32e]=l_reg;asm volatile("s_waitcnt lgkmcnt(0)":::"memory");
  float rli[16];
  #pragma unroll
  for(int r=0;r<16;++r)rli[r]=__builtin_amdgcn_rcpf(wsf[32+crow(r,hie)]);
  bf16*Ow=O+(rowbase+q0+wid*QBLK)*DMO+h*D;
  { bf16*stg=(bf16*)(shm+LDS_OST)+wid*2048;
    #pragma unroll
    for(int r=0;r<16;++r){const int orow=crow(r,hie);
      #pragma unroll
      for(int d0=0;d0<2;++d0)stg[orow*64+d0*32+r32e]=__float2bfloat16(o[d0][r]*rli[r]);}
    asm volatile("s_waitcnt lgkmcnt(0)":::"memory");
    #pragma unroll
    for(int i=0;i<4;++i){const int row=i*8+(lane_e>>3),ch=lane_e&7; const u32x4 v=*(const u32x4*)(stg+row*64+ch*8); ATTN_STORE16(Ow+(long)row*DMO+ch*8,v);} }
  asm volatile("s_waitcnt lgkmcnt(0)\n\ts_barrier":::"memory");
  #undef DMA_K
  #undef DMA_V
  #undef CMASK
  #undef START
  #undef RESC
  #undef ROT
}
constexpr int ATTN_LDS_BYTES=LDS_BYTES;
struct AttnTensors { const bf16* Q; const bf16* K; const bf16* V; bf16* O; const unsigned long long* MK; };
struct AttnUnit { int bh; int qb; };
struct StaticOrder {
  int vcu;
  __device__ __forceinline__ explicit StaticOrder(int grid,int block):vcu((block%8)*(grid/8)+block/8){}
  __device__ __forceinline__ bool next(int i,AttnUnit&u)const{ if(i>=2)return false; const int s=vcu&7; u.bh=vcu>>3; u.qb=(i==0)?15-s:s; return true; }
  __device__ __forceinline__ void a_ready(const AttnUnit&)const{}
  __device__ __forceinline__ void done(const AttnUnit&)const{}
};
template<class Sched,int THRL=8> __device__ __forceinline__ void attn_phase(char*lds,const AttnTensors&T,const Sched&S){
  AttnUnit u;
  for(int i=0;S.next(i,u);++i){ S.a_ready(u); attn_unit<THRL>(u.bh/NHEAD,u.bh%NHEAD,u.qb,T.Q,T.K,T.V,T.O,T.MK,lds); S.done(u); }
}
#undef SBAR
#undef WAIT_BAR
}
#define GAS __attribute__((address_space(1)))
#define LAS __attribute__((address_space(3)))
typedef unsigned short bf16;
typedef unsigned v4u __attribute__((ext_vector_type(4)));
typedef float f32x4 __attribute__((ext_vector_type(4)));
typedef short bf16x8 __attribute__((ext_vector_type(8)));
typedef GAS unsigned gu32;
typedef GAS unsigned long long gu64;
#define RLX_AGENT __ATOMIC_RELAXED, __HIP_MEMORY_SCOPE_AGENT
#define LDS_WAIT() asm volatile("s_waitcnt lgkmcnt(0)" ::: "memory")
#define VM_WAIT() asm volatile("s_waitcnt vmcnt(0)" ::: "memory")
__device__ __forceinline__ unsigned long long rt() { return __builtin_amdgcn_s_memrealtime(); }
__device__ __forceinline__ unsigned f2bf(float f) { unsigned u = __builtin_bit_cast(unsigned, f); return (u + 0x7fffu + ((u >> 16) & 1u)) >> 16; }
__device__ __forceinline__ unsigned pk2(float lo, float hi) { return f2bf(lo) | (f2bf(hi) << 16); }

#define XB_TMO      128
#define XB_XCNT(j)  (256  + 64 * (j))
#define XB_XSUB(j)  (1280 + 64 * (j))
#define XB_XGEN(j)  (2304 + 64 * (j))
#define XB_TOP      3328
#define XB_TOPGEN   3392
#define XCD_BAR_WORDS 3456
#define XB_SPIN_CAP (1u << 18)

__device__ __forceinline__ unsigned xb_ld(unsigned* p)              { return __hip_atomic_load(p, __ATOMIC_RELAXED, __HIP_MEMORY_SCOPE_AGENT); }
__device__ __forceinline__ unsigned xb_add(unsigned* p, unsigned v) { return __hip_atomic_fetch_add(p, v, __ATOMIC_RELAXED, __HIP_MEMORY_SCOPE_AGENT); }
__device__ __forceinline__ unsigned xb_xcc_id() { return (unsigned)__builtin_amdgcn_s_getreg((3 << 11) | 20) & 0xFu; }
#define XB_SPIN(cond, bar) do { unsigned _sp = 0; while (cond) { __builtin_amdgcn_s_sleep(1); \
    if ((++_sp & 255u) == 0u) { if (xb_ld(&(bar)[XB_TMO])) break; if (_sp > XB_SPIN_CAP) { atomicAdd(&(bar)[XB_TMO], 1u); break; } } } } while (0)

struct XcdBarrier {
    unsigned* bar; unsigned x;
    volatile LAS unsigned* st;
};

__device__ __forceinline__ XcdBarrier xcd_barrier_post(unsigned* bar, volatile LAS unsigned* st) {
    XcdBarrier b; b.bar = bar; b.x = xb_xcc_id(); b.st = st;
    if (threadIdx.x == 0) (void)xb_add(&bar[XB_XCNT(b.x)], 1u);
    return b;
}
__device__ __forceinline__ void xcd_barrier_complete(unsigned* bar, unsigned x, unsigned& nloc, unsigned& nx) {
    const unsigned G = gridDim.x * gridDim.y * gridDim.z;
    unsigned sum, cnt, mine, sp = 0u;
    for (;;) {
        sum = 0u; cnt = 0u; mine = 0u;
#pragma unroll
        for (unsigned j = 0; j < 16; ++j) { const unsigned c = xb_ld(&bar[XB_XCNT(j)]); sum += c; cnt += (c > 0u) ? 1u : 0u; mine = (j == x) ? c : mine; }
        if (sum == G) break;
        __builtin_amdgcn_s_sleep(1);
        if ((++sp & 255u) == 0u) { if (xb_ld(&bar[XB_TMO])) break; if (sp > XB_SPIN_CAP) { atomicAdd(&bar[XB_TMO], 1u); break; } }
    }
    nloc = mine > 0u ? mine : 1u; nx = cnt > 0u ? cnt : 1u;
}

__device__ __forceinline__ void xcd_barrier(const XcdBarrier& b) {
    asm volatile("s_waitcnt vmcnt(0)" ::: "memory");
    __syncthreads();
    if (threadIdx.x == 0) {
        unsigned* bar = b.bar;
        __builtin_amdgcn_s_waitcnt(0);
        unsigned nloc = b.st[0], nx = b.st[1];
        if (nloc == 0u) { xcd_barrier_complete(bar, b.x, nloc, nx); b.st[0] = nloc; b.st[1] = nx; }
        const unsigned old = xb_add(&bar[XB_XSUB(b.x)], 1u);
        const unsigned gen = old / nloc;
        if (old + 1u == (gen + 1u) * nloc) {
            __builtin_amdgcn_fence(__ATOMIC_RELEASE, "agent");
            asm volatile("s_waitcnt vmcnt(0)" ::: "memory");
            const unsigned og = xb_add(&bar[XB_TOP], 1u);
            const unsigned tg = og / nx;
            if (og + 1u == (tg + 1u) * nx) xb_add(&bar[XB_TOPGEN], 1u);
            else XB_SPIN(xb_ld(&bar[XB_TOPGEN]) == tg, bar);
            __builtin_amdgcn_fence(__ATOMIC_ACQUIRE, "agent");
            xb_add(&bar[XB_XGEN(b.x)], 1u);
            asm volatile("s_waitcnt vmcnt(0)" ::: "memory");
        } else {
            XB_SPIN(xb_ld(&bar[XB_XGEN(b.x)]) == gen, bar);
            __builtin_amdgcn_fence(__ATOMIC_ACQUIRE, "agent");
            asm volatile("s_waitcnt vmcnt(0)" ::: "memory");
        }
    }
    __syncthreads();
}
constexpr int NWAVES = 8;
constexpr int BATCH = 4, SEQ = 4096, T = BATCH * SEQ, D = 1024, DEPTH = 2;
constexpr int NIN = 2888, NP = 3072;
constexpr int PC_Q = 0, PC_K = 512, PC_V = 1024, PC_QI = 1536, PC_POOL = 2048, PC_CA = 2304, PC_CG = 2560, PC_KI = 2816, PC_WI = 2880;
constexpr int SC_KI = 2048, SC_WI = 2112, SC_POOL = 2120, SC_CONV = 2376;
constexpr float RMS_EPS = 1e-6f;
constexpr float C2 = 0.125f * 1.4426950408889634f;

constexpr size_t MiB = 1u << 20;
constexpr size_t WS_CTL = 0, CTL_ZERO_BYTES = 1 * MiB;
constexpr size_t WS_WIN = 2 * MiB;
constexpr size_t WS_WOUT = 14 * MiB;
constexpr size_t WS_WGU = 18 * MiB;
constexpr size_t WS_WD = 82 * MiB;
constexpr size_t WS_SMALL = 114 * MiB;
constexpr size_t WS_POOLWT = WS_SMALL, WS_PWWT = WS_SMALL + 64 * 1024;
constexpr size_t WS_ROUTE_E = WS_SMALL + 512 * 1024;
constexpr size_t WS_ROUTE_W = WS_SMALL + 768 * 1024;
constexpr size_t WS_KIF = 116 * MiB;
constexpr size_t WS_HB = 118 * MiB;
constexpr size_t WS_PB = 150 * MiB;
constexpr size_t WS_MASK = 246 * MiB;
constexpr size_t WS_BLIST = 254 * MiB;
constexpr size_t WS_BW = 256 * MiB;
constexpr size_t WS_END = 260 * MiB;

constexpr int CW_TMO = 0, CW_CODE = 1;
constexpr int CW_BAR = 4096;
constexpr int CW_BCNT = 131072;

constexpr int RING_OFF = 0, RING_BYTES = 131072;
constexpr int LDSCTL_OFF = RING_BYTES, MISC_OFF = LDSCTL_OFF + 320;
constexpr int LDS_BYTES = 163840;

struct Args { const float* in[21]; float* out; unsigned char* ws; int ph_lo, ph_hi, li, pad; };
struct Frame {
    LAS unsigned char* lds;
    volatile LAS unsigned* MISC;
    gu32* ctl;
    int tid, lane, wave;
    int vcu, G;
    float* out;
    unsigned char* ws;
};
enum { I_X = 0, I_N1G, I_WIN, I_POOLW, I_POOLS, I_DWW, I_DWB, I_LNG, I_LNB, I_PWW, I_PWB, I_WOUT, I_N2G, I_RGW, I_RGB, I_REW, I_REB, I_WG, I_WU, I_WDN, I_FG };

__device__ __forceinline__ float wave_sum(float v, int lane) {
#pragma unroll
    for (int o = 1; o < 64; o <<= 1) v += __int_as_float(__builtin_amdgcn_ds_bpermute((lane ^ o) << 2, __float_as_int(v)));
    return v;
}
__device__ __forceinline__ float bf2f(unsigned short b) { return __uint_as_float((unsigned)b << 16); }

__device__ __forceinline__ void p0_transpose_item(const float* W, int ldw, int c0, int Kd, bf16* WT, int row_off, int row_mul, LAS float* scr, int kb, int nb, int lane) {
    const int k0 = 64 * kb, n0 = 32 * nb;
#pragma unroll 8
    for (int i = 0; i < 32; ++i) { const int kk = 2 * i + (lane >> 5); scr[kk * 33 + (lane & 31)] = W[(size_t)(k0 + kk) * ldw + c0 + n0 + (lane & 31)]; }
    LDS_WAIT(); asm volatile("" ::: "memory");
    const int c = lane & 7;
#pragma unroll
    for (int j = 0; j < 4; ++j) { const int n = (lane >> 3) + 8 * j; const LAS float* s = scr + (8 * c) * 33 + n;
        v4u o; o.x = pk2(s[0 * 33], s[1 * 33]); o.y = pk2(s[2 * 33], s[3 * 33]); o.z = pk2(s[4 * 33], s[5 * 33]); o.w = pk2(s[6 * 33], s[7 * 33]);
        *(GAS v4u*)(WT + (size_t)(row_off + (n0 + n) * row_mul) * Kd + k0 + 8 * c) = o; }
    LDS_WAIT(); asm volatile("" ::: "memory");
}
template <int NR> __device__ __forceinline__ void rms_rows_to_bf16(const float* xrow, size_t rs, const float* g, bf16* orow, int lane) {
    f32x4 v[NR][4]; float s[NR];
#pragma unroll
    for (int r = 0; r < NR; ++r) { const GAS f32x4* xr = (const GAS f32x4*)(xrow + r * rs) + lane;
#pragma unroll
        for (int j = 0; j < 4; ++j) v[r][j] = xr[64 * j]; }
    f32x4 gv[4];
#pragma unroll
    for (int j = 0; j < 4; ++j) gv[j] = ((const GAS f32x4*)g + lane)[64 * j];
#pragma unroll
    for (int r = 0; r < NR; ++r) { s[r] = 0.f;
#pragma unroll
        for (int j = 0; j < 4; ++j) s[r] += (v[r][j].x * v[r][j].x + v[r][j].y * v[r][j].y) + (v[r][j].z * v[r][j].z + v[r][j].w * v[r][j].w); }
#pragma unroll
    for (int r = 0; r < NR; ++r) { const float rstd = 1.f / sqrtf(wave_sum(s[r], lane) * (1.f / D) + RMS_EPS);
        GAS unsigned long long* o8 = (GAS unsigned long long*)(orow + r * rs) + lane;
#pragma unroll
        for (int j = 0; j < 4; ++j) o8[64 * j] = (unsigned long long)pk2(v[r][j].x * rstd * gv[j].x, v[r][j].y * rstd * gv[j].y) | ((unsigned long long)pk2(v[r][j].z * rstd * gv[j].z, v[r][j].w * rstd * gv[j].w) << 32); }
}
__device__ __forceinline__ void rms_row_to_bf16(const float* xrow, const float* g, bf16* orow, int lane) {
    const GAS f32x4* xr = (const GAS f32x4*)xrow + lane; const GAS f32x4* gr = (const GAS f32x4*)g + lane;
    f32x4 v[4]; float s = 0.f;
#pragma unroll
    for (int j = 0; j < 4; ++j) { v[j] = xr[64 * j]; s += (v[j].x * v[j].x + v[j].y * v[j].y) + (v[j].z * v[j].z + v[j].w * v[j].w); }
    const float rstd = 1.f / sqrtf(wave_sum(s, lane) * (1.f / D) + RMS_EPS);
    GAS unsigned long long* o8 = (GAS unsigned long long*)orow + lane;
#pragma unroll
    for (int j = 0; j < 4; ++j) { const f32x4 gv = gr[64 * j];
        o8[64 * j] = (unsigned long long)pk2(v[j].x * rstd * gv.x, v[j].y * rstd * gv.y) | ((unsigned long long)pk2(v[j].z * rstd * gv.z, v[j].w * rstd * gv.w) << 32); }
}
__device__ __forceinline__ void rms_row_f32(float* xrow, const float* g, int lane) {
    GAS f32x4* xr = (GAS f32x4*)xrow + lane; const GAS f32x4* gr = (const GAS f32x4*)g + lane;
    f32x4 v[4]; float s = 0.f;
#pragma unroll
    for (int j = 0; j < 4; ++j) { v[j] = xr[64 * j]; s += (v[j].x * v[j].x + v[j].y * v[j].y) + (v[j].z * v[j].z + v[j].w * v[j].w); }
    const float rstd = 1.f / sqrtf(wave_sum(s, lane) * (1.f / D) + RMS_EPS);
#pragma unroll
    for (int j = 0; j < 4; ++j) { const f32x4 gv = gr[64 * j]; xr[64 * j] = (f32x4){v[j].x * rstd * gv.x, v[j].y * rstd * gv.y, v[j].z * rstd * gv.z, v[j].w * rstd * gv.w}; }
}

__device__ __forceinline__ void p0_prologue(Frame& F, const Args& A) {
    LAS float* scr = (LAS float*)(F.lds + RING_OFF + F.wave * 16384);
    const int gw = F.vcu * NWAVES + F.wave, NGW = F.G * NWAVES, lane = F.lane;
    bf16* Win_t = (bf16*)(F.ws + WS_WIN); bf16* Wout_t = (bf16*)(F.ws + WS_WOUT); bf16* Wgu_t = (bf16*)(F.ws + WS_WGU); bf16* Wd_t = (bf16*)(F.ws + WS_WD);
    bf16* pool_wt = (bf16*)(F.ws + WS_POOLWT); bf16* pw_wt = (bf16*)(F.ws + WS_PWWT);
    constexpr int I_IN0 = 16 * 64, I_IN1 = 16 * 8, I_IN2 = 16 * 16, I_IN3 = 16 * 2;
    constexpr int I_OUT = 16 * 32, I_G = 16 * 256, I_U = 16 * 256, I_DN = 16 * 256, I_PL = 4 * 2, I_PW = 4 * 8;
    constexpr int PER_L = I_IN0 + I_IN1 + I_IN2 + I_IN3 + I_OUT + I_G + I_U + I_DN + I_PL + I_PW;
    for (int it = gw; it < DEPTH * PER_L; it += NGW) {
        const int l = it / PER_L; int r = it % PER_L;
        const float* w_in = A.in[I_WIN] + (size_t)l * D * NIN; bf16* wt = Win_t + (size_t)l * NP * D;
        if (r < I_IN0) { p0_transpose_item(w_in, NIN, 0, D, wt, 0, 1, scr, r / 64, r % 64, lane); continue; } r -= I_IN0;
        if (r < I_IN1) { p0_transpose_item(w_in, NIN, SC_POOL, D, wt, PC_POOL, 1, scr, r / 8, r % 8, lane); continue; } r -= I_IN1;
        if (r < I_IN2) { p0_transpose_item(w_in, NIN, SC_CONV, D, wt, PC_CA, 1, scr, r / 16, r % 16, lane); continue; } r -= I_IN2;
        if (r < I_IN3) { p0_transpose_item(w_in, NIN, SC_KI, D, wt, PC_KI, 1, scr, r / 2, r % 2, lane); continue; } r -= I_IN3;
        if (r < I_OUT) { p0_transpose_item(A.in[I_WOUT] + (size_t)l * D * D, D, 0, D, Wout_t + (size_t)l * D * D, 0, 1, scr, r / 32, r % 32, lane); continue; } r -= I_OUT;
        if (r < I_G) { const int e = r / 256, q = r % 256; p0_transpose_item(A.in[I_WG] + ((size_t)l * 16 + e) * 1024 * 512, 512, 0, 1024, Wgu_t + ((size_t)l * 16 + e) * 1024 * 1024, 0, 2, scr, q / 16, q % 16, lane); continue; } r -= I_G;
        if (r < I_U) { const int e = r / 256, q = r % 256; p0_transpose_item(A.in[I_WU] + ((size_t)l * 16 + e) * 1024 * 512, 512, 0, 1024, Wgu_t + ((size_t)l * 16 + e) * 1024 * 1024, 1, 2, scr, q / 16, q % 16, lane); continue; } r -= I_U;
        if (r < I_DN) { const int e = r / 256, q = r % 256; p0_transpose_item(A.in[I_WDN] + ((size_t)l * 16 + e) * 512 * 1024, 1024, 0, 512, Wd_t + ((size_t)l * 16 + e) * 1024 * 512, 0, 1, scr, q / 32, q % 32, lane); continue; } r -= I_DN;
        if (r < I_PL) { const int g = r / 2; p0_transpose_item(A.in[I_POOLW] + ((size_t)l * 4 + g) * 64 * 64, 64, 0, 64, pool_wt + ((size_t)l * 4 + g) * 64 * 64, 0, 1, scr, 0, r % 2, lane); continue; } r -= I_PL;
        p0_transpose_item(A.in[I_PWW] + (size_t)l * 256 * 256, 256, 0, 256, pw_wt + (size_t)l * 256 * 256, 0, 1, scr, r / 8, r % 8, lane);
    }
    for (int it = gw; it < DEPTH * 192; it += NGW) {
        const int l = it / 192, rr = it % 192;
        bf16* dst = Win_t + ((size_t)l * NP + PC_WI + rr) * D;
        const float* w_in = A.in[I_WIN] + (size_t)l * D * NIN;
#pragma unroll
        for (int j = 0; j < 16; ++j) { const int k = lane + 64 * j; dst[k] = (rr < 8) ? (bf16)f2bf(w_in[(size_t)k * NIN + SC_WI + rr]) : (bf16)0; }
    }
    bf16* HB = (bf16*)(F.ws + WS_HB);
    for (int m = gw; m < T; m += 4 * NGW) rms_rows_to_bf16<4>(A.in[I_X] + (size_t)m * D, (size_t)NGW * D, A.in[I_N1G], HB + (size_t)m * D, lane);
}

struct EpiResF32 {
    static constexpr bool PERM = false, AFTER_DRAIN = false;
    const float* base; float* out; int ldc;
    __device__ __forceinline__ void operator()(const pg8::f32x4 (&acc)[2][2][4][2], const pg8::Unit& u, int wr, int wc, int fr, int fq) const {
        const int col0 = u.pn * pg8::BM + wc * 32 + 4 * fq;
#pragma unroll
        for (int ai = 0; ai < 2; ++ai)
#pragma unroll
            for (int m = 0; m < 4; ++m) { const size_t off = (size_t)(u.pm * pg8::BM + ai * pg8::HALF + wr * 64 + m * 16 + fr) * ldc + col0;
#pragma unroll
                for (int bj = 0; bj < 2; ++bj)
#pragma unroll
                    for (int n = 0; n < 2; ++n) { const pg8::f32x4 bs = *(const pg8::f32x4*)(base + off + bj * pg8::HALF + n * 16); *(pg8::f32x4*)(out + off + bj * pg8::HALF + n * 16) = bs + acc[ai][bj][m][n]; } }
    }
};


constexpr int MOE_TAB_OFF = LDSCTL_OFF + 1024;
__device__ __forceinline__ int pair_lo(int p) { return p < 3 ? 0 : (p < 5 ? 1 : 2); }
__device__ __forceinline__ int pair_hi(int p) { return p < 3 ? p + 1 : (p < 5 ? p - 1 : 3); }

__device__ __forceinline__ void r2_router(Frame& F, const Args& A, int l) {
    LAS float* Wt = (LAS float*)(F.lds + RING_OFF);
    const float* rg = A.in[I_RGW] + (size_t)l * D * 4; const float* re = A.in[I_REW] + (size_t)l * D * 16;
    for (int e = F.tid; e < D * 4; e += NWAVES * 64) Wt[(e & 3) * 1024 + (e >> 2)] = rg[e];
    for (int e = F.tid; e < D * 16; e += NWAVES * 64) Wt[(4 + (e & 15)) * 1024 + (e >> 4)] = re[e];
    __syncthreads();
    const int gw = F.vcu * NWAVES + F.wave, NGW = F.G * NWAVES, lane = F.lane;
    bf16* HB = (bf16*)(F.ws + WS_HB); int* blist = (int*)(F.ws + WS_BLIST); float* bw = (float*)(F.ws + WS_BW);
    const float* g2 = A.in[I_N2G] + (size_t)l * D; const float* rgb = A.in[I_RGB] + l * 4; const float* reb = A.in[I_REB] + l * 16;
    for (int m = gw; m < T; m += NGW) {
        const GAS f32x4* xr = (const GAS f32x4*)(F.out + (size_t)m * D) + lane; const GAS f32x4* gr = (const GAS f32x4*)g2 + lane;
        f32x4 v[4]; float s = 0.f;
#pragma unroll
        for (int j = 0; j < 4; ++j) { v[j] = xr[64 * j]; s += (v[j].x * v[j].x + v[j].y * v[j].y) + (v[j].z * v[j].z + v[j].w * v[j].w); }
        const float rstd = 1.f / sqrtf(wave_sum(s, lane) * (1.f / D) + RMS_EPS);
        GAS unsigned long long* o8 = (GAS unsigned long long*)(HB + (size_t)m * D) + lane;
#pragma unroll
        for (int j = 0; j < 4; ++j) { const f32x4 gv = gr[64 * j]; v[j] = (f32x4){v[j].x * rstd * gv.x, v[j].y * rstd * gv.y, v[j].z * rstd * gv.z, v[j].w * rstd * gv.w};
            o8[64 * j] = (unsigned long long)pk2(v[j].x, v[j].y) | ((unsigned long long)pk2(v[j].z, v[j].w) << 32); }
        float lg[20];
#pragma unroll
        for (int q = 0; q < 20; ++q) { float a = 0.f;
#pragma unroll
            for (int j = 0; j < 4; ++j) { const f32x4 w = *(const LAS f32x4*)(Wt + q * 1024 + 4 * lane + 256 * j); a += (v[j].x * w.x + v[j].y * w.y) + (v[j].z * w.z + v[j].w * w.w); }
            lg[q] = wave_sum(a, lane); __builtin_amdgcn_sched_barrier(0); }
        float gl[4];
#pragma unroll
        for (int j = 0; j < 4; ++j) gl[j] = lg[j] + rgb[j];
        int gs = 0; float gm = gl[0];
#pragma unroll
        for (int j = 1; j < 4; ++j) if (gl[j] > gm) { gm = gl[j]; gs = j; }
        float gsum = 0.f;
#pragma unroll
        for (int j = 0; j < 4; ++j) gsum += expf(gl[j] - gm);
        const float pg = 1.0f / gsum;
        float el[4];
#pragma unroll
        for (int j = 0; j < 4; ++j) { const float e0 = lg[4 + j] + reb[j], e1 = lg[8 + j] + reb[4 + j], e2 = lg[12 + j] + reb[8 + j], e3 = lg[16 + j] + reb[12 + j]; el[j] = gs == 0 ? e0 : (gs == 1 ? e1 : (gs == 2 ? e2 : e3)); }
        float em = fmaxf(fmaxf(el[0], el[1]), fmaxf(el[2], el[3]));
        float ep[4], esum = 0.f;
#pragma unroll
        for (int j = 0; j < 4; ++j) { ep[j] = expf(el[j] - em); esum += ep[j]; }
#pragma unroll
        for (int j = 0; j < 4; ++j) ep[j] /= esum;
        int i1 = 0; float p1 = ep[0];
#pragma unroll
        for (int j = 1; j < 4; ++j) if (ep[j] > p1) { p1 = ep[j]; i1 = j; }
        int i2 = -1; float p2 = -1.f;
#pragma unroll
        for (int j = 0; j < 4; ++j) if (j != i1 && ep[j] > p2) { p2 = ep[j]; i2 = j; }
        const float den = p1 + p2; const float w1 = pg * (p1 / den), w2 = pg * (p2 / den);
        const int lo = i1 < i2 ? i1 : i2, hi = i1 < i2 ? i2 : i1;
        const int pidx = lo == 0 ? hi - 1 : (lo == 1 ? hi + 1 : 5);
        const int bk = gs * 6 + pidx;
        if (lane == 0) {
            const unsigned pos = __hip_atomic_fetch_add((unsigned*)(F.ctl + CW_BCNT + (l * 24 + bk) * 64), 1u, __ATOMIC_RELAXED, __HIP_MEMORY_SCOPE_AGENT);
            blist[(size_t)bk * T + pos] = m;
            bw[((size_t)bk * T + pos) * 2] = i1 < i2 ? w1 : w2; bw[((size_t)bk * T + pos) * 2 + 1] = i1 < i2 ? w2 : w1;
        }
    }
}
__device__ __forceinline__ void moe_build_table(Frame& F, int l) {
    LAS int* tab = (LAS int*)(F.lds + MOE_TAB_OFF);
    if (F.tid == 0) {
        int nt = 0;
        for (int b = 0; b < 24; ++b) {
            const int c = (int)__hip_atomic_load((unsigned*)(F.ctl + CW_BCNT + (l * 24 + b) * 64), __ATOMIC_RELAXED, __HIP_MEMORY_SCOPE_AGENT);
            tab[128 + b] = c;
            const int ntb = (c + 255) >> 8;
            for (int i = 0; i < ntb && nt < 96; ++i) tab[8 + nt++] = (b << 16) | i;
        }
        tab[0] = nt;
    }
    __syncthreads();
}
struct MoeSched {
    const LAS int* tab; int ntiles, ntx, npn, xcd, j, mode;
    const int* blist; const char* Abase; const char* Bbase;
    __device__ __forceinline__ bool next(int i, pg8::Unit2& u) const {
        const int m = i * 32 + j, tl = m / npn, tg = xcd * ntx + tl;
        if (tl >= ntx || tg >= ntiles) return false;
        const int e = __builtin_amdgcn_readfirstlane(tab[8 + tg]);
        u.pm = tg; u.pn = m % npn; u.bk = e >> 16; u.r0 = (e & 0xffff) * 256; u.cnt = __builtin_amdgcn_readfirstlane(tab[128 + (e >> 16)]);
        return true;
    }
    __device__ __forceinline__ int expert(const pg8::Unit2& u, int which) const { const int g = u.bk / 6, p = u.bk % 6; return g * 4 + (which ? pair_hi(p) : pair_lo(p)); }
    __device__ __forceinline__ const char* a_base(const pg8::Unit2& u) const { return mode == 1 ? Abase : Abase + (size_t)u.pm * 256 * 1024 * 2; }
    __device__ __forceinline__ const char* b_base(const pg8::Unit2& u) const {
        if (mode == 1) return Bbase + ((size_t)expert(u, u.pn >> 2) * 1024 + (size_t)(u.pn & 3) * 256) * 1024 * 2;
        return Bbase + ((size_t)expert(u, 0) * 1024 + (size_t)u.pn * 256) * 512 * 2;
    }
    __device__ __forceinline__ long b_jump(const pg8::Unit2& u) const { return mode == 1 ? 0l : (long)(expert(u, 1) - expert(u, 0)) * 1024 * 512 * 2 - 8 * 128; }
    __device__ __forceinline__ int a_row(const pg8::Unit2& u, int r) const { int q = u.r0 + r; q = q < u.cnt ? q : u.cnt - 1; return blist[(size_t)u.bk * T + q]; }
};
__device__ __forceinline__ float silu_f(float a) { return a * __builtin_amdgcn_rcpf(1.0f + __builtin_amdgcn_exp2f(-1.4426950408889634f * a)); }
struct EpiSwiGLU {
    static constexpr bool PERM = true;
    bf16* HID; const float* bw;
    __device__ __forceinline__ void operator()(const pg8::f32x4 (&acc)[2][2][4][2], const pg8::Unit2& u, int wr, int wc, int fr, int fq) const {
        const int half = u.pn >> 2, hc0 = half * 512 + (u.pn & 3) * 128 + wc * 16 + 4 * fq;
#pragma unroll
        for (int ai = 0; ai < 2; ++ai)
#pragma unroll
            for (int m = 0; m < 4; ++m) { const int r = ai * 128 + wr * 64 + m * 16 + fr; int q = u.r0 + r; q = q < u.cnt ? q : u.cnt - 1;
                const float w = bw[((size_t)u.bk * T + q) * 2 + half];
                bf16* rowp = HID + (size_t)(u.pm * 256 + r) * 1024 + hc0;
#pragma unroll
                for (int bj = 0; bj < 2; ++bj) { const pg8::f32x4 v0 = acc[ai][bj][m][0], v1 = acc[ai][bj][m][1];
                    const float h0 = silu_f(v0[0]) * v0[1] * w, h1 = silu_f(v0[2]) * v0[3] * w, h2 = silu_f(v1[0]) * v1[1] * w, h3 = silu_f(v1[2]) * v1[3] * w;
                    *(uint2*)(rowp + bj * 64) = make_uint2(pg8::cvt_pk_bf16(h0, h1), pg8::cvt_pk_bf16(h2, h3)); } }
    }
};
struct EpiScatter {
    static constexpr bool PERM = false;
    float* out; const int* blist;
    __device__ __forceinline__ void operator()(const pg8::f32x4 (&acc)[2][2][4][2], const pg8::Unit2& u, int wr, int wc, int fr, int fq) const {
        const int col0 = u.pn * 256 + wc * 32 + 4 * fq;
#pragma unroll
        for (int ai = 0; ai < 2; ++ai)
#pragma unroll
            for (int m = 0; m < 4; ++m) { const int r = ai * 128 + wr * 64 + m * 16 + fr; const int q = u.r0 + r;
                if (q < u.cnt) { const int tok = blist[(size_t)u.bk * T + q]; float* rowp = out + (size_t)tok * D + col0;
#pragma unroll
                    for (int bj = 0; bj < 2; ++bj)
#pragma unroll
                        for (int n = 0; n < 2; ++n) { pg8::f32x4* p = (pg8::f32x4*)(rowp + bj * 128 + n * 16); *p = *p + acc[ai][bj][m][n]; } } }
    }
};

#ifndef MK_PROBE
#define MK_PROBE 0
#endif
#define PROBE_T0(id) unsigned long long pt0_##id = 0; if (MK_PROBE == (id)) pt0_##id = __builtin_amdgcn_s_memrealtime()
#define PROBE_T1(id) do { if (MK_PROBE == (id)) { const unsigned long long pt1_ = __builtin_amdgcn_s_memrealtime(); if (blockIdx.x == 4 && threadIdx.x == 0) { gu32* w_ = F.ctl + 3; *(volatile GAS unsigned*)w_ = *(volatile GAS unsigned*)w_ + (unsigned)(pt1_ - pt0_##id); } } } while (0)
typedef float f32x16 __attribute__((ext_vector_type(16)));
typedef unsigned u32x2 __attribute__((ext_vector_type(2)));
constexpr int SC_OFF = RING_OFF;
constexpr int HIST_OFF = LDSCTL_OFF + 2560;
constexpr int MM_OFF = LDSCTL_OFF + 1792;
constexpr int QST_OFF = HIST_OFF + 8192;
constexpr int CAND_OFF = HIST_OFF;
__device__ __forceinline__ int bperm_i(int v, int srclane) { return __builtin_amdgcn_ds_bpermute(srclane << 2, v); }
__device__ __forceinline__ float shxr_f(float v, int lane, int o) { return __int_as_float(bperm_i(__float_as_int(v), lane ^ o)); }
__device__ __forceinline__ float bcast_f(float v, int src) { return __int_as_float(__builtin_amdgcn_readlane(__float_as_int(v), src)); }
__device__ __forceinline__ int bcast_i(int v, int src) { return __builtin_amdgcn_readlane(v, src); }
typedef float f32x2c __attribute__((ext_vector_type(2)));
__device__ __forceinline__ unsigned wave_sum_u(unsigned x) {
    x += (unsigned)__builtin_amdgcn_update_dpp(0, (int)x, 0xB1, 0xf, 0xf, false);
    x += (unsigned)__builtin_amdgcn_update_dpp(0, (int)x, 0x4E, 0xf, 0xf, false);
    x += (unsigned)__builtin_amdgcn_update_dpp(0, (int)x, 0x141, 0xf, 0xf, false);
    x += (unsigned)__builtin_amdgcn_update_dpp(0, (int)x, 0x140, 0xf, 0xf, false);
    return (unsigned)(__builtin_amdgcn_readlane((int)x, 0) + __builtin_amdgcn_readlane((int)x, 16) + __builtin_amdgcn_readlane((int)x, 32) + __builtin_amdgcn_readlane((int)x, 48));
}
__device__ __forceinline__ unsigned wave_excl_scan_u(unsigned x, int lane) {
    unsigned s = x;
#pragma unroll
    for (int o = 1; o < 64; o <<= 1) { const unsigned t = (unsigned)bperm_i((int)s, (lane - o) & 63); if (lane >= o) s += t; }
    return s - x;
}
struct TkOps { bf16x8 af[2][4]; bf16x8 wv[2][2]; };
struct TkStage { v4u q; v4u w; };
__device__ __forceinline__ void topk_stage_load(TkStage& s, const GAS bf16* PBg, size_t tb, int t0, int tid) {
    s.q = *(const GAS v4u*)(PBg + (tb + t0 + (tid >> 6)) * NP + PC_QI + (tid & 63) * 8);
    s.w = (v4u){0u, 0u, 0u, 0u};
    if (tid < 8) s.w = *(const GAS v4u*)(PBg + (tb + t0 + tid) * NP + PC_WI);
}
__device__ __forceinline__ void topk_stage_store(const TkStage& s, LAS unsigned char* qst, int tid) {
    *(LAS v4u*)(qst + (tid >> 6) * 1056 + (tid & 63) * 16) = s.q;
    if (tid < 8) *(LAS v4u*)(qst + tid * 1056 + 1024) = s.w;
}
__device__ __forceinline__ void topk_ops_load(TkOps& o, const LAS unsigned char* qst, int lane) {
    const int r = lane & 31, hb = lane >> 5;
    const int a_ = r >> 3, hi_ = (r >> 2) & 1, i_ = r & 3;
    const int ql = 2 * (a_ >> 1) + hi_, head = 4 * (a_ & 1) + i_;
#pragma unroll
    for (int rt = 0; rt < 2; ++rt)
#pragma unroll
        for (int ks = 0; ks < 4; ++ks) o.af[rt][ks] = *(const LAS bf16x8*)(qst + (rt * 4 + ql) * 1056 + head * 128 + hb * 64 + ks * 16);
#pragma unroll
    for (int rt = 0; rt < 2; ++rt)
#pragma unroll
        for (int s = 0; s < 2; ++s) o.wv[rt][s] = *(const LAS bf16x8*)(qst + (rt * 4 + 2 * s + hb) * 1056 + 1024);
}
__device__ __forceinline__ void topk_unit(Frame& F, int b, int t0, int nt0, int dbg) {
    const GAS bf16* PBg = (const GAS bf16*)(F.ws + WS_PB);
    GAS unsigned long long* MASK = (GAS unsigned long long*)(F.ws + WS_MASK);
    int lane_ = F.lane; asm volatile("" : "+v"(lane_));
    const int lane = lane_, wave = F.wave;
    const int c = t0 >> 6, n = (c + 1) * 64;
    const size_t tb = (size_t)b * SEQ;
    LAS unsigned char* qst = F.lds + QST_OFF;
    if (n <= 256) {
        const unsigned long long w = (lane <= c) ? ~0ull : 0ull;
        MASK[(tb + t0 + wave) * 64 + lane] = w;
        if (nt0 >= 0) { TkStage st; topk_stage_load(st, PBg, tb, nt0, F.tid); topk_stage_store(st, qst, F.tid); LDS_WAIT(); __syncthreads(); }
        return;
    }
    LAS float* sc = (LAS float*)(F.lds + SC_OFF);
    LAS float* mm = (LAS float*)(F.lds + MM_OFF);
    PROBE_T0(1); PROBE_T0(3);
    {
        TkOps ops; topk_ops_load(ops, qst, lane);
        const int r = lane & 31, hb = lane >> 5;
        float wq[2][2][8];
#pragma unroll
        for (int rt = 0; rt < 2; ++rt)
#pragma unroll
            for (int s = 0; s < 2; ++s)
#pragma unroll
                for (int h = 0; h < 8; ++h) wq[rt][s][h] = bf2f((unsigned short)ops.wv[rt][s][h]);
        float qmn[4], qmx[4];
#pragma unroll
        for (int s = 0; s < 4; ++s) { qmn[s] = INFINITY; qmx[s] = -INFINITY; }
        const int nkt = n >> 5;
        const GAS bf16* kbase = (const GAS bf16*)(F.ws + WS_KIF) + (tb >> 5) * 2048 + lane * 8;
#define TK_LOAD(dst, kt) do { int kc_ = (kt); kc_ = kc_ < nkt ? kc_ : nkt - 1; const GAS bf16* kp_ = kbase + (size_t)kc_ * 2048; \
            asm volatile("global_load_dwordx4 %0, %4, off\n\tglobal_load_dwordx4 %1, %4, off offset:1024\n\tglobal_load_dwordx4 %2, %4, off offset:2048\n\tglobal_load_dwordx4 %3, %4, off offset:3072" \
                : "=&v"(dst[0]), "=&v"(dst[1]), "=&v"(dst[2]), "=&v"(dst[3]) : "v"(kp_) : "memory"); } while (0)
#define TK_WAIT(dst, N) asm volatile("s_waitcnt vmcnt(" #N ")" : "+v"(dst[0]), "+v"(dst[1]), "+v"(dst[2]), "+v"(dst[3]) :: "memory")
#define TK_RELU16(A) asm volatile("s_nop 15\n\ts_nop 3\n\tv_max_f32_e32 %0, 0, %0\n\tv_max_f32_e32 %1, 0, %1\n\tv_max_f32_e32 %2, 0, %2\n\tv_max_f32_e32 %3, 0, %3\n\tv_max_f32_e32 %4, 0, %4\n\tv_max_f32_e32 %5, 0, %5\n\tv_max_f32_e32 %6, 0, %6\n\tv_max_f32_e32 %7, 0, %7\n\t" \
            "v_max_f32_e32 %8, 0, %8\n\tv_max_f32_e32 %9, 0, %9\n\tv_max_f32_e32 %10, 0, %10\n\tv_max_f32_e32 %11, 0, %11\n\tv_max_f32_e32 %12, 0, %12\n\tv_max_f32_e32 %13, 0, %13\n\tv_max_f32_e32 %14, 0, %14\n\tv_max_f32_e32 %15, 0, %15" \
            : "+v"(A[0]), "+v"(A[1]), "+v"(A[2]), "+v"(A[3]), "+v"(A[4]), "+v"(A[5]), "+v"(A[6]), "+v"(A[7]), "+v"(A[8]), "+v"(A[9]), "+v"(A[10]), "+v"(A[11]), "+v"(A[12]), "+v"(A[13]), "+v"(A[14]), "+v"(A[15]))
#define TK_COMP(src, kt) do { _Pragma("unroll") for (int rt = 0; rt < 2; ++rt) { f32x16 acc = {}; \
            _Pragma("unroll") for (int ks = 0; ks < 4; ++ks) acc = __builtin_amdgcn_mfma_f32_32x32x16_bf16(ops.af[rt][ks], src[ks], acc, 0, 0, 0); \
            float e_[16]; _Pragma("unroll") for (int h = 0; h < 16; ++h) e_[h] = acc[h]; \
            TK_RELU16(e_); \
            float s0 = e_[0] * wq[rt][0][0], s1 = e_[8] * wq[rt][1][0]; \
            _Pragma("unroll") for (int h = 1; h < 8; ++h) { s0 = __builtin_fmaf(e_[h], wq[rt][0][h], s0); s1 = __builtin_fmaf(e_[8 + h], wq[rt][1][h], s1); } \
            sc[(rt * 4 + hb) * SEQ + (kt) * 32 + r] = s0; sc[(rt * 4 + 2 + hb) * SEQ + (kt) * 32 + r] = s1; \
            qmn[rt * 2] = fminf(qmn[rt * 2], s0); qmx[rt * 2] = fmaxf(qmx[rt * 2], s0); qmn[rt * 2 + 1] = fminf(qmn[rt * 2 + 1], s1); qmx[rt * 2 + 1] = fmaxf(qmx[rt * 2 + 1], s1); } } while (0)
        bf16x8 kb0[4], kb1[4], kb2[4], kb3[4];
        int kt = wave;
        TK_LOAD(kb0, kt); TK_LOAD(kb1, kt + 8); TK_LOAD(kb2, kt + 16);
        for (; kt < nkt; kt += 32) {
            TK_LOAD(kb3, kt + 24); TK_WAIT(kb0, 12);
            TK_COMP(kb0, kt);
            TK_LOAD(kb0, kt + 32); TK_WAIT(kb1, 12); if (kt + 8 < nkt) TK_COMP(kb1, kt + 8);
            TK_LOAD(kb1, kt + 40); TK_WAIT(kb2, 12); if (kt + 16 < nkt) TK_COMP(kb2, kt + 16);
            TK_LOAD(kb2, kt + 48); TK_WAIT(kb3, 12); if (kt + 24 < nkt) TK_COMP(kb3, kt + 24);
        }
        TK_WAIT(kb0, 0); TK_WAIT(kb1, 0); TK_WAIT(kb2, 0); TK_WAIT(kb3, 0);
#undef TK_LOAD
#undef TK_WAIT
#undef TK_COMP
#undef TK_RELU16
#pragma unroll
        for (int s = 0; s < 4; ++s) {
#pragma unroll
            for (int o = 1; o < 32; o <<= 1) { qmn[s] = fminf(qmn[s], shxr_f(qmn[s], lane, o)); qmx[s] = fmaxf(qmx[s], shxr_f(qmx[s], lane, o)); }
            if (r == 0) { const int q = (s >> 1) * 4 + 2 * (s & 1) + hb; mm[(wave * 8 + q) * 2] = qmn[s]; mm[(wave * 8 + q) * 2 + 1] = qmx[s]; }
        }
    }
    __syncthreads();
    TkStage nst; if (nt0 >= 0) topk_stage_load(nst, PBg, tb, nt0, F.tid);
    PROBE_T1(1); PROBE_T0(2);
    if (!(dbg & 4)) {
        asm volatile("; TK_P2_BEGIN");
        const LAS float* row = sc + wave * SEQ;
        LAS float* cand = (LAS float*)(F.lds + CAND_OFF) + wave * 256;
        float lo = INFINITY, hi = -INFINITY;
#pragma unroll
        for (int w = 0; w < 8; ++w) { lo = fminf(lo, mm[(w * 8 + wave) * 2]); hi = fmaxf(hi, mm[(w * 8 + wave) * 2 + 1]); }
        GAS unsigned long long* mrow = MASK + (tb + t0 + wave) * 64;
        const int nj = n >> 6;
        float v[64];
#pragma unroll
        for (int jb = 0; jb < 4; ++jb) {
#pragma unroll
            for (int j = jb * 16; j < jb * 16 + 16; ++j) v[j] = -INFINITY;
            if (jb * 16 < nj) {
#pragma unroll
                for (int j = jb * 16; j < jb * 16 + 16; ++j) if (j < nj) v[j] = row[j * 64 + lane]; } }
#define TK_GTM(P, X) (__float_as_int((P) - (X)) >> 31)
#define TK_COUNT_GT(P, OUT, LOUT) do { int c0_ = 0, c1_ = 0, c2_ = 0, c3_ = 0; _Pragma("unroll") for (int jb = 0; jb < 4; ++jb) { if (jb * 16 < nj) { _Pragma("unroll") for (int j = jb * 16; j < jb * 16 + 16; j += 4) { \
            c0_ -= TK_GTM(P, v[j]); c1_ -= TK_GTM(P, v[j + 1]); c2_ -= TK_GTM(P, v[j + 2]); c3_ -= TK_GTM(P, v[j + 3]); } } } LOUT = (c0_ + c1_) + (c2_ + c3_); OUT = (int)wave_sum_u((unsigned)LOUT); } while (0)
        float a = lo, bb = hi; int ga, gb = 0, la, lb = 0;
        TK_COUNT_GT(a, ga, la);
        float thr = 0.f; int ithr = -1, need_eq = 0; bool tie = false, have = false;
        if (ga < 256) { thr = a; need_eq = 256 - ga; tie = true; have = true; }
        for (int it = 0; it < 48 && !have; ++it) {
            if (ga - gb <= 64) break;
            const float mid = a + 0.5f * (bb - a);
            if (!(mid > a && mid < bb)) { thr = bb; need_eq = 256 - gb; tie = true; have = true; break; }
            int g, lg; TK_COUNT_GT(mid, g, lg);
            if (g >= 256) { a = mid; ga = g; la = lg; } else { bb = mid; gb = g; lb = lg; }
            if (MK_PROBE == 5 && blockIdx.x == 4 && threadIdx.x == 0) { gu32* w_ = F.ctl + 3; *(volatile GAS unsigned*)w_ = *(volatile GAS unsigned*)w_ + 1u; }
        }
        bool dup = false;
        if (!have) {
            const int hcount = ga - gb, need2 = 256 - gb;
            const int mycnt = la - lb;
            int pos = (int)wave_excl_scan_u((unsigned)mycnt, lane);
            const int candb = (int)(size_t)cand, dumpb = candb + 512 + 8 * lane;
#pragma unroll
            for (int jb = 0; jb < 4; ++jb) { if (jb * 16 < nj) {
#pragma unroll
                for (int j = jb * 16; j < jb * 16 + 16; ++j) { const int m = TK_GTM(a, v[j]) - TK_GTM(bb, v[j]);
                    const int addr = dumpb + (m & (candb + 8 * pos - dumpb));
                    *(LAS f32x2c*)(size_t)addr = (f32x2c){v[j], __int_as_float(j * 64 + lane)}; pos -= m; } } }
            LDS_WAIT();
            float ms = -INFINITY; int mi = 0x7fffffff;
            if (lane < hcount) { ms = cand[2 * lane]; mi = __float_as_int(cand[2 * lane + 1]); }
            int rank = 0, nge = 0;
            for (int j = 0; j < hcount; ++j) { const float sj = bcast_f(ms, j); rank -= TK_GTM(ms, sj); nge += 1 + TK_GTM(sj, ms); }
            if (__ballot(lane < hcount && nge - rank != 1) != 0ull) {
                rank = 0;
                for (int j = 0; j < hcount; ++j) { const float sj = bcast_f(ms, j); const int ij = bcast_i(mi, j); rank += (sj > ms || (sj == ms && ij < mi)) ? 1 : 0; }
            }
            const unsigned long long tb2 = __ballot(lane < hcount && rank == need2 - 1);
            const int s2 = __builtin_amdgcn_readfirstlane(tb2 != 0ull ? __ffsll((long long)tb2) - 1 : 0);
            thr = bcast_f(ms, s2); ithr = bcast_i(mi, s2);
            dup = __popcll(__ballot(lane < hcount && ms == thr)) > 1;
        }
#undef TK_COUNT_GT
#define TK_PUTW(W, J) do { const unsigned wl_ = (unsigned)(W), wh_ = (unsigned)((W) >> 32); asm volatile("s_nop 1\n\tv_writelane_b32 %0, %2, %4\n\tv_writelane_b32 %1, %3, %4" : "+v"(wlo), "+v"(whi) : "s"(wl_), "s"(wh_), "n"(J)); } while (0)
        int wlo = 0, whi = 0;
        if (!tie && !dup) {
#pragma unroll
            for (int jb = 0; jb < 4; ++jb) { if (jb * 16 < nj) {
#pragma unroll
                for (int j = jb * 16; j < jb * 16 + 16; ++j) { const unsigned long long w = __ballot(v[j] >= thr); TK_PUTW(w, j); } } }
        } else if (!tie) {
#pragma unroll
            for (int jb = 0; jb < 4; ++jb) { if (jb * 16 < nj) {
#pragma unroll
                for (int j = jb * 16; j < jb * 16 + 16; ++j) { const float s = v[j]; const int irel = ithr - j * 64; const bool sel = s > thr || (s == thr && lane <= irel);
                    const unsigned long long w = __ballot(sel); TK_PUTW(w, j); } } }
        } else {
            int run_eq = 0;
#pragma unroll
            for (int jb = 0; jb < 4; ++jb) { if (jb * 16 < nj) {
#pragma unroll
                for (int j = jb * 16; j < jb * 16 + 16; ++j) { const float s = v[j]; const bool eq = s == thr;
                    const unsigned long long em = __ballot(eq); const int rank = run_eq + __popcll(em & ((1ull << lane) - 1ull));
                    const unsigned long long w = __ballot(s > thr || (eq && rank < need_eq)); TK_PUTW(w, j); run_eq += __popcll(em); } } }
        }
#undef TK_PUTW
#undef TK_GTM
        const unsigned long long myword = ((unsigned long long)(unsigned)whi << 32) | (unsigned)wlo;
        mrow[lane] = myword;
        asm volatile("; TK_P2_END");
    }
    if (nt0 >= 0) { topk_stage_store(nst, qst, F.tid); LDS_WAIT(); }
    __syncthreads();
    PROBE_T1(2); PROBE_T1(3);
}

__device__ __forceinline__ float sigm_f(float x) { return __builtin_amdgcn_rcpf(1.0f + __builtin_amdgcn_exp2f(-1.4426950408889634f * x)); }
__device__ __forceinline__ void poolconv_tile(Frame& F, const Args& A, int l, int tile) {
    const GAS bf16* PB = (const GAS bf16*)(F.ws + WS_PB); GAS bf16* YB = (GAS bf16*)(F.ws + WS_HB);
    const int tid = F.tid, lane = F.lane, wave = F.wave;
    const int t0 = (tile & 63) * 64; const size_t tb = (size_t)(tile >> 6) * SEQ;
    LAS bf16* act = (LAS bf16*)(F.lds + RING_OFF);
    LAS float* hbuf = (LAS float*)(F.lds + RING_OFF + 49152);
    const int ch = tid & 255, th = tid >> 8;
    {
        float gl[62];
#pragma unroll
        for (int i = 0; i < 62; ++i) { const int t = t0 + th * 32 - 30 + i; const size_t rowo = (tb + (t >= 0 ? t : 0)) * NP;
            const float a = bf2f(PB[rowo + PC_CA + ch]), g = bf2f(PB[rowo + PC_CG + ch]); gl[i] = (t >= 0) ? a * sigm_f(g) : 0.f; }
        const float* dw = A.in[I_DWW] + (size_t)l * 31 * 256; float wt[31];
#pragma unroll
        for (int j = 0; j < 31; ++j) wt[j] = dw[j * 256 + ch];
        const float bias = A.in[I_DWB][l * 256 + ch];
#pragma unroll
        for (int tt = 0; tt < 32; ++tt) { float acc = bias;
#pragma unroll
            for (int j = 0; j < 31; ++j) acc = __builtin_fmaf(gl[tt + j], wt[j], acc);
            hbuf[(th * 32 + tt) * 256 + ch] = acc; }
    }
    __syncthreads();
    {
        const f32x4 g4 = *(const f32x4*)(A.in[I_LNG] + l * 256 + 4 * lane), b4 = *(const f32x4*)(A.in[I_LNB] + l * 256 + 4 * lane);
        for (int tr = wave; tr < 64; tr += NWAVES) { const f32x4 v = *(const LAS f32x4*)(hbuf + tr * 256 + 4 * lane);
            const float mu = wave_sum((v.x + v.y) + (v.z + v.w), lane) * (1.0f / 256.0f);
            const f32x4 d = v - mu; const float var = wave_sum((d.x * d.x + d.y * d.y) + (d.z * d.z + d.w * d.w), lane) * (1.0f / 256.0f);
            const float rs = 1.0f / sqrtf(var + RMS_EPS);
            f32x4 y = d * rs * g4 + b4;
            y.x *= sigm_f(y.x); y.y *= sigm_f(y.y); y.z *= sigm_f(y.z); y.w *= sigm_f(y.w);
            *(LAS u32x2*)(act + tr * 264 + 4 * lane) = (u32x2){pk2(y.x, y.y), pk2(y.z, y.w)}; }
    }
    __syncthreads();
    {
        const GAS bf16* pw = (const GAS bf16*)(F.ws + WS_PWWT) + (size_t)l * 256 * 256;
        f32x4 acc[2][4];
#pragma unroll
        for (int a = 0; a < 2; ++a)
#pragma unroll
            for (int t = 0; t < 4; ++t) acc[a][t] = (f32x4){0.f, 0.f, 0.f, 0.f};
        const int fr = lane & 15, fq = lane >> 4;
#pragma unroll
        for (int ks = 0; ks < 8; ++ks) {
            bf16x8 af[2], bfv[4];
#pragma unroll
            for (int a = 0; a < 2; ++a) af[a] = *(const GAS bf16x8*)(pw + (size_t)((2 * wave + a) * 16 + fr) * 256 + ks * 32 + 8 * fq);
#pragma unroll
            for (int t = 0; t < 4; ++t) bfv[t] = *(const LAS bf16x8*)(act + (t * 16 + fr) * 264 + ks * 32 + 8 * fq);
#pragma unroll
            for (int a = 0; a < 2; ++a)
#pragma unroll
                for (int t = 0; t < 4; ++t) acc[a][t] = __builtin_amdgcn_mfma_f32_16x16x32_bf16(af[a], bfv[t], acc[a][t], 0, 0, 0);
        }
#pragma unroll
        for (int a = 0; a < 2; ++a) { const int n0 = (2 * wave + a) * 16 + 4 * fq; const f32x4 pb4 = *(const f32x4*)(A.in[I_PWB] + l * 256 + n0);
#pragma unroll
            for (int t = 0; t < 4; ++t) { const f32x4 o = acc[a][t] + pb4;
                *(GAS u32x2*)(YB + (tb + t0 + t * 16 + fr) * D + 768 + n0) = (u32x2){pk2(o.x, o.y), pk2(o.z, o.w)}; } }
    }
    LAS bf16* dp = (LAS bf16*)hbuf;
    {
        const int win = 2 << (ch >> 6);
        float u[47];
#pragma unroll
        for (int i = 0; i < 47; ++i) { const int t = t0 + th * 32 - 15 + i; u[i] = (t >= 0) ? bf2f(PB[(tb + (t >= 0 ? t : 0)) * NP + PC_POOL + ch]) : 0.f; }
#pragma unroll
        for (int tt = 0; tt < 32; ++tt) { const int t = t0 + th * 32 + tt; float s = 0.f;
#pragma unroll
            for (int j = 0; j < 16; ++j) if (j < win) s += u[15 + tt - j];
            const int cnt = (t + 1 < win) ? (t + 1) : win;
            dp[(th * 32 + tt) * 264 + ch] = (bf16)f2bf(s * __builtin_amdgcn_rcpf((float)cnt) - u[15 + tt]); }
    }
    __syncthreads();
    {
        const int g = wave >> 1; const GAS bf16* pwt = (const GAS bf16*)(F.ws + WS_POOLWT) + ((size_t)l * 4 + g) * 64 * 64;
        f32x4 acc[2][4];
#pragma unroll
        for (int a = 0; a < 2; ++a)
#pragma unroll
            for (int t = 0; t < 4; ++t) acc[a][t] = (f32x4){0.f, 0.f, 0.f, 0.f};
        const int fr = lane & 15, fq = lane >> 4;
#pragma unroll
        for (int ks = 0; ks < 2; ++ks) {
            bf16x8 af[2], bfv[4];
#pragma unroll
            for (int a = 0; a < 2; ++a) af[a] = *(const GAS bf16x8*)(pwt + (size_t)((2 * (wave & 1) + a) * 16 + fr) * 64 + ks * 32 + 8 * fq);
#pragma unroll
            for (int t = 0; t < 4; ++t) bfv[t] = *(const LAS bf16x8*)(dp + (t * 16 + fr) * 264 + g * 64 + ks * 32 + 8 * fq);
#pragma unroll
            for (int a = 0; a < 2; ++a)
#pragma unroll
                for (int t = 0; t < 4; ++t) acc[a][t] = __builtin_amdgcn_mfma_f32_16x16x32_bf16(af[a], bfv[t], acc[a][t], 0, 0, 0);
        }
#pragma unroll
        for (int a = 0; a < 2; ++a) { const int n0 = g * 64 + (2 * (wave & 1) + a) * 16 + 4 * fq; const f32x4 ps4 = *(const f32x4*)(A.in[I_POOLS] + l * 256 + n0);
#pragma unroll
            for (int t = 0; t < 4; ++t) { const f32x4 o = acc[a][t] * ps4;
                *(GAS u32x2*)(YB + (tb + t0 + t * 16 + fr) * D + 512 + n0) = (u32x2){pk2(o.x, o.y), pk2(o.z, o.w)}; } }
    }
    __syncthreads();
}
__device__ __forceinline__ void phaseB(Frame& F, const Args& A, int l) {
    if (!(A.pad & 1)) {
    const int b = F.vcu & 3, j = F.vcu >> 2;
    {
#define TK_T0(i) ((((i) < 4) ? j : 63 - j) * 64 + (i) * 8)
        { TkStage st; topk_stage_load(st, (const GAS bf16*)(F.ws + WS_PB), (size_t)b * SEQ, TK_T0(0), F.tid); topk_stage_store(st, F.lds + QST_OFF, F.tid); LDS_WAIT(); __syncthreads(); }
        for (int i = 0; i < 8; ++i) topk_unit(F, b, TK_T0(i), (i + 1 < 8) ? TK_T0(i + 1) : -1, A.pad);
#undef TK_T0
    }
    }
    if (!(A.pad & 2)) { PROBE_T0(4); poolconv_tile(F, A, l, F.vcu); PROBE_T1(4); }
}

struct EpiInProj {
    static constexpr bool PERM = true, AFTER_DRAIN = false;
    bf16* O; bf16* KIF; float scale0;
    __device__ __forceinline__ void operator()(const pg8::f32x4 (&acc)[2][2][4][2], const pg8::Unit& u, int wr, int wc, int fr, int fq) const {
        const int row0 = u.pm * pg8::BM + wr * 64 + fr; const int colt = u.pn * pg8::BM;
        const float sc = colt < 512 ? scale0 : 1.f;
        const int col0 = colt + wc * 32 + 8 * fq;
        const bool kif = (u.pn == 11) && (wc < 2);
        const int chunk = wc * 4 + fq;
#pragma unroll
        for (int ai = 0; ai < 2; ++ai)
#pragma unroll
            for (int m = 0; m < 4; ++m) { const int row = row0 + ai * pg8::HALF + m * 16; bf16* rowp = O + (size_t)row * NP + col0;
#pragma unroll
                for (int bj = 0; bj < 2; ++bj) { pg8::f32x4 v0 = acc[ai][bj][m][0] * sc, v1 = acc[ai][bj][m][1] * sc;
                    pg8::u32x4 w; w.x = pg8::cvt_pk_bf16(v0[0], v0[1]); w.y = pg8::cvt_pk_bf16(v0[2], v0[3]); w.z = pg8::cvt_pk_bf16(v1[0], v1[1]); w.w = pg8::cvt_pk_bf16(v1[2], v1[3]);
                    *(pg8::u32x4*)(rowp + bj * pg8::HALF) = w;
                    if (bj == 0 && kif) *(pg8::u32x4*)((char*)KIF + (size_t)(row >> 5) * 4096 + (chunk & 3) * 1024 + ((chunk >> 2) * 32 + (row & 31)) * 16) = w; } }
    }
};

constexpr int N_PHASES = 17;
__global__ void __launch_bounds__(NWAVES * 64, 2) skel_fwd(Args args) {
    extern __shared__ __attribute__((aligned(16))) unsigned char lds[];
    Frame F;
    F.lds = (LAS unsigned char*)lds;
    F.MISC = (volatile LAS unsigned*)(F.lds + MISC_OFF);
    F.tid = threadIdx.x; F.lane = F.tid & 63; F.wave = __builtin_amdgcn_readfirstlane(F.tid >> 6);
    F.G = gridDim.x; { const int bx = blockIdx.x; F.vcu = (F.G % 8 == 0) ? (bx % 8) * (F.G / 8) + bx / 8 : bx; }
    F.ws = args.ws; F.out = args.out; F.ctl = (gu32*)(args.ws + WS_CTL);
    for (int u = F.tid; u < (LDS_BYTES - LDSCTL_OFF) / 4; u += NWAVES * 64) ((LAS unsigned*)(F.lds + LDSCTL_OFF))[u] = 0u;
    __syncthreads();
    const int lo = args.ph_lo, hi = args.ph_hi;
    const bool multi = (hi - lo) > 1;
    XcdBarrier bar; bar.bar = (unsigned*)(F.ctl + CW_BAR) + args.li * XCD_BAR_WORDS; bar.x = 0; bar.st = nullptr;
    if (multi) bar = xcd_barrier_post((unsigned*)(F.ctl + CW_BAR) + args.li * XCD_BAR_WORDS, F.MISC + 8);
#define FRESH() do { int t_ = threadIdx.x; asm volatile("" : "+v"(t_)); F.tid = t_; F.lane = t_ & 63; F.wave = __builtin_amdgcn_readfirstlane(t_ >> 6); } while (0)
#ifndef MK_REP
#define MK_REP (-1)
#endif
#define REPS(k) for (int rep_ = 0; rep_ < ((MK_REP) == (k) ? 2 : 1); ++rep_)
#define IN(k) (lo <= (k) && (k) < hi)
#define SEAM(k) do { if (IN(k) && IN((k) + 1)) xcd_barrier(bar); } while (0)

    if (IN(0)) { REPS(0) { FRESH(); p0_prologue(F, args); } SEAM(0);
#ifdef MK_XBAR
        for (int xb_ = 0; xb_ < MK_XBAR; ++xb_) xcd_barrier(bar);
#endif
    }
    for (int l = 0; l < DEPTH; ++l) {
        const int pb = 1 + 8 * l;
        bf16* HB = (bf16*)(F.ws + WS_HB); bf16* PB = (bf16*)(F.ws + WS_PB);
        if (IN(pb + 0)) {
            pg8::Gemm g{HB, (const bf16*)(F.ws + WS_WIN) + (size_t)l * NP * D, T, NP, D}; pg8::StaticOrder S; S.init(T, NP, F.G, (int)blockIdx.x);
            EpiInProj E{PB, (bf16*)(F.ws + WS_KIF), C2};
            REPS(pb + 0) pg8::gemm_phase<EpiInProj, pg8::StaticOrder, PG8_ALIGN, PG8_SP2>(F.lds + RING_OFF, g, S, E);
            SEAM(pb + 0);
        }
        if (IN(pb + 1)) { REPS(pb + 1) { FRESH(); phaseB(F, args, l); } SEAM(pb + 1); }
#ifndef MK_NO_ATTN
        if (IN(pb + 2)) {
            const attn_body::AttnTensors AT{(const attn_body::bf16*)(PB + PC_Q), (const attn_body::bf16*)(PB + PC_K), (const attn_body::bf16*)(PB + PC_V), (attn_body::bf16*)HB, (const unsigned long long*)(F.ws + WS_MASK)};
            const attn_body::StaticOrder S((int)F.G, (int)blockIdx.x);
            REPS(pb + 2) attn_body::attn_phase<attn_body::StaticOrder>((char*)lds + RING_OFF, AT, S);
            SEAM(pb + 2);
        }
#endif
        if (IN(pb + 3)) {
            pg8::Gemm g{HB, (const bf16*)(F.ws + WS_WOUT) + (size_t)l * D * D, T, D, D}; pg8::StaticOrder S; S.init(T, D, F.G, (int)blockIdx.x);
            EpiResF32 E{l == 0 ? args.in[I_X] : F.out, F.out, D};
            REPS(pb + 3) pg8::gemm_phase<EpiResF32, pg8::StaticOrder, PG8_ALIGN, PG8_SP2>(F.lds + RING_OFF, g, S, E);
            SEAM(pb + 3);
        }
#ifndef MK_NO_R2
        if (IN(pb + 4)) { FRESH(); r2_router(F, args, l); SEAM(pb + 4); }
#endif
        if (IN(pb + 5) || IN(pb + 6)) {
            FRESH(); moe_build_table(F, l);
            MoeSched S; S.tab = (const LAS int*)(F.lds + MOE_TAB_OFF); S.ntiles = __builtin_amdgcn_readfirstlane(S.tab[0]); S.ntx = (S.ntiles + 7) / 8; S.xcd = F.vcu / 32; S.j = F.vcu % 32;
            S.blist = (const int*)(F.ws + WS_BLIST);
            bf16* HID = PB;
#ifndef MK_NO_D1
            if (IN(pb + 5)) {
                S.mode = 1; S.npn = 8; S.Abase = (const char*)HB; S.Bbase = (const char*)(F.ws + WS_WGU) + (size_t)l * 16 * 1024 * 1024 * 2;
                pg8::Gemm2 g{1024, 1024, 1024}; EpiSwiGLU E{HID, (const float*)(F.ws + WS_BW)};
                REPS(pb + 5) pg8::gemm_phase2<EpiSwiGLU, MoeSched, true, PG8_ALIGN>(F.lds + RING_OFF, g, S, E);
                SEAM(pb + 5);
            }
#endif
#ifndef MK_NO_D2
            if (IN(pb + 6)) {
                S.mode = 2; S.npn = 4; S.Abase = (const char*)HID; S.Bbase = (const char*)(F.ws + WS_WD) + (size_t)l * 16 * 1024 * 512 * 2;
                pg8::Gemm2 g{1024, 1024, 512}; EpiScatter E{F.out, (const int*)(F.ws + WS_BLIST)};
                pg8::gemm_phase2<EpiScatter, MoeSched, false, PG8_ALIGN>(F.lds + RING_OFF, g, S, E);
                SEAM(pb + 6);
            }
#endif
        }
        if (IN(pb + 7)) {
            FRESH(); const int gw = F.vcu * NWAVES + F.wave, NGW = F.G * NWAVES;
            if (l + 1 < DEPTH) { REPS(pb + 7) for (int m = gw; m < T; m += 4 * NGW) rms_rows_to_bf16<4>(F.out + (size_t)m * D, (size_t)NGW * D, args.in[I_N1G] + (size_t)(l + 1) * D, HB + (size_t)m * D, F.lane); }
            else { for (int m = gw; m < T; m += NGW) rms_row_f32(F.out + (size_t)m * D, args.in[I_FG], F.lane);
#ifndef MK_PROBE_SHIFT
#define MK_PROBE_SHIFT 0.0f
#endif
#if MK_PROBE
                { VM_WAIT(); __syncthreads(); const float tk_ = (float)__hip_atomic_load(F.ctl + 3, RLX_AGENT); const float dl = sqrtf(0.01f * floorf(logf(fmaxf(tk_, 1.f)) * (1.0f / 0.13976194f) + MK_PROBE_SHIFT));
                  for (int m = gw; m < T; m += NGW) { GAS f32x4* xr = (GAS f32x4*)(F.out + (size_t)m * D) + F.lane; for (int j = 0; j < 4; ++j) xr[64 * j] = xr[64 * j] + dl; } }
#endif
            }
            SEAM(pb + 7);
        }
    }
#undef IN
#undef SEAM
}
namespace nv {
__device__ __forceinline__ float wave_max(float v) {
#pragma unroll
    for (int o = 1; o < 64; o <<= 1) v = fmaxf(v, __shfl_xor(v, o));
    return v;
}
__device__ __forceinline__ float block_sum256(float v, float* red) {
    v = wave_sum(v, threadIdx.x & 63);
    __syncthreads();
    if ((threadIdx.x & 63) == 0) red[threadIdx.x >> 6] = v;
    __syncthreads();
    return (red[0] + red[1]) + (red[2] + red[3]);
}
__device__ __forceinline__ float ldb(const bf16* p) { return bf2f(*p); }

__global__ void __launch_bounds__(256) k_index_topk(const bf16* __restrict__ PB, unsigned* __restrict__ mask) {
    __shared__ float qi[512];
    __shared__ float w[8];
    __shared__ float sc[SEQ];
    const int tok = blockIdx.x, b = tok / SEQ, t = tok % SEQ, tid = threadIdx.x, lane = tid & 63, wv = tid >> 6;
    const int n = ((t >> 6) + 1) * 64;
    const bf16* prow = PB + (size_t)tok * NP;
    qi[tid] = ldb(prow + PC_QI + tid); qi[tid + 256] = ldb(prow + PC_QI + 256 + tid);
    if (tid < 8) w[tid] = ldb(prow + PC_WI + tid);
    __syncthreads();
    for (int s = tid; s < n; s += 256) {
        const bf16* kr = PB + (size_t)(b * SEQ + s) * NP + PC_KI;
        float kv[64];
#pragma unroll
        for (int d = 0; d < 64; ++d) kv[d] = ldb(kr + d);
        float score = 0.f;
        for (int h = 0; h < 8; ++h) {
            float dsum = 0.f;
#pragma unroll
            for (int d = 0; d < 64; ++d) dsum += qi[h * 64 + d] * kv[d];
            score += fmaxf(dsum, 0.f) * w[h];
        }
        sc[s] = score;
    }
    __syncthreads();
    unsigned* mrow = mask + (size_t)tok * 128;
    for (int base = 0; base < SEQ; base += 256) {
        const int s = base + wv * 64 + lane;
        bool sel = false;
        if (s < n) {
            if (n <= 256) sel = true;
            else {
                const float v = sc[s];
                int rank = 0;
                for (int j = 0; j < n; ++j) { const float u = sc[j]; rank += (u > v || (u == v && j < s)) ? 1 : 0; }
                sel = rank < 256;
            }
        }
        const unsigned long long bal = __ballot(sel);
        if (lane == 0) { mrow[(base + wv * 64) / 32] = (unsigned)bal; mrow[(base + wv * 64) / 32 + 1] = (unsigned)(bal >> 32); }
    }
}

__global__ void __launch_bounds__(256) k_attn(const bf16* __restrict__ PB, const unsigned* __restrict__ mask, bf16* __restrict__ YB) {
    __shared__ float q[512];
    __shared__ int sel[256];
    __shared__ int pre[129];
    __shared__ float lg[8][256];
    __shared__ float rs[8];
    const int tok = blockIdx.x, b = tok / SEQ, tid = threadIdx.x, lane = tid & 63, wv = tid >> 6;
    const bf16* prow = PB + (size_t)tok * NP;
    q[tid] = ldb(prow + PC_Q + tid); q[tid + 256] = ldb(prow + PC_Q + 256 + tid);
    const unsigned* mrow = mask + (size_t)tok * 128;
    unsigned mw = 0;
    if (tid < 128) mw = mrow[tid];
    if (tid < 128) pre[tid + 1] = __popc(mw);
    if (tid == 0) pre[0] = 0;
    __syncthreads();
    if (tid == 0) { for (int i = 1; i <= 128; ++i) pre[i] += pre[i - 1]; }
    __syncthreads();
    if (tid < 128) { int p = pre[tid]; unsigned m = mw; while (m) { const int bit = __ffs(m) - 1; m &= m - 1; if (p < 256) sel[p] = tid * 32 + bit; ++p; } }
    __syncthreads();
    int cnt = pre[128]; if (cnt > 256) cnt = 256;
    if (tid < cnt) {
        const bf16* kr = PB + (size_t)(b * SEQ + sel[tid]) * NP + PC_K;
        for (int h = 0; h < 8; ++h) {
            float dsum = 0.f;
#pragma unroll
            for (int d = 0; d < 64; ++d) dsum += q[h * 64 + d] * ldb(kr + h * 64 + d);
            lg[h][tid] = dsum;
        }
    }
    __syncthreads();
    for (int hh = 0; hh < 2; ++hh) {
        const int h = wv * 2 + hh;
        float m = -INFINITY;
        for (int j = lane; j < cnt; j += 64) m = fmaxf(m, lg[h][j]);
        m = wave_max(m);
        float s = 0.f;
        for (int j = lane; j < cnt; j += 64) { const float e = exp2f(lg[h][j] - m); lg[h][j] = e; s += e; }
        s = wave_sum(s, lane);
        if (lane == 0) rs[h] = 1.0f / s;
    }
    __syncthreads();
    for (int oo = 0; oo < 2; ++oo) {
        const int o = tid + oo * 256, h = o >> 6;
        float acc = 0.f;
        for (int j = 0; j < cnt; ++j) acc += lg[h][j] * ldb(PB + (size_t)(b * SEQ + sel[j]) * NP + PC_V + o);
        YB[(size_t)tok * D + o] = (bf16)f2bf(acc * rs[h]);
    }
}

__global__ void __launch_bounds__(256) k_pool(const bf16* __restrict__ PB, const float* __restrict__ pw, const float* __restrict__ ps, bf16* __restrict__ YB) {
    __shared__ float d[256];
    const int tok = blockIdx.x, t = tok % SEQ, c = threadIdx.x, g = c >> 6;
    const int win = 2 << g;
    const int cntw = (t + 1 < win) ? (t + 1) : win;
    float s = 0.f;
    for (int j = 0; j < cntw; ++j) s += ldb(PB + (size_t)(tok - j) * NP + PC_POOL + c);
    d[c] = s / (float)cntw - ldb(PB + (size_t)tok * NP + PC_POOL + c);
    __syncthreads();
    const int dout = c & 63;
    float acc = 0.f;
    for (int cc = 0; cc < 64; ++cc) acc += d[g * 64 + cc] * pw[(size_t)(g * 64 + cc) * 64 + dout];
    YB[(size_t)tok * D + 512 + c] = (bf16)f2bf(acc * ps[c]);
}

__global__ void __launch_bounds__(256) k_conv(const bf16* __restrict__ PB, const float* __restrict__ dw_w, const float* __restrict__ dw_b, const float* __restrict__ ln_g,
                                              const float* __restrict__ ln_b, const float* __restrict__ pw_w, const float* __restrict__ pw_b, bf16* __restrict__ YB) {
    __shared__ float sh[256];
    __shared__ float red[4];
    const int tok = blockIdx.x, t = tok % SEQ, c = threadIdx.x;
    float h = dw_b[c];
    for (int j = 0; j < 31; ++j) {
        const int tt = t - 30 + j;
        if (tt >= 0) {
            const bf16* pr = PB + (size_t)(tok - 30 + j) * NP;
            const float a = ldb(pr + PC_CA + c), gt = ldb(pr + PC_CG + c);
            h += a * (1.0f / (1.0f + expf(-gt))) * dw_w[j * 256 + c];
        }
    }
    const float mu = block_sum256(h, red) * (1.0f / 256.0f);
    const float dv = h - mu;
    const float var = block_sum256(dv * dv, red) * (1.0f / 256.0f);
    float y = dv * (1.0f / sqrtf(var + RMS_EPS)) * ln_g[c] + ln_b[c];
    y = y / (1.0f + expf(-y));
    __syncthreads();
    sh[c] = y;
    __syncthreads();
    float acc = pw_b[c];
    for (int k = 0; k < 256; ++k) acc += sh[k] * pw_w[k * 256 + c];
    YB[(size_t)tok * D + 768 + c] = (bf16)f2bf(acc);
}

__global__ void __launch_bounds__(256) k_router(const float* __restrict__ X1, const float* __restrict__ g2, const float* __restrict__ rg_w, const float* __restrict__ rg_b,
                                                const float* __restrict__ re_w, const float* __restrict__ re_b, bf16* __restrict__ H2, int* __restrict__ route_e, float* __restrict__ route_w) {
    __shared__ float red[4];
    __shared__ float part[20][4];
    const int tok = blockIdx.x, tid = threadIdx.x, lane = tid & 63, wv = tid >> 6;
    const float4 v = ((const float4*)(X1 + (size_t)tok * D))[tid];
    float s = v.x * v.x + v.y * v.y + v.z * v.z + v.w * v.w;
    s = block_sum256(s, red);
    const float r = 1.0f / sqrtf(s * (1.0f / D) + RMS_EPS);
    const float4 gv = ((const float4*)g2)[tid];
    float hv[4] = {v.x * r * gv.x, v.y * r * gv.y, v.z * r * gv.z, v.w * r * gv.w};
    ((uint2*)(H2 + (size_t)tok * D))[tid] = make_uint2(pk2(hv[0], hv[1]), pk2(hv[2], hv[3]));
    float lg[20];
#pragma unroll
    for (int j = 0; j < 20; ++j) lg[j] = 0.f;
#pragma unroll
    for (int i = 0; i < 4; ++i) {
        const int k = tid * 4 + i;
#pragma unroll
        for (int j = 0; j < 4; ++j) lg[j] += hv[i] * rg_w[k * 4 + j];
#pragma unroll
        for (int j = 0; j < 16; ++j) lg[4 + j] += hv[i] * re_w[k * 16 + j];
    }
#pragma unroll
    for (int j = 0; j < 20; ++j) { const float x = wave_sum(lg[j], lane); if (lane == 0) part[j][wv] = x; }
    __syncthreads();
    if (tid == 0) {
        float gl[4], el[16];
        for (int j = 0; j < 4; ++j) gl[j] = (part[j][0] + part[j][1]) + (part[j][2] + part[j][3]) + rg_b[j];
        for (int j = 0; j < 16; ++j) el[j] = (part[4 + j][0] + part[4 + j][1]) + (part[4 + j][2] + part[4 + j][3]) + re_b[j];
        int gs = 0; float gm = gl[0];
        for (int j = 1; j < 4; ++j) if (gl[j] > gm) { gm = gl[j]; gs = j; }
        float gsum = 0.f;
        for (int j = 0; j < 4; ++j) gsum += expf(gl[j] - gm);
        const float pg = 1.0f / gsum;
        float em = el[gs * 4];
        for (int j = 1; j < 4; ++j) em = fmaxf(em, el[gs * 4 + j]);
        float ep[4], esum = 0.f;
        for (int j = 0; j < 4; ++j) { ep[j] = expf(el[gs * 4 + j] - em); esum += ep[j]; }
        for (int j = 0; j < 4; ++j) ep[j] /= esum;
        int i1 = 0; for (int j = 1; j < 4; ++j) if (ep[j] > ep[i1]) i1 = j;
        int i2 = -1; for (int j = 0; j < 4; ++j) if (j != i1 && (i2 < 0 || ep[j] > ep[i2])) i2 = j;
        const float den = ep[i1] + ep[i2];
        route_e[tok * 2] = gs * 4 + i1; route_e[tok * 2 + 1] = gs * 4 + i2;
        route_w[tok * 2] = pg * (ep[i1] / den); route_w[tok * 2 + 1] = pg * (ep[i2] / den);
    }
}

__global__ void __launch_bounds__(256) k_moe(const bf16* __restrict__ H2, const int* __restrict__ route_e, const float* __restrict__ route_w,
                                             const float* __restrict__ w_gate, const float* __restrict__ w_up, const float* __restrict__ w_down,
                                             const float* Xin, float* Xout) {
    __shared__ float xs[1024];
    __shared__ float hid[2][512];
    const int tok = blockIdx.x, tid = threadIdx.x;
#pragma unroll
    for (int i = 0; i < 4; ++i) xs[tid + 256 * i] = ldb(H2 + (size_t)tok * D + tid + 256 * i);
    __syncthreads();
    for (int s = 0; s < 2; ++s) {
        const int e = route_e[tok * 2 + s]; const float gw = route_w[tok * 2 + s];
        const float* Wg = w_gate + (size_t)e * 1024 * 512; const float* Wu = w_up + (size_t)e * 1024 * 512;
        for (int hh = 0; hh < 2; ++hh) {
            const int h = tid + hh * 256;
            float a = 0.f, bb = 0.f;
            for (int k = 0; k < 1024; ++k) { const float x = xs[k]; a += x * Wg[(size_t)k * 512 + h]; bb += x * Wu[(size_t)k * 512 + h]; }
            hid[s][h] = (a / (1.0f + expf(-a))) * bb * gw;
        }
    }
    __syncthreads();
    float acc[4] = {0.f, 0.f, 0.f, 0.f};
    for (int s = 0; s < 2; ++s) {
        const int e = route_e[tok * 2 + s];
        const float* Wd = w_down + (size_t)e * 512 * 1024;
        for (int h = 0; h < 512; ++h) {
            const float hv = hid[s][h];
#pragma unroll
            for (int i = 0; i < 4; ++i) acc[i] += hv * Wd[(size_t)h * 1024 + tid + i * 256];
        }
    }
#pragma unroll
    for (int i = 0; i < 4; ++i) Xout[(size_t)tok * D + tid + i * 256] = Xin[(size_t)tok * D + tid + i * 256] + acc[i];
}
}
#ifndef MK_NAIVE_MASK
#define MK_NAIVE_MASK 0u
#endif
#ifndef MK_HOSTREP_FLAGS
#define MK_HOSTREP_FLAGS 0
#endif
#ifndef MK_FUSE
#define MK_FUSE 1
#endif
static void launch_naive_phase(int ph, void* const* d_in, float* out, unsigned char* ws, hipStream_t stream) {
    const int l = (ph - 1) / 8, k = (ph - 1) % 8;
    const bf16* PB = (const bf16*)(ws + WS_PB); bf16* HB = (bf16*)(ws + WS_HB); unsigned* mask = (unsigned*)(ws + WS_MASK);
    int* route_e = (int*)(ws + WS_ROUTE_E); float* route_w = (float*)(ws + WS_ROUTE_W);
    const float* const* in = (const float* const*)d_in;
    switch (k) {
    case 1:
        nv::k_index_topk<<<T, 256, 0, stream>>>(PB, mask);
        nv::k_pool<<<T, 256, 0, stream>>>(PB, in[I_POOLW] + (size_t)l * 4 * 64 * 64, in[I_POOLS] + (size_t)l * 256, HB);
        nv::k_conv<<<T, 256, 0, stream>>>(PB, in[I_DWW] + (size_t)l * 31 * 256, in[I_DWB] + (size_t)l * 256, in[I_LNG] + (size_t)l * 256, in[I_LNB] + (size_t)l * 256,
                                          in[I_PWW] + (size_t)l * 256 * 256, in[I_PWB] + (size_t)l * 256, HB);
        break;
    case 2: nv::k_attn<<<T, 256, 0, stream>>>(PB, mask, HB); break;
    case 4: nv::k_router<<<T, 256, 0, stream>>>(out, in[I_N2G] + (size_t)l * D, in[I_RGW] + (size_t)l * D * 4, in[I_RGB] + (size_t)l * 4, in[I_REW] + (size_t)l * D * 16, in[I_REB] + (size_t)l * 16, HB, route_e, route_w); break;
    case 5: break;
    case 6: nv::k_moe<<<T, 256, 0, stream>>>(HB, route_e, route_w, in[I_WG] + (size_t)l * 16 * 1024 * 512, in[I_WU] + (size_t)l * 16 * 1024 * 512, in[I_WDN] + (size_t)l * 16 * 512 * 1024, out, out); break;
    default: break;
    }
}
extern "C" void kernel_launch(void* const* d_in, const int* in_sizes, int n_in, void* d_out, int out_size, void* d_ws, size_t ws_size, hipStream_t stream) {
    static int grid = 0;
    if (grid == 0) {
        if (n_in != 21 || in_sizes[0] != T * D || out_size != T * D || ws_size < WS_END) { fprintf(stderr, "kernel_launch: unexpected shapes / workspace (%d inputs, ws %zu)\n", n_in, ws_size); grid = -1; return; }
        int dev = 0, cus = 0, per_cu = 0;
        if (hipGetDevice(&dev) != hipSuccess || hipDeviceGetAttribute(&cus, hipDeviceAttributeMultiprocessorCount, dev) != hipSuccess) { grid = -1; return; }
        if (hipFuncSetAttribute((const void*)skel_fwd, hipFuncAttributeMaxDynamicSharedMemorySize, LDS_BYTES) != hipSuccess) { fprintf(stderr, "kernel_launch: hipFuncSetAttribute failed\n"); grid = -1; return; }
        if (hipOccupancyMaxActiveBlocksPerMultiprocessor(&per_cu, (const void*)skel_fwd, NWAVES * 64, LDS_BYTES) != hipSuccess || per_cu < 1)
            fprintf(stderr, "kernel_launch: note: occupancy query reports %d workgroups per CU\n", per_cu);
        (void)hipGetLastError();
        grid = cus;
    }
    if (grid < 0) return;
    if (hipMemsetAsync((char*)d_ws + WS_CTL, 0, CTL_ZERO_BYTES, stream) != hipSuccess) return;
    Args a{};
    for (int i = 0; i < 21; ++i) a.in[i] = (const float*)d_in[i];
    a.out = (float*)d_out; a.ws = (unsigned char*)d_ws;
    int ph = 0, li = 0;
    while (ph < N_PHASES) {
        if ((MK_NAIVE_MASK >> ph) & 1u) { launch_naive_phase(ph, d_in, (float*)d_out, (unsigned char*)d_ws, stream); ++ph; continue; }
        int hi = ph + 1;
        if (MK_FUSE) while (hi < N_PHASES && !((MK_NAIVE_MASK >> hi) & 1u)) ++hi;
        a.ph_lo = ph; a.ph_hi = hi; a.li = li++;
        hipLaunchKernelGGL(skel_fwd, dim3(grid), dim3(NWAVES * 64), LDS_BYTES, stream, a);
#ifdef MK_HOSTREP
        if (ph == MK_HOSTREP && hi == ph + 1) { a.pad = MK_HOSTREP_FLAGS; for (int r_ = 1; r_ < MK_HOSTREP_N; ++r_) hipLaunchKernelGGL(skel_fwd, dim3(grid), dim3(NWAVES * 64), LDS_BYTES, stream, a); a.pad = 0; }
#endif
        ph = hi;
    }
}
```
